# Optimizing an MI355X kernel written in HIP

```python
import math
import jax, jax.numpy as jnp
from jax import lax
import numpy as np

D_MODEL = 2048
BATCH = 2
SEQ = 16384
DEPTH = 4

MLA_HEADS = 6
MLA_Q_RANK = 512
MLA_KV_RANK = 256
MLA_NOPE = 128
MLA_ROPE = 64
MLA_V = 128
GLA_HEADS = 4
GLA_DK = 64
GLA_DV = 128
GLA_GATE_RANK = 16
GLA_TAU = 16.0
GLA_CHUNK = 64
DSWA_GROUPS = ((128, 1), (512, 4), (2048, 16))
DSWA_HEADS_PER_GROUP = 2
DSWA_HEADS = 6
DSWA_HEAD_DIM = 128
D_FF = 128 * ((8 * D_MODEL // 3 + 127) // 128)
ROPE_THETA = 10000.0
ALIBI_MAX_EXP = 8.0
Q_BLOCK = 128
NORM_EPS = 1e-6
NEG_INF = -1e30
IN_SPLITS = (MLA_Q_RANK, MLA_KV_RANK, MLA_ROPE,
             GLA_HEADS * GLA_DK, GLA_HEADS * GLA_DK, GLA_HEADS * GLA_DV, GLA_GATE_RANK, GLA_HEADS * GLA_DV,
             DSWA_HEADS * DSWA_HEAD_DIM, DSWA_HEADS * DSWA_HEAD_DIM, DSWA_HEADS * DSWA_HEAD_DIM,
             D_MODEL, D_MODEL, D_MODEL)
D_IN = sum(IN_SPLITS)

kernel_name = 'hybrid_mla_gla_dilated_swa_macaron'


def rms_norm(x, g):
    xf = x.astype(jnp.float32)
    y = xf * lax.rsqrt(jnp.mean(xf * xf, axis=-1, keepdims=True) + NORM_EPS)
    return (y * g.astype(jnp.float32)).astype(x.dtype)


def swiglu(h, w_gate, w_up, w_down):
    return (jax.nn.silu(h @ w_gate) * (h @ w_up)) @ w_down


def split_columns(u):
    idx, acc = [], 0
    for s in IN_SPLITS[:-1]:
        acc += s
        idx.append(acc)
    return jnp.split(u, idx, axis=-1)


def apply_rope(x, positions):
    half = x.shape[-1] // 2
    inv_freq = ROPE_THETA ** (-jnp.arange(half, dtype=jnp.float32) / half)
    ang = positions.astype(jnp.float32)[..., None] * inv_freq
    cos = jnp.cos(ang)[:, :, None, :]
    sin = jnp.sin(ang)[:, :, None, :]
    xf = x.astype(jnp.float32)
    x1, x2 = xf[..., :half], xf[..., half:]
    return jnp.concatenate([x1 * cos - x2 * sin, x1 * sin + x2 * cos], axis=-1).astype(x.dtype)


def causal_dense_attention(q, k, v, scale):
    B, S, H, Dk = q.shape
    Dv = v.shape[-1]
    nb = S // Q_BLOCK
    qb = q.reshape(B, nb, Q_BLOCK, H, Dk).transpose(1, 0, 3, 2, 4)
    kt = k.transpose(0, 2, 1, 3)
    vt = v.transpose(0, 2, 1, 3)
    key_pos = jnp.arange(S)

    def one_block(args):
        i, q_blk = args
        s = jnp.einsum('bhqd,bhkd->bhqk', q_blk, kt, preferred_element_type=jnp.float32) * scale
        q_pos = i * Q_BLOCK + jnp.arange(Q_BLOCK)
        s = jnp.where(key_pos[None, :] <= q_pos[:, None], s, NEG_INF)
        p = jax.nn.softmax(s, axis=-1)
        return jnp.einsum('bhqk,bhkd->bhqd', p.astype(v.dtype), vt)

    out = lax.map(one_block, (jnp.arange(nb), qb))
    return out.transpose(1, 0, 3, 2, 4).reshape(B, S, H, Dv)


def mla_attention(c_q, c_kv, k_rope, positions, g_cq, g_ckv, w_uq, w_ukv, g_q, g_k):
    B, S, _ = c_q.shape
    c_q = rms_norm(c_q, g_cq)
    c_kv = rms_norm(c_kv, g_ckv)
    q = (c_q @ w_uq).reshape(B, S, MLA_HEADS, MLA_NOPE + MLA_ROPE)
    kv = (c_kv @ w_ukv).reshape(B, S, MLA_HEADS, MLA_NOPE + MLA_V)
    k_nope, v = kv[..., :MLA_NOPE], kv[..., MLA_NOPE:]
    k = jnp.concatenate([k_nope, jnp.broadcast_to(k_rope[:, :, None, :], (B, S, MLA_HEADS, MLA_ROPE))], axis=-1)
    q = rms_norm(q, g_q)
    k = rms_norm(k, g_k)
    q = jnp.concatenate([q[..., :MLA_NOPE], apply_rope(q[..., MLA_NOPE:], positions)], axis=-1)
    k = jnp.concatenate([k[..., :MLA_NOPE], apply_rope(k[..., MLA_NOPE:], positions)], axis=-1)
    out = causal_dense_attention(q, k, v, (MLA_NOPE + MLA_ROPE) ** -0.5)
    return out.reshape(B, S, MLA_HEADS * MLA_V)


def gla_mixer(q, k, v, gate_lr, r, w_gate2, b_gate2, g_o):
    B, S, _ = q.shape
    H, DK, DV, C = GLA_HEADS, GLA_DK, GLA_DV, GLA_CHUNK
    n = S // C
    log_a = jax.nn.log_sigmoid((gate_lr @ w_gate2 + b_gate2).astype(jnp.float32)) / GLA_TAU

    def chunks(t, d):
        return t.astype(jnp.float32).reshape(B, n, C, H, d).transpose(1, 0, 3, 2, 4)

    qc = chunks(q, DK) * (DK ** -0.5)
    kc, vc, ac = chunks(k, DK), chunks(v, DV), chunks(log_a, DK)
    causal = jnp.tril(jnp.ones((C, C), dtype=bool))[:, :, None]

    def step(state, inp):
        qi, ki, vi, ai = inp
        b = jnp.cumsum(ai, axis=-2)
        diff = b[:, :, :, None, :] - b[:, :, None, :, :]
        decay = jnp.exp(jnp.where(causal, diff, -jnp.inf))
        attn = jnp.einsum('bhtd,bhsd,bhtsd->bhts', qi, ki, decay)
        o = attn @ vi + jnp.einsum('bhtd,bhde->bhte', qi * jnp.exp(b), state)
        b_end = b[:, :, -1:, :]
        new_state = jnp.exp(b_end[:, :, 0, :])[..., None] * state + jnp.einsum('bhsd,bhse->bhde', ki * jnp.exp(b_end - b), vi)
        return new_state, o

    state0 = jnp.zeros((B, H, DK, DV), jnp.float32)
    _, o = lax.scan(step, state0, (qc, kc, vc, ac))
    o = o.transpose(1, 0, 3, 2, 4).reshape(B, S, H, DV)
    o = rms_norm(o, g_o).reshape(B, S, H * DV)
    return (o * jax.nn.silu(r.astype(jnp.float32))).astype(v.dtype)


def dilated_group_attention(q, k, v, slopes, window, dilation):
    B, S, H, D = q.shape
    w = window // dilation
    nblk = -(-S // window)
    s_pad = nblk * window

    def to_blocks(t):
        t = jnp.pad(t, ((0, 0), (0, s_pad - S), (0, 0), (0, 0)))
        return t.reshape(B, nblk, w, dilation, H, D)

    def with_prev(t):
        prev = jnp.pad(t[:, :-1], ((0, 0), (1, 0), (0, 0), (0, 0), (0, 0), (0, 0)))
        return jnp.concatenate([prev, t], axis=2)

    qb = to_blocks(q)
    kk = with_prev(to_blocks(k))
    vv = with_prev(to_blocks(v))
    scores = jnp.einsum('bnirhd,bnjrhd->bnrhij', qb, kk, preferred_element_type=jnp.float32) * (D ** -0.5)
    i = jnp.arange(w)[:, None]
    j = jnp.arange(2 * w)[None, :]
    steps = w + i - j
    blk = jnp.arange(nblk)[:, None, None]
    valid = (steps >= 0) & (steps <= w) & ((blk > 0) | (j >= w))
    bias = -slopes.astype(jnp.float32)[:, None, None] * (steps * dilation).astype(jnp.float32)
    scores = jnp.where(valid[None, :, None, None], scores + bias[None, None, None], NEG_INF)
    lse = jax.nn.logsumexp(scores, axis=-1)
    probs = jnp.exp(scores - lse[..., None])
    out = jnp.einsum('bnrhij,bnjrhd->bnirhd', probs.astype(v.dtype), vv)
    out = out.reshape(B, s_pad, H, D)[:, :S]
    lse = lse.transpose(0, 1, 4, 2, 3).reshape(B, s_pad, H)[:, :S]
    return out, lse


def dilated_swa_mixer(q, k, v, g_q, g_k):
    B, S, _ = q.shape
    q = rms_norm(q.reshape(B, S, DSWA_HEADS, DSWA_HEAD_DIM), g_q)
    k = rms_norm(k.reshape(B, S, DSWA_HEADS, DSWA_HEAD_DIM), g_k)
    v = v.reshape(B, S, DSWA_HEADS, DSWA_HEAD_DIM)
    slopes = 2.0 ** (-ALIBI_MAX_EXP * jnp.arange(1, DSWA_HEADS + 1, dtype=jnp.float32) / DSWA_HEADS)
    outs, lses = [], []
    for gi, (window, dilation) in enumerate(DSWA_GROUPS):
        sl = slice(gi * DSWA_HEADS_PER_GROUP, (gi + 1) * DSWA_HEADS_PER_GROUP)
        o, l = dilated_group_attention(q[:, :, sl], k[:, :, sl], v[:, :, sl], slopes[sl], window, dilation)
        outs.append(o)
        lses.append(l)
    wts = jax.nn.softmax(jnp.stack(lses, axis=0), axis=0)
    y = jnp.einsum('gbsh,gbshd->bshd', wts.astype(v.dtype), jnp.stack(outs, axis=0))
    return y.reshape(B, S, DSWA_HEADS_PER_GROUP * DSWA_HEAD_DIM)


def setup_inputs(seed: int = 0) -> dict:
    key = jax.random.key(seed)
    ks = jax.random.split(key, 32)

    def w(k, fan_in, fan_out):
        return jax.random.normal(k, (DEPTH, fan_in, fan_out), jnp.float32) * (fan_in ** -0.5)

    def gain(k, n):
        return 1.0 + 0.02 * jax.random.normal(k, (DEPTH, n), jnp.float32)

    x = jax.random.normal(ks[0], (BATCH, SEQ, D_MODEL), jnp.float32)
    offsets = jax.random.randint(ks[1], (BATCH, 1), 0, 4096, dtype=jnp.int32)
    positions = (offsets + jnp.arange(SEQ, dtype=jnp.int32)[None, :]).astype(jnp.int32)
    return {
        'x': x,
        'positions': positions,
        'ffn1_norm': gain(ks[2], D_MODEL),
        'ffn1_w_gate': w(ks[3], D_MODEL, D_FF),
        'ffn1_w_up': w(ks[4], D_MODEL, D_FF),
        'ffn1_w_down': w(ks[5], D_FF, D_MODEL),
        'mix_norm': gain(ks[6], D_MODEL),
        'w_in': w(ks[7], D_MODEL, D_IN),
        'mla_cq_norm': gain(ks[8], MLA_Q_RANK),
        'mla_ckv_norm': gain(ks[9], MLA_KV_RANK),
        'mla_w_uq': w(ks[10], MLA_Q_RANK, MLA_HEADS * (MLA_NOPE + MLA_ROPE)),
        'mla_w_ukv': w(ks[11], MLA_KV_RANK, MLA_HEADS * (MLA_NOPE + MLA_V)),
        'mla_q_norm': gain(ks[12], MLA_NOPE + MLA_ROPE),
        'mla_k_norm': gain(ks[13], MLA_NOPE + MLA_ROPE),
        'gla_w_gate2': w(ks[14], GLA_GATE_RANK, GLA_HEADS * GLA_DK),
        'gla_b_gate2': 0.1 * jax.random.normal(ks[15], (DEPTH, GLA_HEADS * GLA_DK), jnp.float32),
        'gla_o_norm': gain(ks[16], GLA_DV),
        'dswa_q_norm': gain(ks[17], DSWA_HEAD_DIM),
        'dswa_k_norm': gain(ks[18], DSWA_HEAD_DIM),
        'w_branch_a': w(ks[19], MLA_HEADS * MLA_V, D_MODEL),
        'w_branch_b': w(ks[20], GLA_HEADS * GLA_DV, D_MODEL),
        'w_branch_c': w(ks[21], DSWA_HEADS_PER_GROUP * DSWA_HEAD_DIM, D_MODEL),
        'w_out': w(ks[22], D_MODEL, D_MODEL),
        'ffn2_norm': gain(ks[23], D_MODEL),
        'ffn2_w_gate': w(ks[24], D_MODEL, D_FF),
        'ffn2_w_up': w(ks[25], D_MODEL, D_FF),
        'ffn2_w_down': w(ks[26], D_FF, D_MODEL),
    }


def reference(x, positions, ffn1_norm, ffn1_w_gate, ffn1_w_up, ffn1_w_down, mix_norm, w_in,
              mla_cq_norm, mla_ckv_norm, mla_w_uq, mla_w_ukv, mla_q_norm, mla_k_norm,
              gla_w_gate2, gla_b_gate2, gla_o_norm, dswa_q_norm, dswa_k_norm,
              w_branch_a, w_branch_b, w_branch_c, w_out,
              ffn2_norm, ffn2_w_gate, ffn2_w_up, ffn2_w_down):
    for l in range(DEPTH):
        x = x + 0.5 * swiglu(rms_norm(x, ffn1_norm[l]), ffn1_w_gate[l], ffn1_w_up[l], ffn1_w_down[l])
        h = rms_norm(x, mix_norm[l])
        (c_q, c_kv, k_rope, q_b, k_b, v_b, gate_lr, r_b,
         q_c, k_c, v_c, g_a, g_b, g_c) = split_columns(h @ w_in[l])
        y_a = mla_attention(c_q, c_kv, k_rope, positions, mla_cq_norm[l], mla_ckv_norm[l],
                            mla_w_uq[l], mla_w_ukv[l], mla_q_norm[l], mla_k_norm[l])
        y_b = gla_mixer(q_b, k_b, v_b, gate_lr, r_b, gla_w_gate2[l], gla_b_gate2[l], gla_o_norm[l])
        y_c = dilated_swa_mixer(q_c, k_c, v_c, dswa_q_norm[l], dswa_k_norm[l])
        merged = (jax.nn.sigmoid(g_a) * (y_a @ w_branch_a[l])
                  + jax.nn.sigmoid(g_b) * (y_b @ w_branch_b[l])
                  + jax.nn.sigmoid(g_c) * (y_c @ w_branch_c[l]))
        x = x + merged @ w_out[l]
        x = x + 0.5 * swiglu(rms_norm(x, ffn2_norm[l]), ffn2_w_gate[l], ffn2_w_up[l], ffn2_w_down[l])
    return x
```

```cpp
#include <hip/hip_runtime.h>
#include <cstdio>
#include <cstdint>

#ifndef MK_SINGLE
#define MK_SINGLE 0
#endif

__device__ __forceinline__ int lane_id_v() { int x; asm volatile("v_mbcnt_lo_u32_b32 %0, -1, 0\n\tv_mbcnt_hi_u32_b32 %0, -1, %0" : "=v"(x)); return x; }
namespace pg8 {
#define PG8_LAS __attribute__((address_space(3)))
typedef unsigned short bf16_t;
typedef short bf16x8 __attribute__((ext_vector_type(8)));
typedef float f32x4 __attribute__((ext_vector_type(4)));
typedef unsigned u32x4 __attribute__((ext_vector_type(4)));
constexpr int BM = 256, BK = 64, HALF = 128, HTB = HALF * BK * 2  , STAGE_BYTES = 8 * HTB, NXCD = 8, WGM = 8;

__host__ __device__ __forceinline__ int lds_byte(int r, int c) { const int st = (r >> 4) * 2 + (c >> 5), rr = r & 15, cc = c & 31, ob = rr * 64 + cc * 2; return st * 1024 + (ob ^ (((ob >> 9) & 1) << 5)); }
__host__ __device__ __forceinline__ void stage_rc(int b, int& R, int& C) { const int st = b / 1024, sb = b % 1024, swz = sb ^ (((sb >> 9) & 1) << 5); R = (st >> 1) * 16 + swz / 64; C = (st & 1) * 32 + (swz % 64) / 2; }
__host__ __device__ __forceinline__ int perm32(int rho) { const int n = rho >> 4, i = rho & 15; return 8 * (i >> 2) + 4 * n + (i & 3); }

struct Unit { int pm, pn; };
struct Gemm { const bf16_t* A; const bf16_t* Bt; int M, N, K, lda; };

struct StaticOrder {
    int nM, nN, nwg, G, c;
    __host__ __device__ void init(int M, int N, int G_, int c_) { nM = M / BM; nN = N / BM; nwg = nM * nN; G = G_; c = c_; }
    __host__ __device__ bool next(int i, Unit& u) const {
        const long L = (long)i * G + c; if (L >= nwg) return false;
        int wgid = (int)L; { const int q = nwg / NXCD, r = nwg % NXCD, xcd = wgid % NXCD, off = wgid / NXCD; wgid = (xcd < r ? xcd * (q + 1) : r * (q + 1) + (xcd - r) * q) + off; }
        const int nig = WGM * nN, gid = wgid / nig, fm = gid * WGM, gsz = (nM - fm) < WGM ? (nM - fm) : WGM;
        u.pm = fm + ((wgid % nig) % gsz); u.pn = (wgid % nig) / gsz; return true;
    }
    __device__ __forceinline__ void a_ready(const Unit&) const {}
    __device__ __forceinline__ void done(const Unit&) const {}
};
__device__ __forceinline__ unsigned cvt_pk_bf16(float lo, float hi) { unsigned r; asm volatile("v_cvt_pk_bf16_f32 %0, %1, %2" : "=v"(r) : "v"(lo), "v"(hi)); return r; }

template <class Epi, class Sched, bool ALIGN_EPI = false, bool SP2 = false>
__device__ __forceinline__ void gemm_phase(PG8_LAS unsigned char* lds, const Gemm g, const Sched& S, const Epi& E, const int wv) {
    int tid_ = wv * 64 + lane_id_v(); asm volatile("" : "+v"(tid_));
    const int tid = tid_, wid = __builtin_amdgcn_readfirstlane(tid >> 6), lane = tid & 63, wr = wid >> 2, wc = wid & 3, fr = lane & 15, fq = lane >> 4;
    const int K = g.K, nt = K / BK;
    unsigned voffA[2], voffB[2];
#pragma unroll
    for (int i = 0; i < 2; ++i) { int R, C; stage_rc(tid * 16 + i * 8192, R, C); const int Rb = Epi::PERM ? ((R & ~31) + perm32(R & 31)) : R;
        voffA[i] = (unsigned)(R * g.lda + C) * 2u; voffB[i] = (unsigned)(Rb * K + C) * 2u; }
    const size_t kstep = (size_t)(BK * 2);
    const size_t hstep = (size_t)HALF * K * 2, hstepA = (size_t)HALF * g.lda * 2;
    const size_t tstep = 2 * hstep, tstepA = 2 * hstepA;
    const unsigned ldsw = (unsigned)wid * 1024u;
    const int aoff = lds_byte(wr * 64 + fr, fq * 8), boff = lds_byte(wc * 32 + fr, fq * 8);
#define PG8_SA(b, h) (((b) * 2 + (h)) * HTB)
#define PG8_SB(b, h) ((4 + (b) * 2 + (h)) * HTB)
#define PG8_STAGE(bufoff, gbase, voff) do { _Pragma("unroll") for (int _i = 0; _i < 2; ++_i) \
        __builtin_amdgcn_global_load_lds((const unsigned*)((const char*)(gbase) + (voff)[_i]), (PG8_LAS unsigned*)(lds + (bufoff) + ldsw + _i * 8192), 16, 0, 0); } while (0)
#define PG8_LDA(dst, b, h) do { _Pragma("unroll") for (int m = 0; m < 4; ++m) _Pragma("unroll") for (int k = 0; k < 2; ++k) dst[m][k] = *(const PG8_LAS bf16x8*)(lds + PG8_SA(b, h) + aoff + m * 2048 + k * 1024); } while (0)
#define PG8_LDB(dst, b, h) do { _Pragma("unroll") for (int n = 0; n < 2; ++n) _Pragma("unroll") for (int k = 0; k < 2; ++k) dst[n][k] = *(const PG8_LAS bf16x8*)(lds + PG8_SB(b, h) + boff + n * 2048 + k * 1024); } while (0)
#define PG8_MMA(ai, bj, At, Bt) do { __builtin_amdgcn_s_setprio(1); _Pragma("unroll") for (int m = 0; m < 4; ++m) _Pragma("unroll") for (int n = 0; n < 2; ++n) _Pragma("unroll") for (int k = 0; k < 2; ++k) \
        acc[ai][bj][m][n] = __builtin_amdgcn_mfma_f32_16x16x32_bf16(Bt[n][k], At[m][k], acc[ai][bj][m][n], 0, 0, 0); __builtin_amdgcn_s_setprio(0); } while (0)
#define PG8_WAIT_V(n) asm volatile("s_waitcnt vmcnt(" #n ")" ::: "memory")
#define PG8_WAIT_L(n) asm volatile("s_waitcnt lgkmcnt(" #n ")" ::: "memory")
#define PG8_BAR __builtin_amdgcn_s_barrier()
#define PG8_SCHED __builtin_amdgcn_sched_barrier(0)
    Unit cur, nxt; int ui = 0;
    if (!S.next(0, cur)) return;
    f32x4 acc[2][2][4][2];
#pragma unroll
    for (int a = 0; a < 2; ++a)
#pragma unroll
        for (int b = 0; b < 2; ++b)
#pragma unroll
            for (int m = 0; m < 4; ++m)
#pragma unroll
                for (int n = 0; n < 2; ++n) acc[a][b][m][n] = (f32x4){0.f, 0.f, 0.f, 0.f};
    bf16x8 At[4][2], B0[2][2], B1[2][2];
    const char* cA = (const char*)g.A + (size_t)cur.pm * tstepA; const char* cB = (const char*)g.Bt + (size_t)cur.pn * tstep;
    S.a_ready(cur);
    if constexpr (SP2) {
        PG8_STAGE(PG8_SB(0, 0), cB, voffB); PG8_STAGE(PG8_SB(0, 1), cB + hstep, voffB); PG8_STAGE(PG8_SA(0, 0), cA, voffA); PG8_STAGE(PG8_SA(0, 1), cA + hstepA, voffA);
        if (wr == 1) PG8_BAR;
        PG8_WAIT_V(2); PG8_BAR;
        PG8_STAGE(PG8_SB(1, 0), cB + kstep, voffB); PG8_STAGE(PG8_SA(1, 0), cA + kstep, voffA); PG8_STAGE(PG8_SB(1, 1), cB + hstep + kstep, voffB);
        PG8_WAIT_V(6); PG8_BAR;
    } else {
        PG8_STAGE(PG8_SB(0, 0), cB, voffB); PG8_STAGE(PG8_SA(0, 0), cA, voffA); PG8_STAGE(PG8_SB(0, 1), cB + hstep, voffB); PG8_STAGE(PG8_SA(0, 1), cA + hstepA, voffA);
        if (wr == 1) PG8_BAR;
        PG8_WAIT_V(4); PG8_BAR;
        PG8_STAGE(PG8_SB(1, 0), cB + kstep, voffB); PG8_STAGE(PG8_SA(1, 0), cA + kstep, voffA); PG8_STAGE(PG8_SB(1, 1), cB + hstep + kstep, voffB);
        PG8_WAIT_V(6); PG8_BAR;
    }
    for (;;) {
        const bool has_next = S.next(ui + 1, nxt);
        const char* nA = has_next ? (const char*)g.A + (size_t)nxt.pm * tstepA : cA; const char* nB = has_next ? (const char*)g.Bt + (size_t)nxt.pn * tstep : cB;
        for (int t = 0; t < nt; t += 2) {
            const bool last = (t == nt - 2);
            const char* a1 = cA + (size_t)(t + 1) * kstep;
            const char* a2 = last ? nA : cA + (size_t)(t + 2) * kstep; const char* b2 = last ? nB : cB + (size_t)(t + 2) * kstep;
            const char* a3 = a2 + kstep; const char* b3 = b2 + kstep;
            if (last && has_next) S.a_ready(nxt);
            if constexpr (SP2) {
            PG8_LDB(B0, 0, 0); PG8_LDB(B1, 0, 1); PG8_SCHED; PG8_LDA(At, 0, 0); PG8_STAGE(PG8_SA(1, 1), a1 + hstepA, voffA);
            PG8_WAIT_V(8); PG8_WAIT_L(0); PG8_BAR; PG8_MMA(0, 0, At, B0); PG8_MMA(0, 1, At, B1); PG8_BAR; PG8_SCHED;
            PG8_LDA(At, 0, 1); PG8_STAGE(PG8_SB(0, 0), b2, voffB); PG8_STAGE(PG8_SB(0, 1), b2 + hstep, voffB); PG8_STAGE(PG8_SA(0, 0), a2, voffA);
            PG8_WAIT_V(8); PG8_WAIT_L(0); PG8_BAR; PG8_MMA(1, 0, At, B0); PG8_MMA(1, 1, At, B1); PG8_BAR; PG8_SCHED;
            PG8_LDB(B0, 1, 0); PG8_LDB(B1, 1, 1); PG8_SCHED; PG8_LDA(At, 1, 0); PG8_STAGE(PG8_SA(0, 1), a2 + hstepA, voffA);
            PG8_WAIT_V(8); PG8_WAIT_L(0); PG8_BAR; PG8_MMA(0, 0, At, B0); PG8_MMA(0, 1, At, B1); PG8_BAR; PG8_SCHED;
            PG8_LDA(At, 1, 1); PG8_STAGE(PG8_SB(1, 0), b3, voffB); PG8_STAGE(PG8_SB(1, 1), b3 + hstep, voffB); PG8_STAGE(PG8_SA(1, 0), a3, voffA);
            PG8_WAIT_V(8); PG8_WAIT_L(0); PG8_BAR; PG8_MMA(1, 0, At, B0); PG8_MMA(1, 1, At, B1); PG8_BAR; PG8_SCHED;
            } else {
            PG8_LDB(B0, 0, 0); PG8_SCHED; PG8_LDA(At, 0, 0); PG8_STAGE(PG8_SA(1, 1), a1 + hstepA, voffA);
            PG8_WAIT_L(8); PG8_BAR; PG8_WAIT_L(0); PG8_MMA(0, 0, At, B0); PG8_BAR; PG8_SCHED;
            PG8_LDB(B1, 0, 1); PG8_STAGE(PG8_SB(0, 0), b2, voffB);
            PG8_BAR; PG8_WAIT_L(0); PG8_MMA(0, 1, At, B1); PG8_BAR;
            PG8_LDA(At, 0, 1); PG8_STAGE(PG8_SA(0, 0), a2, voffA);
            PG8_BAR; PG8_WAIT_L(0); PG8_MMA(1, 0, At, B0); PG8_BAR; PG8_SCHED;
            PG8_STAGE(PG8_SB(0, 1), b2 + hstep, voffB);
            PG8_WAIT_V(6); PG8_BAR; PG8_MMA(1, 1, At, B1); PG8_BAR;
            PG8_LDB(B0, 1, 0); PG8_SCHED; PG8_LDA(At, 1, 0); PG8_STAGE(PG8_SA(0, 1), a2 + hstepA, voffA);
            PG8_WAIT_L(8); PG8_BAR; PG8_WAIT_L(0); PG8_MMA(0, 0, At, B0); PG8_BAR; PG8_SCHED;
            PG8_LDB(B1, 1, 1); PG8_STAGE(PG8_SB(1, 0), b3, voffB);
            PG8_BAR; PG8_WAIT_L(0); PG8_MMA(0, 1, At, B1); PG8_BAR;
            PG8_LDA(At, 1, 1); PG8_STAGE(PG8_SA(1, 0), a3, voffA);
            PG8_BAR; PG8_WAIT_L(0); PG8_MMA(1, 0, At, B0); PG8_BAR; PG8_SCHED;
            PG8_STAGE(PG8_SB(1, 1), b3 + hstep, voffB);
            PG8_WAIT_V(6); PG8_BAR; PG8_MMA(1, 1, At, B1); PG8_BAR;
            }
        }
        if constexpr (ALIGN_EPI) { if (wr == 0) PG8_BAR; }
        if constexpr (!Epi::AFTER_DRAIN) { E(acc, cur, wr, wc, fr, fq); S.done(cur); }
        if (!has_next) break;
#pragma unroll
        for (int a = 0; a < 2; ++a)
#pragma unroll
            for (int b = 0; b < 2; ++b)
#pragma unroll
                for (int m = 0; m < 4; ++m)
#pragma unroll
                    for (int n = 0; n < 2; ++n) acc[a][b][m][n] = (f32x4){0.f, 0.f, 0.f, 0.f};
        cur = nxt; cA = nA; cB = nB; ++ui;
        if constexpr (ALIGN_EPI) { if (wr == 1) PG8_BAR; }
    }
    PG8_WAIT_V(0);
    if constexpr (!ALIGN_EPI) { if (wr == 0) PG8_BAR; }
    PG8_BAR;
    if constexpr (Epi::AFTER_DRAIN) { E.fused(acc, cur, wr, wc, fr, fq, lds, wid, lane); S.done(cur); }
#undef PG8_SA
#undef PG8_SB
#undef PG8_STAGE
#undef PG8_LDA
#undef PG8_LDB
#undef PG8_MMA
#undef PG8_WAIT_V
#undef PG8_WAIT_L
#undef PG8_BAR
#undef PG8_SCHED
}

constexpr float NORM_EPS = 1e-6f;
__device__ __forceinline__ float row_rstd(const float* ssq, int row, int fq) {
    const f32x4 a = *(const f32x4*)(ssq + (size_t)row * 32 + fq * 8), b = *(const f32x4*)(ssq + (size_t)row * 32 + fq * 8 + 4);
    float s = ((a[0] + a[1]) + (a[2] + a[3])) + ((b[0] + b[1]) + (b[2] + b[3]));
    s += __shfl_xor(s, 16); s += __shfl_xor(s, 32);
    return rsqrtf(s * (1.0f / 2048.0f) + NORM_EPS);
}
__device__ __forceinline__ float fsigmoid(float x) { return __builtin_amdgcn_rcpf(1.0f + __expf(-x)); }
__device__ __forceinline__ u32x4 pack8(const f32x4 v0, const f32x4 v1) { u32x4 w; w.x = cvt_pk_bf16(v0[0], v0[1]); w.y = cvt_pk_bf16(v0[2], v0[3]); w.z = cvt_pk_bf16(v1[0], v1[1]); w.w = cvt_pk_bf16(v1[2], v1[3]); return w; }
__device__ __forceinline__ void unpack8(const u32x4 w, f32x4& v0, f32x4& v1) {
    v0[0] = __uint_as_float(w.x << 16); v0[1] = __uint_as_float(w.x & 0xffff0000u); v0[2] = __uint_as_float(w.y << 16); v0[3] = __uint_as_float(w.y & 0xffff0000u);
    v1[0] = __uint_as_float(w.z << 16); v1[1] = __uint_as_float(w.z & 0xffff0000u); v1[2] = __uint_as_float(w.w << 16); v1[3] = __uint_as_float(w.w & 0xffff0000u); }

struct EpiSwiGLU {
    static constexpr bool PERM = true, AFTER_DRAIN = false;
    const float* ssq; bf16_t* H; int ldh;
    __device__ __forceinline__ void operator()(const f32x4 (&acc)[2][2][4][2], const Unit& u, int wr, int wc, int fr, int fq) const {
        const int row0 = u.pm * BM + wr * 64 + fr, col0 = u.pn * HALF + wc * 32 + 8 * fq;
#pragma unroll
        for (int ai = 0; ai < 2; ++ai)
#pragma unroll
            for (int m = 0; m < 4; ++m) { const int row = row0 + ai * HALF + m * 16; const float rs = row_rstd(ssq, row, fq);
                f32x4 h0, h1;
#pragma unroll
                for (int j = 0; j < 4; ++j) { const float g0 = acc[ai][0][m][0][j] * rs, g1 = acc[ai][0][m][1][j] * rs;
                    h0[j] = g0 * fsigmoid(g0) * (acc[ai][1][m][0][j] * rs); h1[j] = g1 * fsigmoid(g1) * (acc[ai][1][m][1][j] * rs); }
                *(u32x4*)(H + (size_t)row * ldh + col0) = pack8(h0, h1); }
    }
};
struct EpiResid {
    static constexpr bool PERM = true, AFTER_DRAIN = false;
    const float* base; float* out; bf16_t* xb; float* ssq; float alpha;
    __device__ __forceinline__ void operator()(const f32x4 (&acc)[2][2][4][2], const Unit& u, int wr, int wc, int fr, int fq) const {
        const int row0 = u.pm * BM + wr * 64 + fr, col0 = u.pn * BM + wc * 32 + 8 * fq;
#pragma unroll
        for (int ai = 0; ai < 2; ++ai)
#pragma unroll
            for (int m = 0; m < 4; ++m) { const int row = row0 + ai * HALF + m * 16; float ss = 0.f;
#pragma unroll
                for (int bj = 0; bj < 2; ++bj) { const size_t off = (size_t)row * 2048 + col0 + bj * HALF;
                    const f32x4 b0 = *(const f32x4*)(base + off), b1 = *(const f32x4*)(base + off + 4);
                    const f32x4 v0 = b0 + acc[ai][bj][m][0] * alpha, v1 = b1 + acc[ai][bj][m][1] * alpha;
                    *(f32x4*)(out + off) = v0; *(f32x4*)(out + off + 4) = v1;
                    ss += ((v0[0] * v0[0] + v0[1] * v0[1]) + (v0[2] * v0[2] + v0[3] * v0[3])) + ((v1[0] * v1[0] + v1[1] * v1[1]) + (v1[2] * v1[2] + v1[3] * v1[3]));
                    *(u32x4*)(xb + off) = pack8(v0, v1); }
                ss += __shfl_xor(ss, 16); ss += __shfl_xor(ss, 32);
                if (fq == 0) ssq[(size_t)row * 32 + u.pn * 4 + wc] = ss; }
    }
};
struct EpiWin {
    static constexpr bool PERM = true, AFTER_DRAIN = false;
    const float* ssq; bf16_t* u1; bf16_t* u2; int ld1, ld2;
    __device__ __forceinline__ void operator()(const f32x4 (&acc)[2][2][4][2], const Unit& u, int wr, int wc, int fr, int fq) const {
        const int row0 = u.pm * BM + wr * 64 + fr; const int mode = u.pn < 17 ? 0 : (u.pn < 19 ? 1 : 2);
        bf16_t* dst = mode == 2 ? u2 : u1; const int ld = mode == 2 ? ld2 : ld1; const int col0 = (mode == 2 ? (u.pn - 19) : u.pn) * BM + wc * 32 + 8 * fq;
#pragma unroll
        for (int ai = 0; ai < 2; ++ai)
#pragma unroll
            for (int m = 0; m < 4; ++m) { const int row = row0 + ai * HALF + m * 16; const float rs = row_rstd(ssq, row, fq);
#pragma unroll
                for (int bj = 0; bj < 2; ++bj) { f32x4 v0 = acc[ai][bj][m][0] * rs, v1 = acc[ai][bj][m][1] * rs;
                    if (mode == 1) {
#pragma unroll
                        for (int j = 0; j < 4; ++j) { v0[j] = v0[j] * fsigmoid(v0[j]); v1[j] = v1[j] * fsigmoid(v1[j]); } }
                    else if (mode == 2) {
#pragma unroll
                        for (int j = 0; j < 4; ++j) { v0[j] = fsigmoid(v0[j]); v1[j] = fsigmoid(v1[j]); } }
                    *(u32x4*)(dst + (size_t)row * ld + col0 + bj * HALF) = pack8(v0, v1); } }
    }
};
struct EpiF32 {
    static constexpr bool PERM = false, AFTER_DRAIN = false;
    float* C; int ldc;
    __device__ __forceinline__ void operator()(const f32x4 (&acc)[2][2][4][2], const Unit& u, int wr, int wc, int fr, int fq) const {
        const int row0 = u.pm * BM + wr * 64 + fr, col0 = u.pn * BM + wc * 32 + 4 * fq;
#pragma unroll
        for (int ai = 0; ai < 2; ++ai)
#pragma unroll
            for (int m = 0; m < 4; ++m) { float* rowp = C + (size_t)(row0 + ai * HALF + m * 16) * ldc + col0;
#pragma unroll
                for (int bj = 0; bj < 2; ++bj)
#pragma unroll
                    for (int n = 0; n < 2; ++n) *(f32x4*)(rowp + bj * HALF + n * 16) = acc[ai][bj][m][n]; }
    }
};
template <int MODE> struct EpiMerge {
    static constexpr bool PERM = true, AFTER_DRAIN = false;
    const bf16_t* gate; int ldg; float* m32; bf16_t* mb;
    __device__ __forceinline__ void operator()(const f32x4 (&acc)[2][2][4][2], const Unit& u, int wr, int wc, int fr, int fq) const {
        const int row0 = u.pm * BM + wr * 64 + fr, col0 = u.pn * BM + wc * 32 + 8 * fq;
#pragma unroll
        for (int ai = 0; ai < 2; ++ai)
#pragma unroll
            for (int m = 0; m < 4; ++m) { const int row = row0 + ai * HALF + m * 16;
#pragma unroll
                for (int bj = 0; bj < 2; ++bj) { const int col = col0 + bj * HALF; const size_t off = (size_t)row * 2048 + col;
                    f32x4 g0, g1; unpack8(*(const u32x4*)(gate + (size_t)row * ldg + col), g0, g1);
                    f32x4 v0 = g0 * acc[ai][bj][m][0], v1 = g1 * acc[ai][bj][m][1];
                    if (MODE >= 1) { v0 += *(const f32x4*)(m32 + off); v1 += *(const f32x4*)(m32 + off + 4); }
                    if (MODE <= 1) { *(f32x4*)(m32 + off) = v0; *(f32x4*)(m32 + off + 4) = v1; }
                    else *(u32x4*)(mb + off) = pack8(v0, v1); } }
    }
};
}

#define GAS __attribute__((address_space(1)))
#define LAS __attribute__((address_space(3)))
typedef unsigned short bf16_t;
typedef short bf16x8 __attribute__((ext_vector_type(8)));
typedef short s16x4 __attribute__((ext_vector_type(4)));
typedef float f32x4 __attribute__((ext_vector_type(4)));
typedef float f32x16 __attribute__((ext_vector_type(16)));
typedef unsigned u32x4 __attribute__((ext_vector_type(4)));
typedef unsigned u32x2 __attribute__((ext_vector_type(2)));
#define LDS_WAIT() asm volatile("s_waitcnt lgkmcnt(0)" ::: "memory")
#define VM_WAIT() asm volatile("s_waitcnt vmcnt(0)" ::: "memory")
#define SBAR() __builtin_amdgcn_sched_barrier(0)
__device__ __forceinline__ unsigned f2bf(float f) { unsigned u = __builtin_bit_cast(unsigned, f); return (u + 0x7fffu + ((u >> 16) & 1u)) >> 16; }
__device__ __forceinline__ float bf2f(bf16_t b) { return __uint_as_float(((unsigned)b) << 16); }
__device__ __forceinline__ unsigned pk2(float lo, float hi) { return f2bf(lo) | (f2bf(hi) << 16); }
__device__ __forceinline__ float wave_sum(float v) {
#pragma unroll
    for (int o = 1; o < 64; o <<= 1) v += __shfl_xor(v, o);
    return v;
}

constexpr int NB = 2, SEQ = 16384, MTOK = NB * SEQ, DM = 2048, FF = 5504, DEPTH = 4;
constexpr int NGU = 2 * FF, NIN = 11008, U1W = 4864, U2W = 6144;
constexpr int C_CQ = 0, C_CKV = 512, C_QB = 768, C_KB = 1024, C_VB = 1280, C_QC = 1792, C_KC = 2560, C_VC = 3328, C_KROPE = 4096, C_GLR = 4160, C_RB = 4352;
constexpr int QRAW_LD = 1280, KVRAW_LD = 1536;
constexpr float EPS = 1e-6f, LOG2E = 1.4426950408889634f, LN2 = 0.6931471805599453f;
constexpr float QS_MLA = 0.07216878364870322f * LOG2E;
constexpr float QS_DSWA = 0.08838834764831845f * LOG2E;

namespace att {
constexpr int SHM_V = 64 * 128 * 2;
constexpr int K_OFF = 2 * SHM_V;
template <int DQK> struct Geo { static constexpr int KP = DQK * 2 + 16, SHM_K = 64 * KP, NCH = DQK / 8, NKST = (64 * NCH) / 512, WS_OFF = K_OFF + 2 * SHM_K; };
__device__ __forceinline__ int v_st(int k, int c) { const int kk = (k & ~0xC) | ((k & 4) << 1) | ((k & 8) >> 1); return ((kk >> 3) * 4 + (c >> 5)) * 512 + ((kk & 7) * 32 + (c & 31)) * 2; }
__device__ __forceinline__ int v_rd_base(int lane) { return ((lane & 3) << 3) | (((lane >> 2) & 3) << 6) | (((lane >> 4) & 1) << 5) | (((lane >> 5) & 1) << 8); }
constexpr int v_rd_off(int d0, int ks, int half) { return d0 * 512 + ks * 4096 + half * 2048; }
__device__ __forceinline__ int crow(int r, int hi) { return (r & 3) + 8 * (r >> 2) + 4 * hi; }
__device__ __forceinline__ unsigned cvtpk(float lo, float hi) { unsigned r; asm volatile("v_cvt_pk_bf16_f32 %0, %1, %2" : "=v"(r) : "v"(lo), "v"(hi)); return r; }

__device__ __forceinline__ void pv_tile(f32x16* o, int vb, bf16x8 pa0, bf16x8 pa1, bf16x8 pa2, bf16x8 pa3) {
#define TRRD(dst, off) asm volatile("ds_read_b64_tr_b16 %0, %1 offset:%2" : "=&v"(dst) : "v"(vb), "i"(off) : "memory")
#define PV_D0(d0) do { s16x4 l0, l1, l2, l3, h0, h1, h2, h3; constexpr int b_ = v_rd_off(d0, 0, 0); \
        TRRD(l0, b_); TRRD(h0, b_ + 2048); TRRD(l1, b_ + 4096); TRRD(h1, b_ + 6144); TRRD(l2, b_ + 8192); TRRD(h2, b_ + 10240); TRRD(l3, b_ + 12288); TRRD(h3, b_ + 14336); \
        asm volatile("s_waitcnt lgkmcnt(0)" ::: "memory"); SBAR(); \
        o[d0] = __builtin_amdgcn_mfma_f32_32x32x16_bf16(pa0, (bf16x8){l0[0], l0[1], l0[2], l0[3], h0[0], h0[1], h0[2], h0[3]}, o[d0], 0, 0, 0); \
        o[d0] = __builtin_amdgcn_mfma_f32_32x32x16_bf16(pa1, (bf16x8){l1[0], l1[1], l1[2], l1[3], h1[0], h1[1], h1[2], h1[3]}, o[d0], 0, 0, 0); \
        o[d0] = __builtin_amdgcn_mfma_f32_32x32x16_bf16(pa2, (bf16x8){l2[0], l2[1], l2[2], l2[3], h2[0], h2[1], h2[2], h2[3]}, o[d0], 0, 0, 0); \
        o[d0] = __builtin_amdgcn_mfma_f32_32x32x16_bf16(pa3, (bf16x8){l3[0], l3[1], l3[2], l3[3], h3[0], h3[1], h3[2], h3[3]}, o[d0], 0, 0, 0); } while (0)
    PV_D0(0); PV_D0(1); PV_D0(2); PV_D0(3);
#undef PV_D0
#undef TRRD
}

struct AUnit { const bf16_t* Q; const bf16_t* K; const bf16_t* V; bf16_t* O; float* lse; size_t qpitch, kpitch, vpitch, opitch, lsepitch; int q0, j_lo, j_hi; float bias_c; };

template <int DQK, int MODE>
__device__ __forceinline__ void attn_unit(LAS unsigned char* lds, const AUnit& u, const int wv) {
    using G = Geo<DQK>;
    int tid_ = wv * 64 + lane_id_v(); asm volatile("" : "+v"(tid_));
    const int tid = tid_, wid = __builtin_amdgcn_readfirstlane(tid >> 6), lane = tid & 63, r32 = lane & 31, hi = lane >> 5;
    LAS unsigned char* V_lds = lds; LAS unsigned char* K_lds = lds + K_OFF;
    LAS float* wsl = (LAS float*)(lds + G::WS_OFF) + wid * 64; LAS float* li_l = wsl; LAS float* al_l = wsl + 32;
    bf16x8 qr[DQK / 16];
    { const bf16_t* qrow = u.Q + (size_t)(wid * 32 + r32) * u.qpitch + hi * 8;
#pragma unroll
      for (int d0 = 0; d0 < DQK / 16; ++d0) qr[d0] = *(const bf16x8*)(qrow + d0 * 16); }
    float m_reg = -1e30f, l_reg = 0.f; f32x16 o[4] = {};
    bf16x8 stk[G::NKST], stv0, stv1;
    const int sr = tid >> 4, sc = (tid & 15) * 8, vst0 = v_st(sr, sc), vst1 = v_st(32 + sr, sc);
    const int vb0 = (int)(size_t)V_lds + v_rd_base(lane);
    const int qlo = u.q0 + wid * 32, qj = qlo + r32;
#define ST_LOAD(t) do { const int k0_ = (t) * 64; _Pragma("unroll") for (int i_ = 0; i_ < G::NKST; ++i_) { const int cid_ = tid + 512 * i_, row_ = cid_ / G::NCH, ch_ = cid_ % G::NCH; \
            stk[i_] = *(const bf16x8*)(u.K + (size_t)(k0_ + row_) * u.kpitch + ch_ * 8); } \
        stv0 = *(const bf16x8*)(u.V + (size_t)(k0_ + sr) * u.vpitch + sc); stv1 = *(const bf16x8*)(u.V + (size_t)(k0_ + 32 + sr) * u.vpitch + sc); } while (0)
#define ST_WRITE(bf) do { _Pragma("unroll") for (int i_ = 0; i_ < G::NKST; ++i_) { const int cid_ = tid + 512 * i_, row_ = cid_ / G::NCH, ch_ = cid_ % G::NCH; \
            *(LAS bf16x8*)(K_lds + (bf) * G::SHM_K + row_ * G::KP + ch_ * 16) = stk[i_]; } \
        *(LAS bf16x8*)(V_lds + (bf) * SHM_V + vst0) = stv0; *(LAS bf16x8*)(V_lds + (bf) * SHM_V + vst1) = stv1; } while (0)
    ST_LOAD(u.j_lo);
    for (int t = u.j_lo; t < u.j_hi; ++t) {
        const int buf = (t - u.j_lo) & 1;
        VM_WAIT(); ST_WRITE(buf);
        __syncthreads();
        if (t + 1 < u.j_hi) ST_LOAD(t + 1);
        f32x16 p0 = {}, p1 = {};
        { const LAS unsigned char* kb = K_lds + buf * G::SHM_K + r32 * G::KP + hi * 16;
#pragma unroll
          for (int d0 = 0; d0 < DQK / 16; ++d0) { const bf16x8 b0 = *(const LAS bf16x8*)(kb + d0 * 32), b1 = *(const LAS bf16x8*)(kb + 32 * G::KP + d0 * 32);
              p0 = __builtin_amdgcn_mfma_f32_32x32x16_bf16(b0, qr[d0], p0, 0, 0, 0);
              p1 = __builtin_amdgcn_mfma_f32_32x32x16_bf16(b1, qr[d0], p1, 0, 0, 0); } }
        const float NEG = -__builtin_inff(); const int kb0 = t * 64;
        if (MODE == 0) {
            if (kb0 + 63 > qlo) {
#pragma unroll
                for (int r = 0; r < 16; ++r) { const int key = kb0 + (r & 3) + 8 * (r >> 2) + 4 * hi; if (key > qj) p0[r] = NEG; if (key + 32 > qj) p1[r] = NEG; } }
        } else {
#pragma unroll
            for (int r = 0; r < 16; ++r) { const int dist = qj - (kb0 + (r & 3) + 8 * (r >> 2) + 4 * hi), dist2 = dist - 32;
                p0[r] = ((unsigned)dist <= 128u) ? p0[r] - u.bias_c * (float)dist : NEG;
                p1[r] = ((unsigned)dist2 <= 128u) ? p1[r] - u.bias_c * (float)dist2 : NEG; }
        }
        float pmax = p0[0];
#pragma unroll
        for (int r = 1; r < 16; ++r) pmax = fmaxf(pmax, p0[r]);
#pragma unroll
        for (int r = 0; r < 16; ++r) pmax = fmaxf(pmax, p1[r]);
        { auto rr = __builtin_amdgcn_permlane32_swap(__float_as_uint(pmax), __float_as_uint(pmax), false, false); pmax = fmaxf(__uint_as_float(rr[0]), __uint_as_float(rr[1])); }
        const float mn = fmaxf(m_reg, pmax); const float alpha = __builtin_amdgcn_exp2f(m_reg - mn); m_reg = mn;
#pragma unroll
        for (int r = 0; r < 16; ++r) { p0[r] = __builtin_amdgcn_exp2f(p0[r] - mn); p1[r] = __builtin_amdgcn_exp2f(p1[r] - mn); }
        float ps = 0.f;
#pragma unroll
        for (int r = 0; r < 16; ++r) ps += p0[r] + p1[r];
        { auto rr = __builtin_amdgcn_permlane32_swap(__float_as_uint(ps), __float_as_uint(ps), false, false); ps = __uint_as_float(rr[0]) + __uint_as_float(rr[1]); }
        l_reg = l_reg * alpha + ps;
        bf16x8 pa0, pa1, pa2, pa3;
#define PK4(P, B_, OUT) do { unsigned a0 = cvtpk(P[B_ + 0], P[B_ + 1]), a1 = cvtpk(P[B_ + 2], P[B_ + 3]); unsigned b0 = cvtpk(P[B_ + 4], P[B_ + 5]), b1 = cvtpk(P[B_ + 6], P[B_ + 7]); \
        auto r0 = __builtin_amdgcn_permlane32_swap(a0, b0, false, false); auto r1 = __builtin_amdgcn_permlane32_swap(a1, b1, false, false); \
        u32x4 w = {r0[0], r1[0], r0[1], r1[1]}; OUT = *reinterpret_cast<bf16x8*>(&w); } while (0)
        PK4(p0, 0, pa0); PK4(p0, 8, pa1); PK4(p1, 0, pa2); PK4(p1, 8, pa3);
#undef PK4
        if (__any(alpha < 1.f)) { if (hi == 0) al_l[r32] = alpha; LDS_WAIT();
#pragma unroll
            for (int r = 0; r < 16; ++r) { const float a = al_l[(r & 3) + 8 * (r >> 2) + 4 * hi];
#pragma unroll
                for (int d = 0; d < 4; ++d) o[d][r] *= a; } }
        pv_tile(o, vb0 + buf * SHM_V, pa0, pa1, pa2, pa3);
    }
    if (hi == 0) li_l[r32] = l_reg; LDS_WAIT();
    float rli[16];
#pragma unroll
    for (int r = 0; r < 16; ++r) rli[r] = __builtin_amdgcn_rcpf(li_l[(r & 3) + 8 * (r >> 2) + 4 * hi]);
    bf16_t* Ow = u.O + (size_t)(wid * 32) * u.opitch;
#pragma unroll
    for (int r = 0; r < 16; ++r) { const int orow = (r & 3) + 8 * (r >> 2) + 4 * hi;
#pragma unroll
        for (int d0 = 0; d0 < 4; ++d0) { const float v = o[d0][r] * rli[r]; const float vn = __shfl_xor(v, 1);
            if ((r32 & 1) == 0) *(unsigned*)(Ow + (size_t)orow * u.opitch + d0 * 32 + r32) = cvtpk(v, vn); } }
    if (MODE == 1) { if (hi == 0) u.lse[(size_t)(wid * 32 + r32) * u.lsepitch] = (m_reg + __log2f(l_reg)) * LN2; }
    __syncthreads();
#undef ST_LOAD
#undef ST_WRITE
}
}

constexpr size_t al256(size_t x) { return (x + 255) & ~(size_t)255; }
constexpr size_t WS_CTL = 0, CTL_BYTES = 1u << 20;
constexpr size_t WS_ROPE = WS_CTL + CTL_BYTES;
constexpr size_t WS_SSQ = WS_ROPE + al256((size_t)MTOK * 64 * 4);
constexpr size_t WS_XB = WS_SSQ + al256((size_t)MTOK * 32 * 4);
constexpr size_t WS_W = WS_XB + al256((size_t)MTOK * DM * 2);
constexpr size_t W_GU1 = 0, W_D1 = W_GU1 + (size_t)NGU * DM, W_IN = W_D1 + (size_t)DM * FF, W_UQ = W_IN + (size_t)NIN * DM, W_UKV = W_UQ + (size_t)1280 * 512,
                 W_A = W_UKV + (size_t)1536 * 256, W_B = W_A + (size_t)DM * 768, W_C = W_B + (size_t)DM * 512, W_OUT = W_C + (size_t)DM * 256, W_GU2 = W_OUT + (size_t)DM * DM,
                 W_D2 = W_GU2 + (size_t)NGU * DM, W_END = W_D2 + (size_t)DM * FF;
constexpr size_t WS_R1 = WS_W + al256(W_END * 2);
constexpr size_t WS_R2 = WS_R1 + al256((size_t)MTOK * U2W * 2);
constexpr size_t WS_QKV = WS_R2 + al256((size_t)MTOK * U1W * 2);
constexpr size_t QKV_Q = 0, QKV_K = (size_t)NB * 6 * SEQ * 192 * 2, QKV_V = 2 * QKV_K, QKV_END = QKV_V + (size_t)NB * 6 * SEQ * 128 * 2;
constexpr size_t WS_R3 = WS_QKV + al256(QKV_END);
constexpr size_t R3_QRAW = 0, R3_KVRAW = (size_t)MTOK * QRAW_LD * 4, R3_END = R3_KVRAW + (size_t)MTOK * KVRAW_LD * 4;
constexpr size_t R3_YA = 0, R3_YB = R3_YA + (size_t)MTOK * 768 * 2, R3_YC = R3_YB + (size_t)MTOK * 512 * 2, R3_DO = R3_YC + (size_t)MTOK * 256 * 2, R3_LSE = R3_DO + (size_t)MTOK * 768 * 2;
static_assert(R3_LSE + (size_t)MTOK * 6 * 4 <= R3_END, "R3 overlay");
constexpr size_t WS_GLA = WS_R3 + al256(R3_END);
constexpr size_t GLA_DS = 0, GLA_BC = (size_t)2048 * 8192 * 4, GLA_DEC = GLA_BC + (size_t)MTOK * 256 * 4, GLA_END = GLA_DEC + (size_t)2048 * 64 * 4;
constexpr size_t WS_END = WS_GLA + al256(GLA_END);
constexpr int CW_BAR = 1024;
constexpr int CW_QUEUE = 16384;

constexpr int RING_BYTES = 131072, LDSCTL_OFF = RING_BYTES, LDS_BYTES = 147456;
constexpr int NWAVES = 8, NTHR = 512;

#define XB_TMO      128
#define XB_XCNT(j)  (256  + 64 * (j))
#define XB_XSUB(j)  (1280 + 64 * (j))
#define XB_XGEN(j)  (2304 + 64 * (j))
#define XB_TOP      3328
#define XB_TOPGEN   3392
#define XCD_BAR_WORDS 3456
#define XB_SPIN_CAP (1u << 20)
__device__ __forceinline__ unsigned xb_ld(unsigned* p)              { return __hip_atomic_load(p, __ATOMIC_RELAXED, __HIP_MEMORY_SCOPE_AGENT); }
__device__ __forceinline__ unsigned xb_add(unsigned* p, unsigned v) { return __hip_atomic_fetch_add(p, v, __ATOMIC_RELAXED, __HIP_MEMORY_SCOPE_AGENT); }
__device__ __forceinline__ unsigned xb_xcc_id() { return (unsigned)__builtin_amdgcn_s_getreg((3 << 11) | 20) & 0xFu; }
#define XB_SPIN(cond, bar) do { unsigned _sp = 0; while (cond) { __builtin_amdgcn_s_sleep(1); \
    if ((++_sp & 255u) == 0u) { if (xb_ld(&(bar)[XB_TMO])) break; if (_sp > XB_SPIN_CAP) { atomicAdd(&(bar)[XB_TMO], 1u); break; } } } } while (0)
struct XcdBarrier { unsigned* bar; unsigned x; volatile LAS unsigned* st; int wv; };
__device__ __forceinline__ bool xb_thread0(int wv) { return wv == 0 && lane_id_v() == 0; }
__device__ __forceinline__ XcdBarrier xcd_barrier_post(unsigned* bar, volatile LAS unsigned* st, int wv) {
    XcdBarrier b; b.bar = bar; b.x = xb_xcc_id(); b.st = st; b.wv = wv;
    if (xb_thread0(wv)) (void)xb_add(&bar[XB_XCNT(b.x)], 1u);
    return b;
}
__device__ __forceinline__ void xcd_barrier_complete(unsigned* bar, unsigned x, unsigned& nloc, unsigned& nx) {
    const unsigned G = gridDim.x * gridDim.y * gridDim.z;
    unsigned sum, cnt, mine, sp = 0u;
    for (;;) {
        sum = 0u; cnt = 0u; mine = 0u;
#pragma unroll
        for (unsigned j = 0; j < 16; ++j) { const unsigned c = xb_ld(&bar[XB_XCNT(j)]); sum += c; cnt += (c > 0u) ? 1u : 0u; mine = (j == x) ? c : mine; }
        if (sum == G) break;
        __builtin_amdgcn_s_sleep(1);
        if ((++sp & 255u) == 0u) { if (xb_ld(&bar[XB_TMO])) break; if (sp > XB_SPIN_CAP) { atomicAdd(&bar[XB_TMO], 1u); break; } }
    }
    nloc = mine > 0u ? mine : 1u; nx = cnt > 0u ? cnt : 1u;
}
__device__ __forceinline__ void xcd_barrier(const XcdBarrier& b) {
    asm volatile("s_waitcnt vmcnt(0)" ::: "memory");
    __syncthreads();
    if (xb_thread0(b.wv)) {
        unsigned* bar = b.bar;
        __builtin_amdgcn_s_waitcnt(0);
        unsigned nloc = b.st[0], nx = b.st[1];
        if (nloc == 0u) { xcd_barrier_complete(bar, b.x, nloc, nx); b.st[0] = nloc; b.st[1] = nx; }
        const unsigned old = xb_add(&bar[XB_XSUB(b.x)], 1u);
        const unsigned gen = old / nloc;
        if (old + 1u == (gen + 1u) * nloc) {
            __builtin_amdgcn_fence(__ATOMIC_RELEASE, "agent");
            asm volatile("s_waitcnt vmcnt(0)" ::: "memory");
            const unsigned og = xb_add(&bar[XB_TOP], 1u);
            const unsigned tg = og / nx;
            if (og + 1u == (tg + 1u) * nx) xb_add(&bar[XB_TOPGEN], 1u);
            else XB_SPIN(xb_ld(&bar[XB_TOPGEN]) == tg, bar);
            __builtin_amdgcn_fence(__ATOMIC_ACQUIRE, "agent");
            xb_add(&bar[XB_XGEN(b.x)], 1u);
            asm volatile("s_waitcnt vmcnt(0)" ::: "memory");
        } else {
            XB_SPIN(xb_ld(&bar[XB_XGEN(b.x)]) == gen, bar);
            __builtin_amdgcn_fence(__ATOMIC_ACQUIRE, "agent");
            asm volatile("s_waitcnt vmcnt(0)" ::: "memory");
        }
    }
    __syncthreads();
}

struct Args { const float* in[27]; float* out; unsigned char* ws; int ph_lo, ph_hi; };
struct Ctx { unsigned char* ws; volatile LAS unsigned long long* ptab;
    __device__ __forceinline__ const float* in(int i) const { const unsigned long long v = ptab[i];
        const unsigned lo = __builtin_amdgcn_readfirstlane((unsigned)v), hi = __builtin_amdgcn_readfirstlane((unsigned)(v >> 32)); return (const float*)(((unsigned long long)hi << 32) | lo); } };
enum { I_X = 0, I_POS, I_F1N, I_F1G, I_F1U, I_F1D, I_MIXN, I_WIN, I_CQN, I_CKVN, I_WUQ, I_WUKV, I_QN, I_KN, I_WG2, I_BG2, I_ON, I_DQN, I_DKN, I_WA, I_WB, I_WC, I_WOUT, I_F2N, I_F2G, I_F2U, I_F2D };

__device__ __forceinline__ int win_map(int n) {
    if (n < 768) return n;
    if (n < 1024) return 832 + (n - 768);
    if (n < 1280) return 1088 + (n - 1024);
    if (n < 1792) return 1344 + (n - 1280);
    if (n < 2560) return 2384 + (n - 1792);
    if (n < 3328) return 3152 + (n - 2560);
    if (n < 4096) return 3920 + (n - 3328);
    if (n < 4160) return 768 + (n - 4096);
    if (n < 4176) return 1856 + (n - 4160);
    if (n < 4352) return -1;
    if (n < 4864) return 1872 + (n - 4352);
    return 4688 + (n - 4864);
}
struct WMat { const float* src; const float* src2; const float* gain; bf16_t* dst; int K, Nsrc, Ndst, kind; };
__device__ __forceinline__ void wconv_item(const WMat& w, int item, LAS float* scr, int lane) {
    const int nblk = w.Ndst / 32, kb = item / nblk, nb = item % nblk, k0 = 64 * kb, n0 = 32 * nb;
    const int nn = n0 + (lane & 31);
    const float* sp = w.src; int scol = nn; bool valid = true;
    if (w.kind == 1) { const int tile = nn >> 8; int wi = nn & 255; if (wi >= 128) { sp = w.src2; wi -= 128; } scol = tile * 128 + wi; }
    else if (w.kind == 2) { scol = win_map(nn); valid = scol >= 0; }
    else valid = nn < w.Nsrc;
    if (!valid) scol = 0;
#pragma unroll 8
    for (int i = 0; i < 32; ++i) { const int kk = 2 * i + (lane >> 5); float v = sp[(size_t)(k0 + kk) * w.Nsrc + scol]; if (w.gain) v *= w.gain[k0 + kk]; scr[kk * 33 + (lane & 31)] = valid ? v : 0.f; }
    LDS_WAIT(); asm volatile("" ::: "memory");
    const int c = lane & 7;
#pragma unroll
    for (int j = 0; j < 4; ++j) { const int n = (lane >> 3) + 8 * j; const LAS float* s = scr + (8 * c) * 33 + n;
        u32x4 o; o.x = pk2(s[0 * 33], s[1 * 33]); o.y = pk2(s[2 * 33], s[3 * 33]); o.z = pk2(s[4 * 33], s[5 * 33]); o.w = pk2(s[6 * 33], s[7 * 33]);
        *(u32x4*)(w.dst + (size_t)(n0 + n) * w.K + k0 + 8 * c) = o; }
    LDS_WAIT(); asm volatile("" ::: "memory");
}
constexpr int wc_items(int K, int Ndst) { return (K / 64) * (Ndst / 32); }
constexpr int WI_GU = wc_items(DM, NGU), WI_D = wc_items(FF, DM), WI_IN = wc_items(DM, NIN), WI_UQ = wc_items(512, 1280), WI_UKV = wc_items(256, 1536),
              WI_A = wc_items(768, DM), WI_B = wc_items(512, DM), WI_C = wc_items(256, DM), WI_OUT = wc_items(DM, DM);
constexpr int WI_TOTAL = 2 * WI_GU + 2 * WI_D + WI_IN + WI_UQ + WI_UKV + WI_A + WI_B + WI_C + WI_OUT;

__device__ __forceinline__ void phase_wconv(const Ctx& a, int l, LAS unsigned char* lds, int gw, int NGW, int wave, int lane) {
    LAS float* scr = (LAS float*)(lds + wave * 16384);
    bf16_t* W = (bf16_t*)(a.ws + WS_W);
    const size_t oFF = (size_t)l * DM * FF;
    for (int it = gw; it < WI_TOTAL; it += NGW) {
        int r = it; WMat w;
        if (r < WI_GU) { w = WMat{a.in(I_F1G) + oFF, a.in(I_F1U) + oFF, a.in(I_F1N) + (size_t)l * DM, W + W_GU1, DM, FF, NGU, 1}; }
        else if ((r -= WI_GU) < WI_GU) { w = WMat{a.in(I_F2G) + oFF, a.in(I_F2U) + oFF, a.in(I_F2N) + (size_t)l * DM, W + W_GU2, DM, FF, NGU, 1}; }
        else if ((r -= WI_GU) < WI_IN) { w = WMat{a.in(I_WIN) + (size_t)l * DM * 10832, nullptr, a.in(I_MIXN) + (size_t)l * DM, W + W_IN, DM, 10832, NIN, 2}; }
        else if ((r -= WI_IN) < WI_D) { w = WMat{a.in(I_F1D) + oFF, nullptr, nullptr, W + W_D1, FF, DM, DM, 0}; }
        else if ((r -= WI_D) < WI_D) { w = WMat{a.in(I_F2D) + oFF, nullptr, nullptr, W + W_D2, FF, DM, DM, 0}; }
        else if ((r -= WI_D) < WI_OUT) { w = WMat{a.in(I_WOUT) + (size_t)l * DM * DM, nullptr, nullptr, W + W_OUT, DM, DM, DM, 0}; }
        else if ((r -= WI_OUT) < WI_A) { w = WMat{a.in(I_WA) + (size_t)l * 768 * DM, nullptr, nullptr, W + W_A, 768, DM, DM, 0}; }
        else if ((r -= WI_A) < WI_B) { w = WMat{a.in(I_WB) + (size_t)l * 512 * DM, nullptr, nullptr, W + W_B, 512, DM, DM, 0}; }
        else if ((r -= WI_B) < WI_C) { w = WMat{a.in(I_WC) + (size_t)l * 256 * DM, nullptr, nullptr, W + W_C, 256, DM, DM, 0}; }
        else if ((r -= WI_C) < WI_UQ) { w = WMat{a.in(I_WUQ) + (size_t)l * 512 * 1152, nullptr, a.in(I_CQN) + (size_t)l * 512, W + W_UQ, 512, 1152, 1280, 0}; }
        else { r -= WI_UQ; w = WMat{a.in(I_WUKV) + (size_t)l * 256 * 1536, nullptr, a.in(I_CKVN) + (size_t)l * 256, W + W_UKV, 256, 1536, 1536, 0}; }
        wconv_item(w, r, scr, lane);
    }
}

__device__ __forceinline__ void phase_prologue(const Ctx& a, int gw, int NGW, int lane) {
    const int* pos = (const int*)a.in(I_POS);
    float* ropec = (float*)(a.ws + WS_ROPE); float* ropes = ropec + (size_t)MTOK * 32;
    const int i = lane & 31; const float invf = exp2f(-(float)i * 0.41524101186092029f);
    for (int p = gw; p < MTOK / 2; p += NGW) { const int tok = 2 * p + (lane >> 5); const float ang = (float)pos[tok] * invf; float sn, cs; sincosf(ang, &sn, &cs);
        ropec[(size_t)tok * 32 + i] = cs; ropes[(size_t)tok * 32 + i] = sn; }
    const float* x = a.in(I_X); bf16_t* xb = (bf16_t*)(a.ws + WS_XB); float* ssq = (float*)(a.ws + WS_SSQ);
    for (int m = gw; m < MTOK; m += NGW) { const f32x4* xr = (const f32x4*)(x + (size_t)m * DM) + lane; u32x2* o8 = (u32x2*)(xb + (size_t)m * DM) + lane; float s = 0.f;
#pragma unroll
        for (int j = 0; j < 8; ++j) { const f32x4 v = xr[64 * j]; s += (v[0] * v[0] + v[1] * v[1]) + (v[2] * v[2] + v[3] * v[3]); u32x2 w; w.x = pk2(v[0], v[1]); w.y = pk2(v[2], v[3]); o8[64 * j] = w; }
        s += __shfl_xor(s, 1); if ((lane & 1) == 0) ssq[(size_t)m * 32 + (lane >> 1)] = s; }
}

__device__ __forceinline__ void phase_prep(const Ctx& a, int l, int gw, int NGW, int lane) {
    bf16_t* u1 = (bf16_t*)(a.ws + WS_R2);
    const float* qraw = (const float*)(a.ws + WS_R3 + R3_QRAW); const float* kvraw = (const float*)(a.ws + WS_R3 + R3_KVRAW);
    const float* ropec = (const float*)(a.ws + WS_ROPE); const float* ropes = ropec + (size_t)MTOK * 32;
    bf16_t* Qo = (bf16_t*)(a.ws + WS_QKV + QKV_Q); bf16_t* Ko = (bf16_t*)(a.ws + WS_QKV + QKV_K); bf16_t* Vo = (bf16_t*)(a.ws + WS_QKV + QKV_V);
    const float* gq = a.in(I_QN) + (size_t)l * 192; const float* gk = a.in(I_KN) + (size_t)l * 192;
    const float gq0 = gq[lane], gq1 = gq[64 + lane], gq2 = gq[128 + lane], gk0 = gk[lane], gk1 = gk[64 + lane], gk2 = gk[128 + lane];
    const float* dq = a.in(I_DQN) + (size_t)l * 128; const float* dk = a.in(I_DKN) + (size_t)l * 128;
    const float dq0 = dq[2 * lane], dq1 = dq[2 * lane + 1], dk0 = dk[2 * lane], dk1 = dk[2 * lane + 1];
    for (int row = gw; row < MTOK; row += NGW) {
        bf16_t* ur = u1 + (size_t)row * U1W; const int b = row / SEQ, s = row % SEQ;
        float rstd_cq, rstd_ckv;
        { const bf16x8 v = *(const bf16x8*)(ur + C_CQ + lane * 8); float q = 0.f;
#pragma unroll
          for (int j = 0; j < 8; ++j) { const float f = bf2f((bf16_t)v[j]); q += f * f; }
          rstd_cq = rsqrtf(wave_sum(q) * (1.f / 512.f) + EPS); }
        { const s16x4 v = *(const s16x4*)(ur + C_CKV + lane * 4); float q = 0.f;
#pragma unroll
          for (int j = 0; j < 4; ++j) { const float f = bf2f((bf16_t)v[j]); q += f * f; }
          rstd_ckv = rsqrtf(wave_sum(q) * (1.f / 256.f) + EPS); }
        const float kr = bf2f(ur[C_KROPE + lane]); const float ssq_kr = wave_sum(kr * kr);
        const float cs = ropec[(size_t)row * 32 + (lane & 31)], sn = ropes[(size_t)row * 32 + (lane & 31)];
#pragma unroll 2
        for (int h = 0; h < 6; ++h) {
            const float* qp = qraw + (size_t)row * QRAW_LD + h * 192;
            float x0 = qp[lane] * rstd_cq, x1 = qp[64 + lane] * rstd_cq, x2 = qp[128 + lane] * rstd_cq;
            const float rq = rsqrtf(wave_sum(x0 * x0 + x1 * x1 + x2 * x2) * (1.f / 192.f) + EPS);
            x0 *= rq * gq0; x1 *= rq * gq1; x2 *= rq * gq2;
            const float xp = __shfl_xor(x2, 32); const float xr = lane < 32 ? x2 * cs - xp * sn : xp * sn + x2 * cs;
            bf16_t* qo = Qo + ((size_t)((b * 6 + h) * SEQ + s)) * 192;
            qo[lane] = (bf16_t)f2bf(x0 * QS_MLA); qo[64 + lane] = (bf16_t)f2bf(x1 * QS_MLA); qo[128 + lane] = (bf16_t)f2bf(xr * QS_MLA);
            const float* kp = kvraw + (size_t)row * KVRAW_LD + h * 256;
            float k0 = kp[lane] * rstd_ckv, k1 = kp[64 + lane] * rstd_ckv; const float v0 = kp[128 + lane] * rstd_ckv, v1 = kp[192 + lane] * rstd_ckv;
            const float rk = rsqrtf((wave_sum(k0 * k0 + k1 * k1) + ssq_kr) * (1.f / 192.f) + EPS);
            k0 *= rk * gk0; k1 *= rk * gk1; const float k2 = kr * rk * gk2;
            const float kx = __shfl_xor(k2, 32); const float kro = lane < 32 ? k2 * cs - kx * sn : kx * sn + k2 * cs;
            bf16_t* ko = Ko + ((size_t)((b * 6 + h) * SEQ + s)) * 192;
            ko[lane] = (bf16_t)f2bf(k0); ko[64 + lane] = (bf16_t)f2bf(k1); ko[128 + lane] = (bf16_t)f2bf(kro);
            bf16_t* vo = Vo + ((size_t)((b * 6 + h) * SEQ + s)) * 128;
            vo[lane] = (bf16_t)f2bf(v0); vo[64 + lane] = (bf16_t)f2bf(v1);
        }
#pragma unroll 2
        for (int h = 0; h < 6; ++h) {
            unsigned* qp = (unsigned*)(ur + C_QC + h * 128) + lane; unsigned* kp = (unsigned*)(ur + C_KC + h * 128) + lane;
            const unsigned qw = *qp, kw = *kp;
            float q0 = __uint_as_float(qw << 16), q1 = __uint_as_float(qw & 0xffff0000u), k0 = __uint_as_float(kw << 16), k1 = __uint_as_float(kw & 0xffff0000u);
            const float rq = rsqrtf(wave_sum(q0 * q0 + q1 * q1) * (1.f / 128.f) + EPS) * QS_DSWA, rk = rsqrtf(wave_sum(k0 * k0 + k1 * k1) * (1.f / 128.f) + EPS);
            *qp = pk2(q0 * rq * dq0, q1 * rq * dq1); *kp = pk2(k0 * rk * dk0, k1 * rk * dk1);
        }
    }
}

__device__ __forceinline__ float logsigmoidf_(float z) { return fminf(z, 0.f) - log1pf(expf(-fabsf(z))); }
__device__ __forceinline__ int crow32(int r, int hi) { return (r & 3) + 8 * (r >> 2) + 4 * hi; }
__device__ __forceinline__ void gla_local(const Ctx& a, int l, LAS unsigned char* lds, int G, int bid, const int wv) {
    int tid_ = wv * 64 + lane_id_v(); asm volatile("" : "+v"(tid_));
    const int tid = tid_, wid = __builtin_amdgcn_readfirstlane(tid >> 6), lane = tid & 63, l32 = lane & 31, hi = lane >> 5;
    LAS float* kd = (LAS float*)lds; LAS float* vv = (LAS float*)(lds + 16640); LAS float* tot = (LAS float*)(lds + 16640 + 32768);
    const bf16_t* u1 = (const bf16_t*)(a.ws + WS_R2);
    float* dS = (float*)(a.ws + WS_GLA + GLA_DS); float* bcum = (float*)(a.ws + WS_GLA + GLA_BC); float* dec = (float*)(a.ws + WS_GLA + GLA_DEC);
    const float* w2 = a.in(I_WG2) + (size_t)l * 16 * 256; const float* b2 = a.in(I_BG2) + (size_t)l * 256;
    const int d = lane, tg = wid;
    for (int ci = bid; ci < 2048; ci += G) {
        const int bh = ci >> 8, c = ci & 255, b = bh >> 2, h = bh & 3, row0 = b * SEQ + 64 * c;
        float w2c[16];
#pragma unroll
        for (int j = 0; j < 16; ++j) w2c[j] = w2[j * 256 + h * 64 + d];
        const float bias = b2[h * 64 + d];
        float bcv[8]; float run = 0.f;
#pragma unroll
        for (int i = 0; i < 8; ++i) { const int t = tg * 8 + i; const bf16_t* gl = u1 + (size_t)(row0 + t) * U1W + C_GLR;
            const bf16x8 g0 = *(const bf16x8*)gl, g1 = *(const bf16x8*)(gl + 8); float z = bias;
#pragma unroll
            for (int j = 0; j < 8; ++j) { z += bf2f((bf16_t)g0[j]) * w2c[j]; z += bf2f((bf16_t)g1[j]) * w2c[8 + j]; }
            run += logsigmoidf_(z) * (1.f / 16.f); bcv[i] = run; }
        tot[tg * 64 + d] = run;
        { const int t = tid >> 3, c0 = (tid & 7) * 16; const bf16_t* vp = u1 + (size_t)(row0 + t) * U1W + C_VB + h * 128 + c0;
          const bf16x8 v0 = *(const bf16x8*)vp, v1 = *(const bf16x8*)(vp + 8);
#pragma unroll
          for (int j = 0; j < 8; ++j) { vv[t * 128 + c0 + j] = bf2f((bf16_t)v0[j]); vv[t * 128 + c0 + 8 + j] = bf2f((bf16_t)v1[j]); } }
        __syncthreads();
        float off = 0.f, bend = 0.f;
#pragma unroll
        for (int g = 0; g < 8; ++g) { const float x = tot[g * 64 + d]; bend += x; if (g < tg) off += x; }
#pragma unroll
        for (int i = 0; i < 8; ++i) { const int t = tg * 8 + i; const float bc = bcv[i] + off;
            bcum[(size_t)(row0 + t) * 256 + h * 64 + d] = bc;
            const float kk = bf2f(u1[(size_t)(row0 + t) * U1W + C_KB + h * 64 + d]);
            kd[t * 65 + d] = kk * expf(bend - bc); }
        if (tg == 0) dec[(size_t)ci * 64 + d] = expf(bend);
        __syncthreads();
        { const int di = wid >> 2, ei = wid & 3; f32x16 acc = {};
#pragma unroll 8
          for (int s0 = 0; s0 < 64; s0 += 2) { const float av = kd[(s0 + hi) * 65 + 32 * di + l32], bv = vv[(s0 + hi) * 128 + 32 * ei + l32];
              acc = __builtin_amdgcn_mfma_f32_32x32x2f32(av, bv, acc, 0, 0, 0); }
          float* dst = dS + (size_t)ci * 8192;
#pragma unroll
          for (int r = 0; r < 16; ++r) dst[(32 * di + crow32(r, hi)) * 128 + 32 * ei + l32] = acc[r]; }
        __syncthreads();
    }
}
__device__ __forceinline__ void gla_scan(const Ctx& a, int bid, const int wv) {
    float* dS = (float*)(a.ws + WS_GLA + GLA_DS); const float* dec = (const float*)(a.ws + WS_GLA + GLA_DEC);
    int tid_ = wv * 64 + lane_id_v(); asm volatile("" : "+v"(tid_));
    const int gid = bid * NTHR + tid_, bh = gid >> 13, de = gid & 8191, d = de >> 7;
    float st = 0.f; float* p = dS + (size_t)bh * 256 * 8192 + de; const float* dc = dec + (size_t)bh * 256 * 64 + d;
    for (int c = 0; c < 256; c += 8) { float x[8], g[8];
#pragma unroll
        for (int i = 0; i < 8; ++i) { x[i] = p[(size_t)(c + i) * 8192]; g[i] = dc[(c + i) * 64]; }
#pragma unroll
        for (int i = 0; i < 8; ++i) { p[(size_t)(c + i) * 8192] = st; st = g[i] * st + x[i]; } }
}
__device__ __forceinline__ void gla_out(const Ctx& a, int l, LAS unsigned char* lds, int G, int bid, const int wv) {
    int tid_ = wv * 64 + lane_id_v(); asm volatile("" : "+v"(tid_));
    const int tid = tid_, wid = __builtin_amdgcn_readfirstlane(tid >> 6), lane = tid & 63, l32 = lane & 31, hi = lane >> 5;
    LAS float* qe = (LAS float*)lds; LAS float* ke = (LAS float*)(lds + 16640); LAS float* At = (LAS float*)(lds + 33280);
    LAS float* vv = (LAS float*)(lds + 49920); LAS float* Sp = (LAS float*)(lds + 82688);
    const bf16_t* u1 = (const bf16_t*)(a.ws + WS_R2);
    const float* dS = (const float*)(a.ws + WS_GLA + GLA_DS); const float* bcum = (const float*)(a.ws + WS_GLA + GLA_BC);
    bf16_t* yb = (bf16_t*)(a.ws + WS_R3 + R3_YB); const float* go = a.in(I_ON) + (size_t)l * 128;
    for (int ci = bid; ci < 2048; ci += G) {
        const int bh = ci >> 8, c = ci & 255, b = bh >> 2, h = bh & 3, row0 = b * SEQ + 64 * c;
        { const int d = lane, tg = wid;
#pragma unroll
          for (int i = 0; i < 8; ++i) { const int t = tg * 8 + i; const float bc = bcum[(size_t)(row0 + t) * 256 + h * 64 + d];
              const float q = bf2f(u1[(size_t)(row0 + t) * U1W + C_QB + h * 64 + d]), k = bf2f(u1[(size_t)(row0 + t) * U1W + C_KB + h * 64 + d]);
              qe[t * 65 + d] = q * 0.125f * expf(bc); ke[t * 65 + d] = k * expf(-bc); } }
        { const int t = tid >> 3, c0 = (tid & 7) * 16; const bf16_t* vp = u1 + (size_t)(row0 + t) * U1W + C_VB + h * 128 + c0;
          const bf16x8 v0 = *(const bf16x8*)vp, v1 = *(const bf16x8*)(vp + 8);
#pragma unroll
          for (int j = 0; j < 8; ++j) { vv[t * 128 + c0 + j] = bf2f((bf16_t)v0[j]); vv[t * 128 + c0 + 8 + j] = bf2f((bf16_t)v1[j]); }
          const f32x4* sp = (const f32x4*)(dS + (size_t)ci * 8192) + tid * 4;
#pragma unroll
          for (int j = 0; j < 4; ++j) *(LAS f32x4*)(Sp + tid * 16 + j * 4) = sp[j]; }
        __syncthreads();
        if (wid < 4) {
            if (wid < 3) { const int ti = wid == 0 ? 0 : 1, si = wid == 2 ? 1 : 0; f32x16 acc = {};
#pragma unroll 8
                for (int d0 = 0; d0 < 64; d0 += 2) { const float av = qe[(32 * ti + l32) * 65 + d0 + hi], bv = ke[(32 * si + l32) * 65 + d0 + hi];
                    acc = __builtin_amdgcn_mfma_f32_32x32x2f32(av, bv, acc, 0, 0, 0); }
#pragma unroll
                for (int r = 0; r < 16; ++r) { const int t = 32 * ti + crow32(r, hi), s = 32 * si + l32; At[t * 65 + s] = (s <= t) ? acc[r] : 0.f; } }
            else {
#pragma unroll
                for (int r = 0; r < 16; ++r) At[crow32(r, hi) * 65 + 32 + l32] = 0.f; }
        }
        __syncthreads();
        f32x16 acc = {}; const int ti = wid >> 2, ei = wid & 3;
#pragma unroll 8
        for (int s0 = 0; s0 < 64; s0 += 2) { const float av = At[(32 * ti + l32) * 65 + s0 + hi], bv = vv[(s0 + hi) * 128 + 32 * ei + l32];
            acc = __builtin_amdgcn_mfma_f32_32x32x2f32(av, bv, acc, 0, 0, 0); }
#pragma unroll 8
        for (int d0 = 0; d0 < 64; d0 += 2) { const float av = qe[(32 * ti + l32) * 65 + d0 + hi], bv = Sp[(d0 + hi) * 128 + 32 * ei + l32];
            acc = __builtin_amdgcn_mfma_f32_32x32x2f32(av, bv, acc, 0, 0, 0); }
        __syncthreads();
#pragma unroll
        for (int r = 0; r < 16; ++r) Sp[(32 * ti + crow32(r, hi)) * 128 + 32 * ei + l32] = acc[r];
        __syncthreads();
        { const int t = tid >> 3, e0 = (tid & 7) * 16; float ov[16]; float ss = 0.f;
#pragma unroll
          for (int j = 0; j < 4; ++j) { const f32x4 x = *(const LAS f32x4*)(Sp + t * 128 + e0 + 4 * j); ov[4 * j] = x[0]; ov[4 * j + 1] = x[1]; ov[4 * j + 2] = x[2]; ov[4 * j + 3] = x[3];
              ss += (x[0] * x[0] + x[1] * x[1]) + (x[2] * x[2] + x[3] * x[3]); }
          ss += __shfl_xor(ss, 1); ss += __shfl_xor(ss, 2); ss += __shfl_xor(ss, 4);
          const float rs = rsqrtf(ss * (1.f / 128.f) + EPS);
          const bf16_t* rp = u1 + (size_t)(row0 + t) * U1W + C_RB + h * 128 + e0; const bf16x8 r0 = *(const bf16x8*)rp, r1 = *(const bf16x8*)(rp + 8);
          unsigned w[8];
#pragma unroll
          for (int j = 0; j < 4; ++j) { w[j] = pk2(ov[2 * j] * rs * go[e0 + 2 * j] * bf2f((bf16_t)r0[2 * j]), ov[2 * j + 1] * rs * go[e0 + 2 * j + 1] * bf2f((bf16_t)r0[2 * j + 1]));
              w[4 + j] = pk2(ov[8 + 2 * j] * rs * go[e0 + 8 + 2 * j] * bf2f((bf16_t)r1[2 * j]), ov[8 + 2 * j + 1] * rs * go[e0 + 8 + 2 * j + 1] * bf2f((bf16_t)r1[2 * j + 1])); }
          u32x4* yo = (u32x4*)(yb + (size_t)(row0 + t) * 512 + h * 128 + e0);
          yo[0] = (u32x4){w[0], w[1], w[2], w[3]}; yo[1] = (u32x4){w[4], w[5], w[6], w[7]}; }
        __syncthreads();
    }
}
__device__ __forceinline__ void dswa_combine(const Ctx& a, int gw, int NGW, int lane) {
    const bf16_t* dout = (const bf16_t*)(a.ws + WS_R3 + R3_DO); const float* lse = (const float*)(a.ws + WS_R3 + R3_LSE); bf16_t* yc = (bf16_t*)(a.ws + WS_R3 + R3_YC);
    const int hp = lane >> 5, e = 4 * (lane & 31);
    for (int row = gw; row < MTOK; row += NGW) {
        const float l0 = lse[(size_t)row * 6 + hp], l1 = lse[(size_t)row * 6 + 2 + hp], l2 = lse[(size_t)row * 6 + 4 + hp];
        const float mx = fmaxf(l0, fmaxf(l1, l2)); float w0 = expf(l0 - mx), w1 = expf(l1 - mx), w2 = expf(l2 - mx); const float inv = 1.f / (w0 + w1 + w2); w0 *= inv; w1 *= inv; w2 *= inv;
        const u32x2 a0 = *(const u32x2*)(dout + (size_t)row * 768 + hp * 128 + e), a1 = *(const u32x2*)(dout + (size_t)row * 768 + (2 + hp) * 128 + e), a2 = *(const u32x2*)(dout + (size_t)row * 768 + (4 + hp) * 128 + e);
        float o[4];
        o[0] = w0 * __uint_as_float(a0.x << 16) + w1 * __uint_as_float(a1.x << 16) + w2 * __uint_as_float(a2.x << 16);
        o[1] = w0 * __uint_as_float(a0.x & 0xffff0000u) + w1 * __uint_as_float(a1.x & 0xffff0000u) + w2 * __uint_as_float(a2.x & 0xffff0000u);
        o[2] = w0 * __uint_as_float(a0.y << 16) + w1 * __uint_as_float(a1.y << 16) + w2 * __uint_as_float(a2.y << 16);
        o[3] = w0 * __uint_as_float(a0.y & 0xffff0000u) + w1 * __uint_as_float(a1.y & 0xffff0000u) + w2 * __uint_as_float(a2.y & 0xffff0000u);
        u32x2 w; w.x = pk2(o[0], o[1]); w.y = pk2(o[2], o[3]); *(u32x2*)(yc + (size_t)row * 256 + hp * 128 + e) = w;
    }
}

constexpr int N_MLA_UNITS = 12 * 64, N_DSWA_UNITS = 12 * 64, N_ATT_UNITS = N_MLA_UNITS + N_DSWA_UNITS;
__device__ __forceinline__ void phase_attention(const Ctx& a, int l, LAS unsigned char* lds, volatile LAS unsigned* qword, const int wv) {
    const int tid0 = wv * 64 + lane_id_v();
    unsigned* head = (unsigned*)(a.ws + WS_CTL) + CW_QUEUE + 64 * l;
    const bf16_t* u1 = (const bf16_t*)(a.ws + WS_R2);
    for (;;) {
        if (tid0 == 0) *qword = __hip_atomic_fetch_add(head, 1u, __ATOMIC_RELAXED, __HIP_MEMORY_SCOPE_AGENT);
        __syncthreads();
        const int uid = (int)__builtin_amdgcn_readfirstlane(*qword);
        if (uid >= N_ATT_UNITS) break;
        att::AUnit u;
        if (uid < N_MLA_UNITS) {
            const int qb = 63 - uid / 12, bh = uid % 12, b = bh / 6, h = bh % 6;
            u.Q = (const bf16_t*)(a.ws + WS_QKV + QKV_Q) + ((size_t)bh * SEQ + 256 * qb) * 192; u.qpitch = 192;
            u.K = (const bf16_t*)(a.ws + WS_QKV + QKV_K) + (size_t)bh * SEQ * 192; u.kpitch = 192;
            u.V = (const bf16_t*)(a.ws + WS_QKV + QKV_V) + (size_t)bh * SEQ * 128; u.vpitch = 128;
            u.O = (bf16_t*)(a.ws + WS_R3 + R3_YA) + ((size_t)(b * SEQ + 256 * qb)) * 768 + h * 128; u.opitch = 768;
            u.lse = nullptr; u.lsepitch = 0; u.q0 = 256 * qb; u.j_lo = 0; u.j_hi = 4 * qb + 4; u.bias_c = 0.f;
            att::attn_unit<192, 0>(lds, u, wv);
        } else {
            const int v = uid - N_MLA_UNITS, b = v / 384, hh = (v / 64) % 6, idx = v % 64, g = hh >> 1, dil = g == 0 ? 1 : (g == 1 ? 4 : 16), nb = 64 / dil, r = idx / nb, qb = idx % nb;
            const size_t tok0 = (size_t)b * SEQ + r;
            u.Q = u1 + (tok0 + (size_t)256 * qb * dil) * U1W + C_QC + hh * 128; u.qpitch = (size_t)dil * U1W;
            u.K = u1 + tok0 * U1W + C_KC + hh * 128; u.kpitch = (size_t)dil * U1W;
            u.V = u1 + tok0 * U1W + C_VC + hh * 128; u.vpitch = (size_t)dil * U1W;
            u.O = (bf16_t*)(a.ws + WS_R3 + R3_DO) + (tok0 + (size_t)256 * qb * dil) * 768 + hh * 128; u.opitch = (size_t)dil * 768;
            u.lse = (float*)(a.ws + WS_R3 + R3_LSE) + (tok0 + (size_t)256 * qb * dil) * 6 + hh; u.lsepitch = (size_t)dil * 6;
            u.q0 = 256 * qb; u.j_lo = 4 * qb - 2 > 0 ? 4 * qb - 2 : 0; u.j_hi = 4 * qb + 4;
            u.bias_c = exp2f(-8.f * (float)(hh + 1) / 6.f) * (float)dil * LOG2E;
            att::attn_unit<128, 1>(lds, u, wv);
        }
    }
    __syncthreads();
}

constexpr int NPL = 12, NPH = 1 + NPL * DEPTH;
__global__ void __launch_bounds__(NTHR, 2) hybrid_fwd(Args args) {
    extern __shared__ __attribute__((aligned(16))) unsigned char lds_raw[];
    LAS unsigned char* lds = (LAS unsigned char*)lds_raw;
    const int tid = threadIdx.x;
    const int wv = __builtin_amdgcn_readfirstlane(tid >> 6);
    const int G = gridDim.x, bid = blockIdx.x, NGW = G * NWAVES;
#define LAUNDER() int tz_ = lane_id_v(); asm volatile("" : "+v"(tz_)); const int lane = tz_, wave = wv, gw = bid * NWAVES + wave
    volatile LAS unsigned* lctl = (volatile LAS unsigned*)(lds + LDSCTL_OFF);
    for (int u = tid; u < (LDS_BYTES - LDSCTL_OFF) / 4; u += NTHR) lctl[u] = 0u;
    __syncthreads();
    const int lo = args.ph_lo, hi = args.ph_hi;
    unsigned* ctl = (unsigned*)(args.ws + WS_CTL);
    XcdBarrier bar; bar.bar = ctl + CW_BAR; bar.x = 0; bar.st = lctl + 8; bar.wv = wv;
    if (hi - lo > 1) bar = xcd_barrier_post(ctl + CW_BAR, lctl + 8, wv);
#ifndef PH_MASK
#define PH_MASK 0xFFFF
#endif
#define IN(k) (lo <= (k) && (k) < hi)
#define EN(j) ((PH_MASK >> (j)) & 1)
#define SEAM(k) do { if (IN(k) && IN((k) + 1)) xcd_barrier(bar); } while (0)
    unsigned char* ws = args.ws;
    volatile LAS unsigned long long* ptab = (volatile LAS unsigned long long*)(lds + LDSCTL_OFF + 256);
    if (tid < 27) ptab[tid] = (unsigned long long)args.in[tid];
    __syncthreads();
    Ctx cx; cx.ws = ws; cx.ptab = ptab;
    bf16_t* W = (bf16_t*)(ws + WS_W);
    bf16_t* xb = (bf16_t*)(ws + WS_XB); float* ssq = (float*)(ws + WS_SSQ);
    bf16_t* h1 = (bf16_t*)(ws + WS_R1); bf16_t* u2 = (bf16_t*)(ws + WS_R1);
    bf16_t* u1 = (bf16_t*)(ws + WS_R2); float* m32 = (float*)(ws + WS_R2);
    bf16_t* mb = (bf16_t*)(ws + WS_QKV);
    float* qraw = (float*)(ws + WS_R3 + R3_QRAW); float* kvraw = (float*)(ws + WS_R3 + R3_KVRAW);
    bf16_t* ya = (bf16_t*)(ws + WS_R3 + R3_YA); bf16_t* yb = (bf16_t*)(ws + WS_R3 + R3_YB); bf16_t* yc = (bf16_t*)(ws + WS_R3 + R3_YC);
    float* xres = args.out;

    if (EN(12) && IN(0)) { LAUNDER(); phase_prologue(cx, gw, NGW, lane); phase_wconv(cx, 0, lds, gw, NGW, wave, lane); }
    SEAM(0);
    for (int l = 0; l < DEPTH; ++l) {
        const int pb = 1 + NPL * l;
        if (EN(0) && IN(pb + 0)) { LAUNDER(); if (l > 0) phase_wconv(cx, l, lds, gw, NGW, wave, lane); }
        SEAM(pb + 0);
        if (EN(1) && IN(pb + 1)) {
            pg8::Gemm g{xb, W + W_GU1, MTOK, NGU, DM, DM}; pg8::StaticOrder S; S.init(MTOK, NGU, G, bid);
            pg8::EpiSwiGLU E{ssq, h1, FF};
            pg8::gemm_phase<pg8::EpiSwiGLU, pg8::StaticOrder, true, true>(lds, g, S, E, wv);
        }
        SEAM(pb + 1);
        if (EN(2) && IN(pb + 2)) {
            pg8::Gemm g{h1, W + W_D1, MTOK, DM, FF, FF}; pg8::StaticOrder S; S.init(MTOK, DM, G, bid);
            pg8::EpiResid E{l == 0 ? cx.in(I_X) : (const float*)xres, xres, xb, ssq, 0.5f};
            pg8::gemm_phase<pg8::EpiResid, pg8::StaticOrder, true, true>(lds, g, S, E, wv);
        }
        SEAM(pb + 2);
        if (EN(3) && IN(pb + 3)) {
            pg8::Gemm g{xb, W + W_IN, MTOK, NIN, DM, DM}; pg8::StaticOrder S; S.init(MTOK, NIN, G, bid);
            pg8::EpiWin E{ssq, u1, u2, U1W, U2W};
            pg8::gemm_phase<pg8::EpiWin, pg8::StaticOrder, true, true>(lds, g, S, E, wv);
        }
        SEAM(pb + 3);
        if (EN(4) && IN(pb + 4)) {
            { pg8::Gemm g{u1 + C_CQ, W + W_UQ, MTOK, 1280, 512, U1W}; pg8::StaticOrder S; S.init(MTOK, 1280, G, bid);
              pg8::EpiF32 E{qraw, QRAW_LD};
              pg8::gemm_phase<pg8::EpiF32, pg8::StaticOrder, true, true>(lds, g, S, E, wv); }
            { pg8::Gemm g{u1 + C_CKV, W + W_UKV, MTOK, 1536, 256, U1W}; pg8::StaticOrder S; S.init(MTOK, 1536, G, bid);
              pg8::EpiF32 E{kvraw, KVRAW_LD};
              pg8::gemm_phase<pg8::EpiF32, pg8::StaticOrder, true, true>(lds, g, S, E, wv); }
        }
        SEAM(pb + 4);
        if (EN(5) && IN(pb + 5)) { LAUNDER(); phase_prep(cx, l, gw, NGW, lane); gla_local(cx, l, lds, G, bid, wv); }
        SEAM(pb + 5);
        if (EN(6) && IN(pb + 6)) { if (bid < 128) gla_scan(cx, bid, wv); phase_attention(cx, l, lds, lctl + 16, wv); }
        SEAM(pb + 6);
        if (EN(7) && IN(pb + 7)) { LAUNDER(); gla_out(cx, l, lds, G, bid, wv); dswa_combine(cx, gw, NGW, lane); }
        SEAM(pb + 7);
        if (EN(8) && IN(pb + 8)) {
            { pg8::Gemm g{ya, W + W_A, MTOK, DM, 768, 768}; pg8::StaticOrder S; S.init(MTOK, DM, G, bid);
              pg8::EpiMerge<0> E{u2, U2W, m32, mb};
              pg8::gemm_phase<pg8::EpiMerge<0>, pg8::StaticOrder, true, true>(lds, g, S, E, wv); }
            { pg8::Gemm g{yb, W + W_B, MTOK, DM, 512, 512}; pg8::StaticOrder S; S.init(MTOK, DM, G, bid);
              pg8::EpiMerge<1> E{u2 + 2048, U2W, m32, mb};
              pg8::gemm_phase<pg8::EpiMerge<1>, pg8::StaticOrder, true, true>(lds, g, S, E, wv); }
            { pg8::Gemm g{yc, W + W_C, MTOK, DM, 256, 256}; pg8::StaticOrder S; S.init(MTOK, DM, G, bid);
              pg8::EpiMerge<2> E{u2 + 4096, U2W, m32, mb};
              pg8::gemm_phase<pg8::EpiMerge<2>, pg8::StaticOrder, true, true>(lds, g, S, E, wv); }
        }
        SEAM(pb + 8);
        if (EN(9) && IN(pb + 9)) {
            pg8::Gemm g{mb, W + W_OUT, MTOK, DM, DM, DM}; pg8::StaticOrder S; S.init(MTOK, DM, G, bid);
            pg8::EpiResid E{xres, xres, xb, ssq, 1.0f};
            pg8::gemm_phase<pg8::EpiResid, pg8::StaticOrder, true, true>(lds, g, S, E, wv);
        }
        SEAM(pb + 9);
        if (EN(10) && IN(pb + 10)) {
            pg8::Gemm g{xb, W + W_GU2, MTOK, NGU, DM, DM}; pg8::StaticOrder S; S.init(MTOK, NGU, G, bid);
            pg8::EpiSwiGLU E{ssq, h1, FF};
            pg8::gemm_phase<pg8::EpiSwiGLU, pg8::StaticOrder, true, true>(lds, g, S, E, wv);
        }
        SEAM(pb + 10);
        if (EN(11) && IN(pb + 11)) {
            pg8::Gemm g{h1, W + W_D2, MTOK, DM, FF, FF}; pg8::StaticOrder S; S.init(MTOK, DM, G, bid);
            pg8::EpiResid E{xres, xres, xb, ssq, 0.5f};
            pg8::gemm_phase<pg8::EpiResid, pg8::StaticOrder, true, true>(lds, g, S, E, wv);
        }
        SEAM(pb + 11);
    }
#undef IN
#undef SEAM
}

extern "C" void kernel_launch(void* const* d_in, const int* in_sizes, int n_in, void* d_out, int out_size, void* d_ws, size_t ws_size, hipStream_t stream) {
    static int grid = 0;
    if (grid == 0) {
        if (n_in != 27 || out_size != MTOK * DM || ws_size < WS_END) { fprintf(stderr, "kernel_launch: unexpected problem: n_in %d out %d ws %zu (need %zu)\n", n_in, out_size, ws_size, (size_t)WS_END); grid = -1; return; }
        int dev = 0, cus = 0, per_cu = 0;
        if (hipGetDevice(&dev) != hipSuccess || hipDeviceGetAttribute(&cus, hipDeviceAttributeMultiprocessorCount, dev) != hipSuccess) { grid = -1; return; }
        if (hipFuncSetAttribute((const void*)hybrid_fwd, hipFuncAttributeMaxDynamicSharedMemorySize, LDS_BYTES) != hipSuccess) { fprintf(stderr, "kernel_launch: hipFuncSetAttribute failed\n"); grid = -1; return; }
        if (hipOccupancyMaxActiveBlocksPerMultiprocessor(&per_cu, (const void*)hybrid_fwd, NTHR, LDS_BYTES) != hipSuccess || per_cu < 1)
            fprintf(stderr, "kernel_launch: occupancy query reports %d workgroups per CU\n", per_cu);
        (void)hipGetLastError();
        grid = cus;
    }
    if (grid < 0) return;
    if (hipMemsetAsync((char*)d_ws + WS_CTL, 0, CTL_BYTES, stream) != hipSuccess) return;
    Args a{};
    for (int i = 0; i < 27; ++i) a.in[i] = (const float*)d_in[i];
    a.out = (float*)d_out; a.ws = (unsigned char*)d_ws;
#if MK_SINGLE
    a.ph_lo = 0; a.ph_hi = NPH;
    hipLaunchKernelGGL(hybrid_fwd, dim3(grid), dim3(NTHR), LDS_BYTES, stream, a);
#else
    for (int p = 0; p < NPH; ++p) { a.ph_lo = p; a.ph_hi = p + 1; hipLaunchKernelGGL(hybrid_fwd, dim3(grid), dim3(NTHR), LDS_BYTES, stream, a); }
#endif
    const hipError_t le = hipPeekAtLastError();
    if (le != hipSuccess) fprintf(stderr, "kernel_launch: launch failed: %s\n", hipGetErrorName(le));
}
```

```cpp
#include <hip/hip_runtime.h>
#include <cstdio>
#include <cstdint>

#ifndef MK_SINGLE
#define MK_SINGLE 1
#endif

__device__ __forceinline__ int lane_id_v() { int x; asm volatile("v_mbcnt_lo_u32_b32 %0, -1, 0\n\tv_mbcnt_hi_u32_b32 %0, -1, %0" : "=v"(x)); return x; }
namespace pg8 {
#define PG8_LAS __attribute__((address_space(3)))
typedef unsigned short bf16_t;
typedef short bf16x8 __attribute__((ext_vector_type(8)));
typedef float f32x4 __attribute__((ext_vector_type(4)));
typedef unsigned u32x4 __attribute__((ext_vector_type(4)));
constexpr int BM = 256, BK = 64, HALF = 128, HTB = HALF * BK * 2  , STAGE_BYTES = 8 * HTB, NXCD = 8, WGM = 8;

__host__ __device__ __forceinline__ int lds_byte(int r, int c) { const int st = (r >> 4) * 2 + (c >> 5), rr = r & 15, cc = c & 31, ob = rr * 64 + cc * 2; return st * 1024 + (ob ^ (((ob >> 9) & 1) << 5)); }
__host__ __device__ __forceinline__ void stage_rc(int b, int& R, int& C) { const int st = b / 1024, sb = b % 1024, swz = sb ^ (((sb >> 9) & 1) << 5); R = (st >> 1) * 16 + swz / 64; C = (st & 1) * 32 + (swz % 64) / 2; }
__host__ __device__ __forceinline__ int perm32(int rho) { const int n = rho >> 4, i = rho & 15; return 8 * (i >> 2) + 4 * n + (i & 3); }

struct Unit { int pm, pn; };
struct Gemm { const bf16_t* A; const bf16_t* Bt; int M, N, K, lda; };

struct StaticOrder {
    int nM, nN, nwg, G, c;
    __host__ __device__ void init(int M, int N, int G_, int c_) { nM = M / BM; nN = N / BM; nwg = nM * nN; G = G_; c = c_; }
    __host__ __device__ bool next(int i, Unit& u) const {
        const long L = (long)i * G + c; if (L >= nwg) return false;
        int wgid = (int)L; { const int q = nwg / NXCD, r = nwg % NXCD, xcd = wgid % NXCD, off = wgid / NXCD; wgid = (xcd < r ? xcd * (q + 1) : r * (q + 1) + (xcd - r) * q) + off; }
        const int nig = WGM * nN, gid = wgid / nig, fm = gid * WGM, gsz = (nM - fm) < WGM ? (nM - fm) : WGM;
        u.pm = fm + ((wgid % nig) % gsz); u.pn = (wgid % nig) / gsz; return true;
    }
    __device__ __forceinline__ void a_ready(const Unit&) const {}
    __device__ __forceinline__ void done(const Unit&) const {}
};
__device__ __forceinline__ unsigned cvt_pk_bf16(float lo, float hi) { unsigned r; asm volatile("v_cvt_pk_bf16_f32 %0, %1, %2" : "=v"(r) : "v"(lo), "v"(hi)); return r; }

template <class Epi, class Sched, bool ALIGN_EPI = false, bool SP2 = false>
__device__ __forceinline__ void gemm_phase(PG8_LAS unsigned char* lds, const Gemm g, const Sched& S, const Epi& E, const int wv) {
    int tid_ = wv * 64 + lane_id_v(); asm volatile("" : "+v"(tid_));
    const int tid = tid_, wid = __builtin_amdgcn_readfirstlane(tid >> 6), lane = tid & 63, wr = wid >> 2, wc = wid & 3, fr = lane & 15, fq = lane >> 4;
    const int K = g.K, nt = K / BK;
    unsigned voffA[2], voffB[2];
#pragma unroll
    for (int i = 0; i < 2; ++i) { int R, C; stage_rc(tid * 16 + i * 8192, R, C); const int Rb = Epi::PERM ? ((R & ~31) + perm32(R & 31)) : R;
        voffA[i] = (unsigned)(R * g.lda + C) * 2u; voffB[i] = (unsigned)(Rb * K + C) * 2u; }
    const size_t kstep = (size_t)(BK * 2);
    const size_t hstep = (size_t)HALF * K * 2, hstepA = (size_t)HALF * g.lda * 2;
    const size_t tstep = 2 * hstep, tstepA = 2 * hstepA;
    const unsigned ldsw = (unsigned)wid * 1024u;
    const int aoff = lds_byte(wr * 64 + fr, fq * 8), boff = lds_byte(wc * 32 + fr, fq * 8);
#define PG8_SA(b, h) (((b) * 2 + (h)) * HTB)
#define PG8_SB(b, h) ((4 + (b) * 2 + (h)) * HTB)
#define PG8_STAGE(bufoff, gbase, voff) do { _Pragma("unroll") for (int _i = 0; _i < 2; ++_i) \
        __builtin_amdgcn_global_load_lds((const unsigned*)((const char*)(gbase) + (voff)[_i]), (PG8_LAS unsigned*)(lds + (bufoff) + ldsw + _i * 8192), 16, 0, 0); } while (0)
#define PG8_LDA(dst, b, h) do { _Pragma("unroll") for (int m = 0; m < 4; ++m) _Pragma("unroll") for (int k = 0; k < 2; ++k) dst[m][k] = *(const PG8_LAS bf16x8*)(lds + PG8_SA(b, h) + aoff + m * 2048 + k * 1024); } while (0)
#define PG8_LDB(dst, b, h) do { _Pragma("unroll") for (int n = 0; n < 2; ++n) _Pragma("unroll") for (int k = 0; k < 2; ++k) dst[n][k] = *(const PG8_LAS bf16x8*)(lds + PG8_SB(b, h) + boff + n * 2048 + k * 1024); } while (0)
#define PG8_MMA(ai, bj, At, Bt) do { __builtin_amdgcn_s_setprio(1); _Pragma("unroll") for (int m = 0; m < 4; ++m) _Pragma("unroll") for (int n = 0; n < 2; ++n) _Pragma("unroll") for (int k = 0; k < 2; ++k) \
        acc[ai][bj][m][n] = __builtin_amdgcn_mfma_f32_16x16x32_bf16(Bt[n][k], At[m][k], acc[ai][bj][m][n], 0, 0, 0); __builtin_amdgcn_s_setprio(0); } while (0)
#define PG8_WAIT_V(n) asm volatile("s_waitcnt vmcnt(" #n ")" ::: "memory")
#define PG8_WAIT_L(n) asm volatile("s_waitcnt lgkmcnt(" #n ")" ::: "memory")
#define PG8_BAR __builtin_amdgcn_s_barrier()
#define PG8_SCHED __builtin_amdgcn_sched_barrier(0)
    Unit cur, nxt; int ui = 0;
    if (!S.next(0, cur)) return;
    f32x4 acc[2][2][4][2];
#pragma unroll
    for (int a = 0; a < 2; ++a)
#pragma unroll
        for (int b = 0; b < 2; ++b)
#pragma unroll
            for (int m = 0; m < 4; ++m)
#pragma unroll
                for (int n = 0; n < 2; ++n) acc[a][b][m][n] = (f32x4){0.f, 0.f, 0.f, 0.f};
    bf16x8 At[4][2], B0[2][2], B1[2][2];
    const char* cA = (const char*)g.A + (size_t)cur.pm * tstepA; const char* cB = (const char*)g.Bt + (size_t)cur.pn * tstep;
    S.a_ready(cur);
    if constexpr (SP2) {
        PG8_STAGE(PG8_SB(0, 0), cB, voffB); PG8_STAGE(PG8_SB(0, 1), cB + hstep, voffB); PG8_STAGE(PG8_SA(0, 0), cA, voffA); PG8_STAGE(PG8_SA(0, 1), cA + hstepA, voffA);
        if (wr == 1) PG8_BAR;
        PG8_WAIT_V(2); PG8_BAR;
        PG8_STAGE(PG8_SB(1, 0), cB + kstep, voffB); PG8_STAGE(PG8_SA(1, 0), cA + kstep, voffA); PG8_STAGE(PG8_SB(1, 1), cB + hstep + kstep, voffB);
        PG8_WAIT_V(6); PG8_BAR;
    } else {
        PG8_STAGE(PG8_SB(0, 0), cB, voffB); PG8_STAGE(PG8_SA(0, 0), cA, voffA); PG8_STAGE(PG8_SB(0, 1), cB + hstep, voffB); PG8_STAGE(PG8_SA(0, 1), cA + hstepA, voffA);
        if (wr == 1) PG8_BAR;
        PG8_WAIT_V(4); PG8_BAR;
        PG8_STAGE(PG8_SB(1, 0), cB + kstep, voffB); PG8_STAGE(PG8_SA(1, 0), cA + kstep, voffA); PG8_STAGE(PG8_SB(1, 1), cB + hstep + kstep, voffB);
        PG8_WAIT_V(6); PG8_BAR;
    }
    for (;;) {
        const bool has_next = S.next(ui + 1, nxt);
        const char* nA = has_next ? (const char*)g.A + (size_t)nxt.pm * tstepA : cA; const char* nB = has_next ? (const char*)g.Bt + (size_t)nxt.pn * tstep : cB;
        for (int t = 0; t < nt; t += 2) {
            const bool last = (t == nt - 2);
            const char* a1 = cA + (size_t)(t + 1) * kstep;
            const char* a2 = last ? nA : cA + (size_t)(t + 2) * kstep; const char* b2 = last ? nB : cB + (size_t)(t + 2) * kstep;
            const char* a3 = a2 + kstep; const char* b3 = b2 + kstep;
            if (last && has_next) S.a_ready(nxt);
            if constexpr (SP2) {
            PG8_LDB(B0, 0, 0); PG8_LDB(B1, 0, 1); PG8_SCHED; PG8_LDA(At, 0, 0); PG8_STAGE(PG8_SA(1, 1), a1 + hstepA, voffA);
            PG8_WAIT_V(8); PG8_WAIT_L(0); PG8_BAR; PG8_MMA(0, 0, At, B0); PG8_MMA(0, 1, At, B1); PG8_BAR; PG8_SCHED;
            PG8_LDA(At, 0, 1); PG8_STAGE(PG8_SB(0, 0), b2, voffB); PG8_STAGE(PG8_SB(0, 1), b2 + hstep, voffB); PG8_STAGE(PG8_SA(0, 0), a2, voffA);
            PG8_WAIT_V(8); PG8_WAIT_L(0); PG8_BAR; PG8_MMA(1, 0, At, B0); PG8_MMA(1, 1, At, B1); PG8_BAR; PG8_SCHED;
            PG8_LDB(B0, 1, 0); PG8_LDB(B1, 1, 1); PG8_SCHED; PG8_LDA(At, 1, 0); PG8_STAGE(PG8_SA(0, 1), a2 + hstepA, voffA);
            PG8_WAIT_V(8); PG8_WAIT_L(0); PG8_BAR; PG8_MMA(0, 0, At, B0); PG8_MMA(0, 1, At, B1); PG8_BAR; PG8_SCHED;
            PG8_LDA(At, 1, 1); PG8_STAGE(PG8_SB(1, 0), b3, voffB); PG8_STAGE(PG8_SB(1, 1), b3 + hstep, voffB); PG8_STAGE(PG8_SA(1, 0), a3, voffA);
            PG8_WAIT_V(8); PG8_WAIT_L(0); PG8_BAR; PG8_MMA(1, 0, At, B0); PG8_MMA(1, 1, At, B1); PG8_BAR; PG8_SCHED;
            } else {
            PG8_LDB(B0, 0, 0); PG8_SCHED; PG8_LDA(At, 0, 0); PG8_STAGE(PG8_SA(1, 1), a1 + hstepA, voffA);
            PG8_WAIT_L(8); PG8_BAR; PG8_WAIT_L(0); PG8_MMA(0, 0, At, B0); PG8_BAR; PG8_SCHED;
            PG8_LDB(B1, 0, 1); PG8_STAGE(PG8_SB(0, 0), b2, voffB);
            PG8_BAR; PG8_WAIT_L(0); PG8_MMA(0, 1, At, B1); PG8_BAR;
            PG8_LDA(At, 0, 1); PG8_STAGE(PG8_SA(0, 0), a2, voffA);
            PG8_BAR; PG8_WAIT_L(0); PG8_MMA(1, 0, At, B0); PG8_BAR; PG8_SCHED;
            PG8_STAGE(PG8_SB(0, 1), b2 + hstep, voffB);
            PG8_WAIT_V(6); PG8_BAR; PG8_MMA(1, 1, At, B1); PG8_BAR;
            PG8_LDB(B0, 1, 0); PG8_SCHED; PG8_LDA(At, 1, 0); PG8_STAGE(PG8_SA(0, 1), a2 + hstepA, voffA);
            PG8_WAIT_L(8); PG8_BAR; PG8_WAIT_L(0); PG8_MMA(0, 0, At, B0); PG8_BAR; PG8_SCHED;
            PG8_LDB(B1, 1, 1); PG8_STAGE(PG8_SB(1, 0), b3, voffB);
            PG8_BAR; PG8_WAIT_L(0); PG8_MMA(0, 1, At, B1); PG8_BAR;
            PG8_LDA(At, 1, 1); PG8_STAGE(PG8_SA(1, 0), a3, voffA);
            PG8_BAR; PG8_WAIT_L(0); PG8_MMA(1, 0, At, B0); PG8_BAR; PG8_SCHED;
            PG8_STAGE(PG8_SB(1, 1), b3 + hstep, voffB);
            PG8_WAIT_V(6); PG8_BAR; PG8_MMA(1, 1, At, B1); PG8_BAR;
            }
        }
        if constexpr (ALIGN_EPI) { if (wr == 0) PG8_BAR; }
        if constexpr (!Epi::AFTER_DRAIN) { E(acc, cur, wr, wc, fr, fq); S.done(cur); }
        if (!has_next) break;
#pragma unroll
        for (int a = 0; a < 2; ++a)
#pragma unroll
            for (int b = 0; b < 2; ++b)
#pragma unroll
                for (int m = 0; m < 4; ++m)
#pragma unroll
                    for (int n = 0; n < 2; ++n) acc[a][b][m][n] = (f32x4){0.f, 0.f, 0.f, 0.f};
        cur = nxt; cA = nA; cB = nB; ++ui;
        if constexpr (ALIGN_EPI) { if (wr == 1) PG8_BAR; }
    }
    PG8_WAIT_V(0);
    if constexpr (!ALIGN_EPI) { if (wr == 0) PG8_BAR; }
    PG8_BAR;
    if constexpr (Epi::AFTER_DRAIN) { E.fused(acc, cur, wr, wc, fr, fq, lds, wid, lane); S.done(cur); }
#undef PG8_SA
#undef PG8_SB
#undef PG8_STAGE
#undef PG8_LDA
#undef PG8_LDB
#undef PG8_MMA
#undef PG8_WAIT_V
#undef PG8_WAIT_L
#undef PG8_BAR
#undef PG8_SCHED
}

constexpr float NORM_EPS = 1e-6f;
__device__ __forceinline__ float row_rstd(const float* ssq, int row, int fq) {
    const f32x4 a = *(const f32x4*)(ssq + (size_t)row * 32 + fq * 8), b = *(const f32x4*)(ssq + (size_t)row * 32 + fq * 8 + 4);
    float s = ((a[0] + a[1]) + (a[2] + a[3])) + ((b[0] + b[1]) + (b[2] + b[3]));
    s += __shfl_xor(s, 16); s += __shfl_xor(s, 32);
    return rsqrtf(s * (1.0f / 2048.0f) + NORM_EPS);
}
__device__ __forceinline__ float fsigmoid(float x) { return __builtin_amdgcn_rcpf(1.0f + __expf(-x)); }
__device__ __forceinline__ u32x4 pack8(const f32x4 v0, const f32x4 v1) { u32x4 w; w.x = cvt_pk_bf16(v0[0], v0[1]); w.y = cvt_pk_bf16(v0[2], v0[3]); w.z = cvt_pk_bf16(v1[0], v1[1]); w.w = cvt_pk_bf16(v1[2], v1[3]); return w; }
__device__ __forceinline__ void unpack8(const u32x4 w, f32x4& v0, f32x4& v1) {
    v0[0] = __uint_as_float(w.x << 16); v0[1] = __uint_as_float(w.x & 0xffff0000u); v0[2] = __uint_as_float(w.y << 16); v0[3] = __uint_as_float(w.y & 0xffff0000u);
    v1[0] = __uint_as_float(w.z << 16); v1[1] = __uint_as_float(w.z & 0xffff0000u); v1[2] = __uint_as_float(w.w << 16); v1[3] = __uint_as_float(w.w & 0xffff0000u); }

struct EpiSwiGLU {
    static constexpr bool PERM = true, AFTER_DRAIN = false;
    const float* ssq; bf16_t* H; int ldh;
    __device__ __forceinline__ void operator()(const f32x4 (&acc)[2][2][4][2], const Unit& u, int wr, int wc, int fr, int fq) const {
        const int row0 = u.pm * BM + wr * 64 + fr, col0 = u.pn * HALF + wc * 32 + 8 * fq;
#pragma unroll
        for (int ai = 0; ai < 2; ++ai)
#pragma unroll
            for (int m = 0; m < 4; ++m) { const int row = row0 + ai * HALF + m * 16; const float rs = row_rstd(ssq, row, fq);
                f32x4 h0, h1;
#pragma unroll
                for (int j = 0; j < 4; ++j) { const float g0 = acc[ai][0][m][0][j] * rs, g1 = acc[ai][0][m][1][j] * rs;
                    h0[j] = g0 * fsigmoid(g0) * (acc[ai][1][m][0][j] * rs); h1[j] = g1 * fsigmoid(g1) * (acc[ai][1][m][1][j] * rs); }
                *(u32x4*)(H + (size_t)row * ldh + col0) = pack8(h0, h1); }
    }
};
struct EpiResid {
    static constexpr bool PERM = true, AFTER_DRAIN = false;
    const float* base; float* out; bf16_t* xb; float* ssq; float alpha;
    __device__ __forceinline__ void operator()(const f32x4 (&acc)[2][2][4][2], const Unit& u, int wr, int wc, int fr, int fq) const {
        const int row0 = u.pm * BM + wr * 64 + fr, col0 = u.pn * BM + wc * 32 + 8 * fq;
#pragma unroll
        for (int ai = 0; ai < 2; ++ai)
#pragma unroll
            for (int m = 0; m < 4; ++m) { const int row = row0 + ai * HALF + m * 16; float ss = 0.f;
#pragma unroll
                for (int bj = 0; bj < 2; ++bj) { const size_t off = (size_t)row * 2048 + col0 + bj * HALF;
                    const f32x4 b0 = *(const f32x4*)(base + off), b1 = *(const f32x4*)(base + off + 4);
                    const f32x4 v0 = b0 + acc[ai][bj][m][0] * alpha, v1 = b1 + acc[ai][bj][m][1] * alpha;
                    *(f32x4*)(out + off) = v0; *(f32x4*)(out + off + 4) = v1;
                    ss += ((v0[0] * v0[0] + v0[1] * v0[1]) + (v0[2] * v0[2] + v0[3] * v0[3])) + ((v1[0] * v1[0] + v1[1] * v1[1]) + (v1[2] * v1[2] + v1[3] * v1[3]));
                    *(u32x4*)(xb + off) = pack8(v0, v1); }
                ss += __shfl_xor(ss, 16); ss += __shfl_xor(ss, 32);
                if (fq == 0) ssq[(size_t)row * 32 + u.pn * 4 + wc] = ss; }
    }
};
struct EpiWin {
    static constexpr bool PERM = true, AFTER_DRAIN = false;
    const float* ssq; bf16_t* u1; bf16_t* u2; int ld1, ld2;
    __device__ __forceinline__ void operator()(const f32x4 (&acc)[2][2][4][2], const Unit& u, int wr, int wc, int fr, int fq) const {
        const int row0 = u.pm * BM + wr * 64 + fr; const int mode = u.pn < 17 ? 0 : (u.pn < 19 ? 1 : 2);
        bf16_t* dst = mode == 2 ? u2 : u1; const int ld = mode == 2 ? ld2 : ld1; const int col0 = (mode == 2 ? (u.pn - 19) : u.pn) * BM + wc * 32 + 8 * fq;
#pragma unroll
        for (int ai = 0; ai < 2; ++ai)
#pragma unroll
            for (int m = 0; m < 4; ++m) { const int row = row0 + ai * HALF + m * 16; const float rs = row_rstd(ssq, row, fq);
#pragma unroll
                for (int bj = 0; bj < 2; ++bj) { f32x4 v0 = acc[ai][bj][m][0] * rs, v1 = acc[ai][bj][m][1] * rs;
                    if (mode == 1) {
#pragma unroll
                        for (int j = 0; j < 4; ++j) { v0[j] = v0[j] * fsigmoid(v0[j]); v1[j] = v1[j] * fsigmoid(v1[j]); } }
                    else if (mode == 2) {
#pragma unroll
                        for (int j = 0; j < 4; ++j) { v0[j] = fsigmoid(v0[j]); v1[j] = fsigmoid(v1[j]); } }
                    *(u32x4*)(dst + (size_t)row * ld + col0 + bj * HALF) = pack8(v0, v1); } }
    }
};
struct EpiF32 {
    static constexpr bool PERM = false, AFTER_DRAIN = false;
    float* C; int ldc;
    __device__ __forceinline__ void operator()(const f32x4 (&acc)[2][2][4][2], const Unit& u, int wr, int wc, int fr, int fq) const {
        const int row0 = u.pm * BM + wr * 64 + fr, col0 = u.pn * BM + wc * 32 + 4 * fq;
#pragma unroll
        for (int ai = 0; ai < 2; ++ai)
#pragma unroll
            for (int m = 0; m < 4; ++m) { float* rowp = C + (size_t)(row0 + ai * HALF + m * 16) * ldc + col0;
#pragma unroll
                for (int bj = 0; bj < 2; ++bj)
#pragma unroll
                    for (int n = 0; n < 2; ++n) *(f32x4*)(rowp + bj * HALF + n * 16) = acc[ai][bj][m][n]; }
    }
};
template <int MODE> struct EpiMerge {
    static constexpr bool PERM = true, AFTER_DRAIN = false;
    const bf16_t* gate; int ldg; float* m32; bf16_t* mb;
    __device__ __forceinline__ void operator()(const f32x4 (&acc)[2][2][4][2], const Unit& u, int wr, int wc, int fr, int fq) const {
        const int row0 = u.pm * BM + wr * 64 + fr, col0 = u.pn * BM + wc * 32 + 8 * fq;
#pragma unroll
        for (int ai = 0; ai < 2; ++ai)
#pragma unroll
            for (int m = 0; m < 4; ++m) { const int row = row0 + ai * HALF + m * 16;
#pragma unroll
                for (int bj = 0; bj < 2; ++bj) { const int col = col0 + bj * HALF; const size_t off = (size_t)row * 2048 + col;
                    f32x4 g0, g1; unpack8(*(const u32x4*)(gate + (size_t)row * ldg + col), g0, g1);
                    f32x4 v0 = g0 * acc[ai][bj][m][0], v1 = g1 * acc[ai][bj][m][1];
                    if (MODE >= 1) { v0 += *(const f32x4*)(m32 + off); v1 += *(const f32x4*)(m32 + off + 4); }
                    if (MODE <= 1) { *(f32x4*)(m32 + off) = v0; *(f32x4*)(m32 + off + 4) = v1; }
                    else *(u32x4*)(mb + off) = pack8(v0, v1); } }
    }
};
}

#define GAS __attribute__((address_space(1)))
#define LAS __attribute__((address_space(3)))
typedef unsigned short bf16_t;
typedef short bf16x8 __attribute__((ext_vector_type(8)));
typedef short s16x4 __attribute__((ext_vector_type(4)));
typedef float f32x4 __attribute__((ext_vector_type(4)));
typedef float f32x16 __attribute__((ext_vector_type(16)));
typedef unsigned u32x4 __attribute__((ext_vector_type(4)));
typedef unsigned u32x2 __attribute__((ext_vector_type(2)));
#define LDS_WAIT() asm volatile("s_waitcnt lgkmcnt(0)" ::: "memory")
#define VM_WAIT() asm volatile("s_waitcnt vmcnt(0)" ::: "memory")
#define SBAR() __builtin_amdgcn_sched_barrier(0)
__device__ __forceinline__ unsigned f2bf(float f) { unsigned u = __builtin_bit_cast(unsigned, f); return (u + 0x7fffu + ((u >> 16) & 1u)) >> 16; }
__device__ __forceinline__ float bf2f(bf16_t b) { return __uint_as_float(((unsigned)b) << 16); }
__device__ __forceinline__ unsigned pk2(float lo, float hi) { return f2bf(lo) | (f2bf(hi) << 16); }
__device__ __forceinline__ float wave_sum(float v) {
#pragma unroll
    for (int o = 1; o < 64; o <<= 1) v += __shfl_xor(v, o);
    return v;
}

constexpr int NB = 2, SEQ = 16384, MTOK = NB * SEQ, DM = 2048, FF = 5504, DEPTH = 4;
constexpr int NGU = 2 * FF, NIN = 11008, U1W = 4864, U2W = 6144;
constexpr int C_CQ = 0, C_CKV = 512, C_QB = 768, C_KB = 1024, C_VB = 1280, C_QC = 1792, C_KC = 2560, C_VC = 3328, C_KROPE = 4096, C_GLR = 4160, C_RB = 4352;
constexpr int QRAW_LD = 1280, KVRAW_LD = 1536;
constexpr float EPS = 1e-6f, LOG2E = 1.4426950408889634f, LN2 = 0.6931471805599453f;
constexpr float QS_MLA = 0.07216878364870322f * LOG2E;
constexpr float QS_DSWA = 0.08838834764831845f * LOG2E;

namespace att {
constexpr int SHM_V = 64 * 128 * 2;
constexpr int K_OFF = 2 * SHM_V;
template <int DQK> struct Geo { static constexpr int KP = DQK * 2 + 16, SHM_K = 64 * KP, NCH = DQK / 8, NKST = (64 * NCH) / 512, WS_OFF = K_OFF + 2 * SHM_K; };
__device__ __forceinline__ int v_st(int k, int c) { const int kk = (k & ~0xC) | ((k & 4) << 1) | ((k & 8) >> 1); return ((kk >> 3) * 4 + (c >> 5)) * 512 + ((kk & 7) * 32 + (c & 31)) * 2; }
__device__ __forceinline__ int v_rd_base(int lane) { return ((lane & 3) << 3) | (((lane >> 2) & 3) << 6) | (((lane >> 4) & 1) << 5) | (((lane >> 5) & 1) << 8); }
constexpr int v_rd_off(int d0, int ks, int half) { return d0 * 512 + ks * 4096 + half * 2048; }
__device__ __forceinline__ int crow(int r, int hi) { return (r & 3) + 8 * (r >> 2) + 4 * hi; }
__device__ __forceinline__ unsigned cvtpk(float lo, float hi) { unsigned r; asm volatile("v_cvt_pk_bf16_f32 %0, %1, %2" : "=v"(r) : "v"(lo), "v"(hi)); return r; }

__device__ __forceinline__ void pv_tile(f32x16* o, int vb, bf16x8 pa0, bf16x8 pa1, bf16x8 pa2, bf16x8 pa3) {
#define TRRD(dst, off) asm volatile("ds_read_b64_tr_b16 %0, %1 offset:%2" : "=&v"(dst) : "v"(vb), "i"(off) : "memory")
#define PV_D0(d0) do { s16x4 l0, l1, l2, l3, h0, h1, h2, h3; constexpr int b_ = v_rd_off(d0, 0, 0); \
        TRRD(l0, b_); TRRD(h0, b_ + 2048); TRRD(l1, b_ + 4096); TRRD(h1, b_ + 6144); TRRD(l2, b_ + 8192); TRRD(h2, b_ + 10240); TRRD(l3, b_ + 12288); TRRD(h3, b_ + 14336); \
        asm volatile("s_waitcnt lgkmcnt(0)" ::: "memory"); SBAR(); \
        o[d0] = __builtin_amdgcn_mfma_f32_32x32x16_bf16(pa0, (bf16x8){l0[0], l0[1], l0[2], l0[3], h0[0], h0[1], h0[2], h0[3]}, o[d0], 0, 0, 0); \
        o[d0] = __builtin_amdgcn_mfma_f32_32x32x16_bf16(pa1, (bf16x8){l1[0], l1[1], l1[2], l1[3], h1[0], h1[1], h1[2], h1[3]}, o[d0], 0, 0, 0); \
        o[d0] = __builtin_amdgcn_mfma_f32_32x32x16_bf16(pa2, (bf16x8){l2[0], l2[1], l2[2], l2[3], h2[0], h2[1], h2[2], h2[3]}, o[d0], 0, 0, 0); \
        o[d0] = __builtin_amdgcn_mfma_f32_32x32x16_bf16(pa3, (bf16x8){l3[0], l3[1], l3[2], l3[3], h3[0], h3[1], h3[2], h3[3]}, o[d0], 0, 0, 0); } while (0)
    PV_D0(0); PV_D0(1); PV_D0(2); PV_D0(3);
#undef PV_D0
#undef TRRD
}

struct AUnit { const bf16_t* Q; const bf16_t* K; const bf16_t* V; bf16_t* O; float* lse; size_t qpitch, kpitch, vpitch, opitch, lsepitch; int q0, j_lo, j_hi; float bias_c; };

template <int DQK, int MODE>
__device__ __forceinline__ void attn_unit(LAS unsigned char* lds, const AUnit& u, const int wv) {
    using G = Geo<DQK>;
    int tid_ = wv * 64 + lane_id_v(); asm volatile("" : "+v"(tid_));
    const int tid = tid_, wid = __builtin_amdgcn_readfirstlane(tid >> 6), lane = tid & 63, r32 = lane & 31, hi = lane >> 5;
    LAS unsigned char* V_lds = lds; LAS unsigned char* K_lds = lds + K_OFF;
    LAS float* wsl = (LAS float*)(lds + G::WS_OFF) + wid * 64; LAS float* li_l = wsl; LAS float* al_l = wsl + 32;
    bf16x8 qr[DQK / 16];
    { const bf16_t* qrow = u.Q + (size_t)(wid * 32 + r32) * u.qpitch + hi * 8;
#pragma unroll
      for (int d0 = 0; d0 < DQK / 16; ++d0) qr[d0] = *(const bf16x8*)(qrow + d0 * 16); }
    float m_reg = -1e30f, l_reg = 0.f; f32x16 o[4] = {};
    bf16x8 stk[G::NKST], stv0, stv1;
    const int sr = tid >> 4, sc = (tid & 15) * 8, vst0 = v_st(sr, sc), vst1 = v_st(32 + sr, sc);
    const int vb0 = (int)(size_t)V_lds + v_rd_base(lane);
    const int qlo = u.q0 + wid * 32, qj = qlo + r32;
#define ST_LOAD(t) do { const int k0_ = (t) * 64; _Pragma("unroll") for (int i_ = 0; i_ < G::NKST; ++i_) { const int cid_ = tid + 512 * i_, row_ = cid_ / G::NCH, ch_ = cid_ % G::NCH; \
            stk[i_] = *(const bf16x8*)(u.K + (size_t)(k0_ + row_) * u.kpitch + ch_ * 8); } \
        stv0 = *(const bf16x8*)(u.V + (size_t)(k0_ + sr) * u.vpitch + sc); stv1 = *(const bf16x8*)(u.V + (size_t)(k0_ + 32 + sr) * u.vpitch + sc); } while (0)
#define ST_WRITE(bf) do { _Pragma("unroll") for (int i_ = 0; i_ < G::NKST; ++i_) { const int cid_ = tid + 512 * i_, row_ = cid_ / G::NCH, ch_ = cid_ % G::NCH; \
            *(LAS bf16x8*)(K_lds + (bf) * G::SHM_K + row_ * G::KP + ch_ * 16) = stk[i_]; } \
        *(LAS bf16x8*)(V_lds + (bf) * SHM_V + vst0) = stv0; *(LAS bf16x8*)(V_lds + (bf) * SHM_V + vst1) = stv1; } while (0)
    ST_LOAD(u.j_lo);
    for (int t = u.j_lo; t < u.j_hi; ++t) {
        const int buf = (t - u.j_lo) & 1;
        VM_WAIT(); ST_WRITE(buf);
        __syncthreads();
        if (t + 1 < u.j_hi) ST_LOAD(t + 1);
        f32x16 p0 = {}, p1 = {};
        { const LAS unsigned char* kb = K_lds + buf * G::SHM_K + r32 * G::KP + hi * 16;
#pragma unroll
          for (int d0 = 0; d0 < DQK / 16; ++d0) { const bf16x8 b0 = *(const LAS bf16x8*)(kb + d0 * 32), b1 = *(const LAS bf16x8*)(kb + 32 * G::KP + d0 * 32);
              p0 = __builtin_amdgcn_mfma_f32_32x32x16_bf16(b0, qr[d0], p0, 0, 0, 0);
              p1 = __builtin_amdgcn_mfma_f32_32x32x16_bf16(b1, qr[d0], p1, 0, 0, 0); } }
        const float NEG = -__builtin_inff(); const int kb0 = t * 64;
        if (MODE == 0) {
            if (kb0 + 63 > qlo) {
#pragma unroll
                for (int r = 0; r < 16; ++r) { const int key = kb0 + (r & 3) + 8 * (r >> 2) + 4 * hi; if (key > qj) p0[r] = NEG; if (key + 32 > qj) p1[r] = NEG; } }
        } else {
#pragma unroll
            for (int r = 0; r < 16; ++r) { const int dist = qj - (kb0 + (r & 3) + 8 * (r >> 2) + 4 * hi), dist2 = dist - 32;
                p0[r] = ((unsigned)dist <= 128u) ? p0[r] - u.bias_c * (float)dist : NEG;
                p1[r] = ((unsigned)dist2 <= 128u) ? p1[r] - u.bias_c * (float)dist2 : NEG; }
        }
        float pmax = p0[0];
#pragma unroll
        for (int r = 1; r < 16; ++r) pmax = fmaxf(pmax, p0[r]);
#pragma unroll
        for (int r = 0; r < 16; ++r) pmax = fmaxf(pmax, p1[r]);
        { auto rr = __builtin_amdgcn_permlane32_swap(__float_as_uint(pmax), __float_as_uint(pmax), false, false); pmax = fmaxf(__uint_as_float(rr[0]), __uint_as_float(rr[1])); }
        const float mn = fmaxf(m_reg, pmax); const float alpha = __builtin_amdgcn_exp2f(m_reg - mn); m_reg = mn;
#pragma unroll
        for (int r = 0; r < 16; ++r) { p0[r] = __builtin_amdgcn_exp2f(p0[r] - mn); p1[r] = __builtin_amdgcn_exp2f(p1[r] - mn); }
        float ps = 0.f;
#pragma unroll
        for (int r = 0; r < 16; ++r) ps += p0[r] + p1[r];
        { auto rr = __builtin_amdgcn_permlane32_swap(__float_as_uint(ps), __float_as_uint(ps), false, false); ps = __uint_as_float(rr[0]) + __uint_as_float(rr[1]); }
        l_reg = l_reg * alpha + ps;
        bf16x8 pa0, pa1, pa2, pa3;
#define PK4(P, B_, OUT) do { unsigned a0 = cvtpk(P[B_ + 0], P[B_ + 1]), a1 = cvtpk(P[B_ + 2], P[B_ + 3]); unsigned b0 = cvtpk(P[B_ + 4], P[B_ + 5]), b1 = cvtpk(P[B_ + 6], P[B_ + 7]); \
        auto r0 = __builtin_amdgcn_permlane32_swap(a0, b0, false, false); auto r1 = __builtin_amdgcn_permlane32_swap(a1, b1, false, false); \
        u32x4 w = {r0[0], r1[0], r0[1], r1[1]}; OUT = *reinterpret_cast<bf16x8*>(&w); } while (0)
        PK4(p0, 0, pa0); PK4(p0, 8, pa1); PK4(p1, 0, pa2); PK4(p1, 8, pa3);
#undef PK4
        if (__any(alpha < 1.f)) { if (hi == 0) al_l[r32] = alpha; LDS_WAIT();
#pragma unroll
            for (int r = 0; r < 16; ++r) { const float a = al_l[(r & 3) + 8 * (r >> 2) + 4 * hi];
#pragma unroll
                for (int d = 0; d < 4; ++d) o[d][r] *= a; } }
        pv_tile(o, vb0 + buf * SHM_V, pa0, pa1, pa2, pa3);
    }
    if (hi == 0) li_l[r32] = l_reg; LDS_WAIT();
    float rli[16];
#pragma unroll
    for (int r = 0; r < 16; ++r) rli[r] = __builtin_amdgcn_rcpf(li_l[(r & 3) + 8 * (r >> 2) + 4 * hi]);
    bf16_t* Ow = u.O + (size_t)(wid * 32) * u.opitch;
#pragma unroll
    for (int r = 0; r < 16; ++r) { const int orow = (r & 3) + 8 * (r >> 2) + 4 * hi;
#pragma unroll
        for (int d0 = 0; d0 < 4; ++d0) { const float v = o[d0][r] * rli[r]; const float vn = __shfl_xor(v, 1);
            if ((r32 & 1) == 0) *(unsigned*)(Ow + (size_t)orow * u.opitch + d0 * 32 + r32) = cvtpk(v, vn); } }
    if (MODE == 1) { if (hi == 0) u.lse[(size_t)(wid * 32 + r32) * u.lsepitch] = (m_reg + __log2f(l_reg)) * LN2; }
    __syncthreads();
#undef ST_LOAD
#undef ST_WRITE
}
}

constexpr size_t al256(size_t x) { return (x + 255) & ~(size_t)255; }
constexpr size_t WS_CTL = 0, CTL_BYTES = 1u << 20;
constexpr size_t WS_ROPE = WS_CTL + CTL_BYTES;
constexpr size_t WS_SSQ = WS_ROPE + al256((size_t)MTOK * 64 * 4);
constexpr size_t WS_XB = WS_SSQ + al256((size_t)MTOK * 32 * 4);
constexpr size_t WS_W = WS_XB + al256((size_t)MTOK * DM * 2);
constexpr size_t W_GU1 = 0, W_D1 = W_GU1 + (size_t)NGU * DM, W_IN = W_D1 + (size_t)DM * FF, W_UQ = W_IN + (size_t)NIN * DM, W_UKV = W_UQ + (size_t)1280 * 512,
                 W_A = W_UKV + (size_t)1536 * 256, W_B = W_A + (size_t)DM * 768, W_C = W_B + (size_t)DM * 512, W_OUT = W_C + (size_t)DM * 256, W_GU2 = W_OUT + (size_t)DM * DM,
                 W_D2 = W_GU2 + (size_t)NGU * DM, W_END = W_D2 + (size_t)DM * FF;
constexpr size_t WS_R1 = WS_W + al256(W_END * 2);
constexpr size_t WS_R2 = WS_R1 + al256((size_t)MTOK * U2W * 2);
constexpr size_t WS_QKV = WS_R2 + al256((size_t)MTOK * U1W * 2);
constexpr size_t QKV_Q = 0, QKV_K = (size_t)NB * 6 * SEQ * 192 * 2, QKV_V = 2 * QKV_K, QKV_END = QKV_V + (size_t)NB * 6 * SEQ * 128 * 2;
constexpr size_t WS_R3 = WS_QKV + al256(QKV_END);
constexpr size_t R3_QRAW = 0, R3_KVRAW = (size_t)MTOK * QRAW_LD * 4, R3_END = R3_KVRAW + (size_t)MTOK * KVRAW_LD * 4;
constexpr size_t R3_YA = 0, R3_YB = R3_YA + (size_t)MTOK * 768 * 2, R3_YC = R3_YB + (size_t)MTOK * 512 * 2, R3_DO = R3_YC + (size_t)MTOK * 256 * 2, R3_LSE = R3_DO + (size_t)MTOK * 768 * 2;
static_assert(R3_LSE + (size_t)MTOK * 6 * 4 <= R3_END, "R3 overlay");
constexpr size_t WS_GLA = WS_R3 + al256(R3_END);
constexpr size_t GLA_DS = 0, GLA_BC = (size_t)2048 * 8192 * 4, GLA_DEC = GLA_BC + (size_t)MTOK * 256 * 4, GLA_END = GLA_DEC + (size_t)2048 * 64 * 4;
constexpr size_t WS_END = WS_GLA + al256(GLA_END);
constexpr int CW_BAR = 1024;
constexpr int CW_QUEUE = 16384;

constexpr int RING_BYTES = 131072, LDSCTL_OFF = RING_BYTES, LDS_BYTES = 147456;
constexpr int NWAVES = 8, NTHR = 512;

#define XB_TMO      128
#define XB_XCNT(j)  (256  + 64 * (j))
#define XB_XSUB(j)  (1280 + 64 * (j))
#define XB_XGEN(j)  (2304 + 64 * (j))
#define XB_TOP      3328
#define XB_TOPGEN   3392
#define XCD_BAR_WORDS 3456
#define XB_SPIN_CAP (1u << 20)
__device__ __forceinline__ unsigned xb_ld(unsigned* p)              { return __hip_atomic_load(p, __ATOMIC_RELAXED, __HIP_MEMORY_SCOPE_AGENT); }
__device__ __forceinline__ unsigned xb_add(unsigned* p, unsigned v) { return __hip_atomic_fetch_add(p, v, __ATOMIC_RELAXED, __HIP_MEMORY_SCOPE_AGENT); }
__device__ __forceinline__ unsigned xb_xcc_id() { return (unsigned)__builtin_amdgcn_s_getreg((3 << 11) | 20) & 0xFu; }
#define XB_SPIN(cond, bar) do { unsigned _sp = 0; while (cond) { __builtin_amdgcn_s_sleep(1); \
    if ((++_sp & 255u) == 0u) { if (xb_ld(&(bar)[XB_TMO])) break; if (_sp > XB_SPIN_CAP) { atomicAdd(&(bar)[XB_TMO], 1u); break; } } } } while (0)
struct XcdBarrier { unsigned* bar; unsigned x; volatile LAS unsigned* st; int wv; };
__device__ __forceinline__ bool xb_thread0(int wv) { return wv == 0 && lane_id_v() == 0; }
__device__ __forceinline__ XcdBarrier xcd_barrier_post(unsigned* bar, volatile LAS unsigned* st, int wv) {
    XcdBarrier b; b.bar = bar; b.x = xb_xcc_id(); b.st = st; b.wv = wv;
    if (xb_thread0(wv)) (void)xb_add(&bar[XB_XCNT(b.x)], 1u);
    return b;
}
__device__ __forceinline__ void xcd_barrier_complete(unsigned* bar, unsigned x, unsigned& nloc, unsigned& nx) {
    const unsigned G = gridDim.x * gridDim.y * gridDim.z;
    unsigned sum, cnt, mine, sp = 0u;
    for (;;) {
        sum = 0u; cnt = 0u; mine = 0u;
#pragma unroll
        for (unsigned j = 0; j < 16; ++j) { const unsigned c = xb_ld(&bar[XB_XCNT(j)]); sum += c; cnt += (c > 0u) ? 1u : 0u; mine = (j == x) ? c : mine; }
        if (sum == G) break;
        __builtin_amdgcn_s_sleep(1);
        if ((++sp & 255u) == 0u) { if (xb_ld(&bar[XB_TMO])) break; if (sp > XB_SPIN_CAP) { atomicAdd(&bar[XB_TMO], 1u); break; } }
    }
    nloc = mine > 0u ? mine : 1u; nx = cnt > 0u ? cnt : 1u;
}
__device__ __forceinline__ void xcd_barrier(const XcdBarrier& b) {
    asm volatile("s_waitcnt vmcnt(0)" ::: "memory");
    __syncthreads();
    if (xb_thread0(b.wv)) {
        unsigned* bar = b.bar;
        __builtin_amdgcn_s_waitcnt(0);
        unsigned nloc = b.st[0], nx = b.st[1];
        if (nloc == 0u) { xcd_barrier_complete(bar, b.x, nloc, nx); b.st[0] = nloc; b.st[1] = nx; }
        const unsigned old = xb_add(&bar[XB_XSUB(b.x)], 1u);
        const unsigned gen = old / nloc;
        if (old + 1u == (gen + 1u) * nloc) {
            __builtin_amdgcn_fence(__ATOMIC_RELEASE, "agent");
            asm volatile("s_waitcnt vmcnt(0)" ::: "memory");
            const unsigned og = xb_add(&bar[XB_TOP], 1u);
            const unsigned tg = og / nx;
            if (og + 1u == (tg + 1u) * nx) xb_add(&bar[XB_TOPGEN], 1u);
            else XB_SPIN(xb_ld(&bar[XB_TOPGEN]) == tg, bar);
            __builtin_amdgcn_fence(__ATOMIC_ACQUIRE, "agent");
            xb_add(&bar[XB_XGEN(b.x)], 1u);
            asm volatile("s_waitcnt vmcnt(0)" ::: "memory");
        } else {
            XB_SPIN(xb_ld(&bar[XB_XGEN(b.x)]) == gen, bar);
            __builtin_amdgcn_fence(__ATOMIC_ACQUIRE, "agent");
            asm volatile("s_waitcnt vmcnt(0)" ::: "memory");
        }
    }
    __syncthreads();
}

struct Args { const float* in[27]; float* out; unsigned char* ws; int ph_lo, ph_hi; };
struct Ctx { unsigned char* ws; volatile LAS unsigned long long* ptab;
    __device__ __forceinline__ const float* in(int i) const { const unsigned long long v = ptab[i];
        const unsigned lo = __builtin_amdgcn_readfirstlane((unsigned)v), hi = __builtin_amdgcn_readfirstlane((unsigned)(v >> 32)); return (const float*)(((unsigned long long)hi << 32) | lo); } };
enum { I_X = 0, I_POS, I_F1N, I_F1G, I_F1U, I_F1D, I_MIXN, I_WIN, I_CQN, I_CKVN, I_WUQ, I_WUKV, I_QN, I_KN, I_WG2, I_BG2, I_ON, I_DQN, I_DKN, I_WA, I_WB, I_WC, I_WOUT, I_F2N, I_F2G, I_F2U, I_F2D };

__device__ __forceinline__ int win_map(int n) {
    if (n < 768) return n;
    if (n < 1024) return 832 + (n - 768);
    if (n < 1280) return 1088 + (n - 1024);
    if (n < 1792) return 1344 + (n - 1280);
    if (n < 2560) return 2384 + (n - 1792);
    if (n < 3328) return 3152 + (n - 2560);
    if (n < 4096) return 3920 + (n - 3328);
    if (n < 4160) return 768 + (n - 4096);
    if (n < 4176) return 1856 + (n - 4160);
    if (n < 4352) return -1;
    if (n < 4864) return 1872 + (n - 4352);
    return 4688 + (n - 4864);
}
struct WMat { const float* src; const float* src2; const float* gain; bf16_t* dst; int K, Nsrc, Ndst, kind; };
__device__ __forceinline__ void wconv_item(const WMat& w, int item, LAS float* scr, int lane) {
    const int nblk = w.Ndst / 32, kb = item / nblk, nb = item % nblk, k0 = 64 * kb, n0 = 32 * nb;
    const int nn = n0 + (lane & 31);
    const float* sp = w.src; int scol = nn; bool valid = true;
    if (w.kind == 1) { const int tile = nn >> 8; int wi = nn & 255; if (wi >= 128) { sp = w.src2; wi -= 128; } scol = tile * 128 + wi; }
    else if (w.kind == 2) { scol = win_map(nn); valid = scol >= 0; }
    else valid = nn < w.Nsrc;
    if (!valid) scol = 0;
#pragma unroll 8
    for (int i = 0; i < 32; ++i) { const int kk = 2 * i + (lane >> 5); float v = sp[(size_t)(k0 + kk) * w.Nsrc + scol]; if (w.gain) v *= w.gain[k0 + kk]; scr[kk * 33 + (lane & 31)] = valid ? v : 0.f; }
    LDS_WAIT(); asm volatile("" ::: "memory");
    const int c = lane & 7;
#pragma unroll
    for (int j = 0; j < 4; ++j) { const int n = (lane >> 3) + 8 * j; const LAS float* s = scr + (8 * c) * 33 + n;
        u32x4 o; o.x = pk2(s[0 * 33], s[1 * 33]); o.y = pk2(s[2 * 33], s[3 * 33]); o.z = pk2(s[4 * 33], s[5 * 33]); o.w = pk2(s[6 * 33], s[7 * 33]);
        *(u32x4*)(w.dst + (size_t)(n0 + n) * w.K + k0 + 8 * c) = o; }
    LDS_WAIT(); asm volatile("" ::: "memory");
}
constexpr int wc_items(int K, int Ndst) { return (K / 64) * (Ndst / 32); }
constexpr int WI_GU = wc_items(DM, NGU), WI_D = wc_items(FF, DM), WI_IN = wc_items(DM, NIN), WI_UQ = wc_items(512, 1280), WI_UKV = wc_items(256, 1536),
              WI_A = wc_items(768, DM), WI_B = wc_items(512, DM), WI_C = wc_items(256, DM), WI_OUT = wc_items(DM, DM);
constexpr int WI_TOTAL = 2 * WI_GU + 2 * WI_D + WI_IN + WI_UQ + WI_UKV + WI_A + WI_B + WI_C + WI_OUT;

__device__ __forceinline__ void phase_wconv(const Ctx& a, int l, LAS unsigned char* lds, int gw, int NGW, int wave, int lane) {
    LAS float* scr = (LAS float*)(lds + wave * 16384);
    bf16_t* W = (bf16_t*)(a.ws + WS_W);
    const size_t oFF = (size_t)l * DM * FF;
    for (int it = gw; it < WI_TOTAL; it += NGW) {
        int r = it; WMat w;
        if (r < WI_GU) { w = WMat{a.in(I_F1G) + oFF, a.in(I_F1U) + oFF, a.in(I_F1N) + (size_t)l * DM, W + W_GU1, DM, FF, NGU, 1}; }
        else if ((r -= WI_GU) < WI_GU) { w = WMat{a.in(I_F2G) + oFF, a.in(I_F2U) + oFF, a.in(I_F2N) + (size_t)l * DM, W + W_GU2, DM, FF, NGU, 1}; }
        else if ((r -= WI_GU) < WI_IN) { w = WMat{a.in(I_WIN) + (size_t)l * DM * 10832, nullptr, a.in(I_MIXN) + (size_t)l * DM, W + W_IN, DM, 10832, NIN, 2}; }
        else if ((r -= WI_IN) < WI_D) { w = WMat{a.in(I_F1D) + oFF, nullptr, nullptr, W + W_D1, FF, DM, DM, 0}; }
        else if ((r -= WI_D) < WI_D) { w = WMat{a.in(I_F2D) + oFF, nullptr, nullptr, W + W_D2, FF, DM, DM, 0}; }
        else if ((r -= WI_D) < WI_OUT) { w = WMat{a.in(I_WOUT) + (size_t)l * DM * DM, nullptr, nullptr, W + W_OUT, DM, DM, DM, 0}; }
        else if ((r -= WI_OUT) < WI_A) { w = WMat{a.in(I_WA) + (size_t)l * 768 * DM, nullptr, nullptr, W + W_A, 768, DM, DM, 0}; }
        else if ((r -= WI_A) < WI_B) { w = WMat{a.in(I_WB) + (size_t)l * 512 * DM, nullptr, nullptr, W + W_B, 512, DM, DM, 0}; }
        else if ((r -= WI_B) < WI_C) { w = WMat{a.in(I_WC) + (size_t)l * 256 * DM, nullptr, nullptr, W + W_C, 256, DM, DM, 0}; }
        else if ((r -= WI_C) < WI_UQ) { w = WMat{a.in(I_WUQ) + (size_t)l * 512 * 1152, nullptr, a.in(I_CQN) + (size_t)l * 512, W + W_UQ, 512, 1152, 1280, 0}; }
        else { r -= WI_UQ; w = WMat{a.in(I_WUKV) + (size_t)l * 256 * 1536, nullptr, a.in(I_CKVN) + (size_t)l * 256, W + W_UKV, 256, 1536, 1536, 0}; }
        wconv_item(w, r, scr, lane);
    }
}

__device__ __forceinline__ void phase_prologue(const Ctx& a, int gw, int NGW, int lane) {
    const int* pos = (const int*)a.in(I_POS);
    float* ropec = (float*)(a.ws + WS_ROPE); float* ropes = ropec + (size_t)MTOK * 32;
    const int i = lane & 31; const float invf = exp2f(-(float)i * 0.41524101186092029f);
    for (int p = gw; p < MTOK / 2; p += NGW) { const int tok = 2 * p + (lane >> 5); const float ang = (float)pos[tok] * invf; float sn, cs; sincosf(ang, &sn, &cs);
        ropec[(size_t)tok * 32 + i] = cs; ropes[(size_t)tok * 32 + i] = sn; }
    const float* x = a.in(I_X); bf16_t* xb = (bf16_t*)(a.ws + WS_XB); float* ssq = (float*)(a.ws + WS_SSQ);
    for (int m = gw; m < MTOK; m += NGW) { const f32x4* xr = (const f32x4*)(x + (size_t)m * DM) + lane; u32x2* o8 = (u32x2*)(xb + (size_t)m * DM) + lane; float s = 0.f;
#pragma unroll
        for (int j = 0; j < 8; ++j) { const f32x4 v = xr[64 * j]; s += (v[0] * v[0] + v[1] * v[1]) + (v[2] * v[2] + v[3] * v[3]); u32x2 w; w.x = pk2(v[0], v[1]); w.y = pk2(v[2], v[3]); o8[64 * j] = w; }
        s += __shfl_xor(s, 1); if ((lane & 1) == 0) ssq[(size_t)m * 32 + (lane >> 1)] = s; }
}

__device__ __forceinline__ void phase_prep(const Ctx& a, int l, int gw, int NGW, int lane) {
    bf16_t* u1 = (bf16_t*)(a.ws + WS_R2);
    const float* qraw = (const float*)(a.ws + WS_R3 + R3_QRAW); const float* kvraw = (const float*)(a.ws + WS_R3 + R3_KVRAW);
    const float* ropec = (const float*)(a.ws + WS_ROPE); const float* ropes = ropec + (size_t)MTOK * 32;
    bf16_t* Qo = (bf16_t*)(a.ws + WS_QKV + QKV_Q); bf16_t* Ko = (bf16_t*)(a.ws + WS_QKV + QKV_K); bf16_t* Vo = (bf16_t*)(a.ws + WS_QKV + QKV_V);
    const float* gq = a.in(I_QN) + (size_t)l * 192; const float* gk = a.in(I_KN) + (size_t)l * 192;
    const float gq0 = gq[lane], gq1 = gq[64 + lane], gq2 = gq[128 + lane], gk0 = gk[lane], gk1 = gk[64 + lane], gk2 = gk[128 + lane];
    const float* dq = a.in(I_DQN) + (size_t)l * 128; const float* dk = a.in(I_DKN) + (size_t)l * 128;
    const float dq0 = dq[2 * lane], dq1 = dq[2 * lane + 1], dk0 = dk[2 * lane], dk1 = dk[2 * lane + 1];
    for (int row = gw; row < MTOK; row += NGW) {
        bf16_t* ur = u1 + (size_t)row * U1W; const int b = row / SEQ, s = row % SEQ;
        float rstd_cq, rstd_ckv;
        { const bf16x8 v = *(const bf16x8*)(ur + C_CQ + lane * 8); float q = 0.f;
#pragma unroll
          for (int j = 0; j < 8; ++j) { const float f = bf2f((bf16_t)v[j]); q += f * f; }
          rstd_cq = rsqrtf(wave_sum(q) * (1.f / 512.f) + EPS); }
        { const s16x4 v = *(const s16x4*)(ur + C_CKV + lane * 4); float q = 0.f;
#pragma unroll
          for (int j = 0; j < 4; ++j) { const float f = bf2f((bf16_t)v[j]); q += f * f; }
          rstd_ckv = rsqrtf(wave_sum(q) * (1.f / 256.f) + EPS); }
        const float kr = bf2f(ur[C_KROPE + lane]); const float ssq_kr = wave_sum(kr * kr);
        const float cs = ropec[(size_t)row * 32 + (lane & 31)], sn = ropes[(size_t)row * 32 + (lane & 31)];
#pragma unroll 2
        for (int h = 0; h < 6; ++h) {
            const float* qp = qraw + (size_t)row * QRAW_LD + h * 192;
            float x0 = qp[lane] * rstd_cq, x1 = qp[64 + lane] * rstd_cq, x2 = qp[128 + lane] * rstd_cq;
            const float rq = rsqrtf(wave_sum(x0 * x0 + x1 * x1 + x2 * x2) * (1.f / 192.f) + EPS);
            x0 *= rq * gq0; x1 *= rq * gq1; x2 *= rq * gq2;
            const float xp = __shfl_xor(x2, 32); const float xr = lane < 32 ? x2 * cs - xp * sn : xp * sn + x2 * cs;
            bf16_t* qo = Qo + ((size_t)((b * 6 + h) * SEQ + s)) * 192;
            qo[lane] = (bf16_t)f2bf(x0 * QS_MLA); qo[64 + lane] = (bf16_t)f2bf(x1 * QS_MLA); qo[128 + lane] = (bf16_t)f2bf(xr * QS_MLA);
            const float* kp = kvraw + (size_t)row * KVRAW_LD + h * 256;
            float k0 = kp[lane] * rstd_ckv, k1 = kp[64 + lane] * rstd_ckv; const float v0 = kp[128 + lane] * rstd_ckv, v1 = kp[192 + lane] * rstd_ckv;
            const float rk = rsqrtf((wave_sum(k0 * k0 + k1 * k1) + ssq_kr) * (1.f / 192.f) + EPS);
            k0 *= rk * gk0; k1 *= rk * gk1; const float k2 = kr * rk * gk2;
            const float kx = __shfl_xor(k2, 32); const float kro = lane < 32 ? k2 * cs - kx * sn : kx * sn + k2 * cs;
            bf16_t* ko = Ko + ((size_t)((b * 6 + h) * SEQ + s)) * 192;
            ko[lane] = (bf16_t)f2bf(k0); ko[64 + lane] = (bf16_t)f2bf(k1); ko[128 + lane] = (bf16_t)f2bf(kro);
            bf16_t* vo = Vo + ((size_t)((b * 6 + h) * SEQ + s)) * 128;
            vo[lane] = (bf16_t)f2bf(v0); vo[64 + lane] = (bf16_t)f2bf(v1);
        }
#pragma unroll 2
        for (int h = 0; h < 6; ++h) {
            unsigned* qp = (unsigned*)(ur + C_QC + h * 128) + lane; unsigned* kp = (unsigned*)(ur + C_KC + h * 128) + lane;
            const unsigned qw = *qp, kw = *kp;
            float q0 = __uint_as_float(qw << 16), q1 = __uint_as_float(qw & 0xffff0000u), k0 = __uint_as_float(kw << 16), k1 = __uint_as_float(kw & 0xffff0000u);
            const float rq = rsqrtf(wave_sum(q0 * q0 + q1 * q1) * (1.f / 128.f) + EPS) * QS_DSWA, rk = rsqrtf(wave_sum(k0 * k0 + k1 * k1) * (1.f / 128.f) + EPS);
            *qp = pk2(q0 * rq * dq0, q1 * rq * dq1); *kp = pk2(k0 * rk * dk0, k1 * rk * dk1);
        }
    }
}

__device__ __forceinline__ float logsigmoidf_(float z) { return fminf(z, 0.f) - log1pf(expf(-fabsf(z))); }
__device__ __forceinline__ int crow32(int r, int hi) { return (r & 3) + 8 * (r >> 2) + 4 * hi; }
__device__ __forceinline__ void gla_local(const Ctx& a, int l, LAS unsigned char* lds, int G, int bid, const int wv) {
    int tid_ = wv * 64 + lane_id_v(); asm volatile("" : "+v"(tid_));
    const int tid = tid_, wid = __builtin_amdgcn_readfirstlane(tid >> 6), lane = tid & 63, l32 = lane & 31, hi = lane >> 5;
    LAS float* kd = (LAS float*)lds; LAS float* vv = (LAS float*)(lds + 16640); LAS float* tot = (LAS float*)(lds + 16640 + 32768);
    const bf16_t* u1 = (const bf16_t*)(a.ws + WS_R2);
    float* dS = (float*)(a.ws + WS_GLA + GLA_DS); float* bcum = (float*)(a.ws + WS_GLA + GLA_BC); float* dec = (float*)(a.ws + WS_GLA + GLA_DEC);
    const float* w2 = a.in(I_WG2) + (size_t)l * 16 * 256; const float* b2 = a.in(I_BG2) + (size_t)l * 256;
    const int d = lane, tg = wid;
    for (int ci = bid; ci < 2048; ci += G) {
        const int bh = ci >> 8, c = ci & 255, b = bh >> 2, h = bh & 3, row0 = b * SEQ + 64 * c;
        float w2c[16];
#pragma unroll
        for (int j = 0; j < 16; ++j) w2c[j] = w2[j * 256 + h * 64 + d];
        const float bias = b2[h * 64 + d];
        float bcv[8]; float run = 0.f;
#pragma unroll
        for (int i = 0; i < 8; ++i) { const int t = tg * 8 + i; const bf16_t* gl = u1 + (size_t)(row0 + t) * U1W + C_GLR;
            const bf16x8 g0 = *(const bf16x8*)gl, g1 = *(const bf16x8*)(gl + 8); float z = bias;
#pragma unroll
            for (int j = 0; j < 8; ++j) { z += bf2f((bf16_t)g0[j]) * w2c[j]; z += bf2f((bf16_t)g1[j]) * w2c[8 + j]; }
            run += logsigmoidf_(z) * (1.f / 16.f); bcv[i] = run; }
        tot[tg * 64 + d] = run;
        { const int t = tid >> 3, c0 = (tid & 7) * 16; const bf16_t* vp = u1 + (size_t)(row0 + t) * U1W + C_VB + h * 128 + c0;
          const bf16x8 v0 = *(const bf16x8*)vp, v1 = *(const bf16x8*)(vp + 8);
#pragma unroll
          for (int j = 0; j < 8; ++j) { vv[t * 128 + c0 + j] = bf2f((bf16_t)v0[j]); vv[t * 128 + c0 + 8 + j] = bf2f((bf16_t)v1[j]); } }
        __syncthreads();
        float off = 0.f, bend = 0.f;
#pragma unroll
        for (int g = 0; g < 8; ++g) { const float x = tot[g * 64 + d]; bend += x; if (g < tg) off += x; }
#pragma unroll
        for (int i = 0; i < 8; ++i) { const int t = tg * 8 + i; const float bc = bcv[i] + off;
            bcum[(size_t)(row0 + t) * 256 + h * 64 + d] = bc;
            const float kk = bf2f(u1[(size_t)(row0 + t) * U1W + C_KB + h * 64 + d]);
            kd[t * 65 + d] = kk * expf(bend - bc); }
        if (tg == 0) dec[(size_t)ci * 64 + d] = expf(bend);
        __syncthreads();
        { const int di = wid >> 2, ei = wid & 3; f32x16 acc = {};
#pragma unroll 8
          for (int s0 = 0; s0 < 64; s0 += 2) { const float av = kd[(s0 + hi) * 65 + 32 * di + l32], bv = vv[(s0 + hi) * 128 + 32 * ei + l32];
              acc = __builtin_amdgcn_mfma_f32_32x32x2f32(av, bv, acc, 0, 0, 0); }
          float* dst = dS + (size_t)ci * 8192;
#pragma unroll
          for (int r = 0; r < 16; ++r) dst[(32 * di + crow32(r, hi)) * 128 + 32 * ei + l32] = acc[r]; }
        __syncthreads();
    }
}
__device__ __forceinline__ void gla_scan(const Ctx& a, int bid, const int wv) {
    float* dS = (float*)(a.ws + WS_GLA + GLA_DS); const float* dec = (const float*)(a.ws + WS_GLA + GLA_DEC);
    int tid_ = wv * 64 + lane_id_v(); asm volatile("" : "+v"(tid_));
    const int gid = bid * NTHR + tid_, bh = gid >> 13, de = gid & 8191, d = de >> 7;
    float st = 0.f; float* p = dS + (size_t)bh * 256 * 8192 + de; const float* dc = dec + (size_t)bh * 256 * 64 + d;
    for (int c = 0; c < 256; c += 8) { float x[8], g[8];
#pragma unroll
        for (int i = 0; i < 8; ++i) { x[i] = p[(size_t)(c + i) * 8192]; g[i] = dc[(c + i) * 64]; }
#pragma unroll
        for (int i = 0; i < 8; ++i) { p[(size_t)(c + i) * 8192] = st; st = g[i] * st + x[i]; } }
}
__device__ __forceinline__ void gla_out(const Ctx& a, int l, LAS unsigned char* lds, int G, int bid, const int wv) {
    int tid_ = wv * 64 + lane_id_v(); asm volatile("" : "+v"(tid_));
    const int tid = tid_, wid = __builtin_amdgcn_readfirstlane(tid >> 6), lane = tid & 63, l32 = lane & 31, hi = lane >> 5;
    LAS float* qe = (LAS float*)lds; LAS float* ke = (LAS float*)(lds + 16640); LAS float* At = (LAS float*)(lds + 33280);
    LAS float* vv = (LAS float*)(lds + 49920); LAS float* Sp = (LAS float*)(lds + 82688);
    const bf16_t* u1 = (const bf16_t*)(a.ws + WS_R2);
    const float* dS = (const float*)(a.ws + WS_GLA + GLA_DS); const float* bcum = (const float*)(a.ws + WS_GLA + GLA_BC);
    bf16_t* yb = (bf16_t*)(a.ws + WS_R3 + R3_YB); const float* go = a.in(I_ON) + (size_t)l * 128;
    for (int ci = bid; ci < 2048; ci += G) {
        const int bh = ci >> 8, c = ci & 255, b = bh >> 2, h = bh & 3, row0 = b * SEQ + 64 * c;
        { const int d = lane, tg = wid;
#pragma unroll
          for (int i = 0; i < 8; ++i) { const int t = tg * 8 + i; const float bc = bcum[(size_t)(row0 + t) * 256 + h * 64 + d];
              const float q = bf2f(u1[(size_t)(row0 + t) * U1W + C_QB + h * 64 + d]), k = bf2f(u1[(size_t)(row0 + t) * U1W + C_KB + h * 64 + d]);
              qe[t * 65 + d] = q * 0.125f * expf(bc); ke[t * 65 + d] = k * expf(-bc); } }
        { const int t = tid >> 3, c0 = (tid & 7) * 16; const bf16_t* vp = u1 + (size_t)(row0 + t) * U1W + C_VB + h * 128 + c0;
          const bf16x8 v0 = *(const bf16x8*)vp, v1 = *(const bf16x8*)(vp + 8);
#pragma unroll
          for (int j = 0; j < 8; ++j) { vv[t * 128 + c0 + j] = bf2f((bf16_t)v0[j]); vv[t * 128 + c0 + 8 + j] = bf2f((bf16_t)v1[j]); }
          const f32x4* sp = (const f32x4*)(dS + (size_t)ci * 8192) + tid * 4;
#pragma unroll
          for (int j = 0; j < 4; ++j) *(LAS f32x4*)(Sp + tid * 16 + j * 4) = sp[j]; }
        __syncthreads();
        if (wid < 4) {
            if (wid < 3) { const int ti = wid == 0 ? 0 : 1, si = wid == 2 ? 1 : 0; f32x16 acc = {};
#pragma unroll 8
                for (int d0 = 0; d0 < 64; d0 += 2) { const float av = qe[(32 * ti + l32) * 65 + d0 + hi], bv = ke[(32 * si + l32) * 65 + d0 + hi];
                    acc = __builtin_amdgcn_mfma_f32_32x32x2f32(av, bv, acc, 0, 0, 0); }
#pragma unroll
                for (int r = 0; r < 16; ++r) { const int t = 32 * ti + crow32(r, hi), s = 32 * si + l32; At[t * 65 + s] = (s <= t) ? acc[r] : 0.f; } }
            else {
#pragma unroll
                for (int r = 0; r < 16; ++r) At[crow32(r, hi) * 65 + 32 + l32] = 0.f; }
        }
        __syncthreads();
        f32x16 acc = {}; const int ti = wid >> 2, ei = wid & 3;
#pragma unroll 8
        for (int s0 = 0; s0 < 64; s0 += 2) { const float av = At[(32 * ti + l32) * 65 + s0 + hi], bv = vv[(s0 + hi) * 128 + 32 * ei + l32];
            acc = __builtin_amdgcn_mfma_f32_32x32x2f32(av, bv, acc, 0, 0, 0); }
#pragma unroll 8
        for (int d0 = 0; d0 < 64; d0 += 2) { const float av = qe[(32 * ti + l32) * 65 + d0 + hi], bv = Sp[(d0 + hi) * 128 + 32 * ei + l32];
            acc = __builtin_amdgcn_mfma_f32_32x32x2f32(av, bv, acc, 0, 0, 0); }
        __syncthreads();
#pragma unroll
        for (int r = 0; r < 16; ++r) Sp[(32 * ti + crow32(r, hi)) * 128 + 32 * ei + l32] = acc[r];
        __syncthreads();
        { const int t = tid >> 3, e0 = (tid & 7) * 16; float ov[16]; float ss = 0.f;
#pragma unroll
          for (int j = 0; j < 4; ++j) { const f32x4 x = *(const LAS f32x4*)(Sp + t * 128 + e0 + 4 * j); ov[4 * j] = x[0]; ov[4 * j + 1] = x[1]; ov[4 * j + 2] = x[2]; ov[4 * j + 3] = x[3];
              ss += (x[0] * x[0] + x[1] * x[1]) + (x[2] * x[2] + x[3] * x[3]); }
          ss += __shfl_xor(ss, 1); ss += __shfl_xor(ss, 2); ss += __shfl_xor(ss, 4);
          const float rs = rsqrtf(ss * (1.f / 128.f) + EPS);
          const bf16_t* rp = u1 + (size_t)(row0 + t) * U1W + C_RB + h * 128 + e0; const bf16x8 r0 = *(const bf16x8*)rp, r1 = *(const bf16x8*)(rp + 8);
          unsigned w[8];
#pragma unroll
          for (int j = 0; j < 4; ++j) { w[j] = pk2(ov[2 * j] * rs * go[e0 + 2 * j] * bf2f((bf16_t)r0[2 * j]), ov[2 * j + 1] * rs * go[e0 + 2 * j + 1] * bf2f((bf16_t)r0[2 * j + 1]));
              w[4 + j] = pk2(ov[8 + 2 * j] * rs * go[e0 + 8 + 2 * j] * bf2f((bf16_t)r1[2 * j]), ov[8 + 2 * j + 1] * rs * go[e0 + 8 + 2 * j + 1] * bf2f((bf16_t)r1[2 * j + 1])); }
          u32x4* yo = (u32x4*)(yb + (size_t)(row0 + t) * 512 + h * 128 + e0);
          yo[0] = (u32x4){w[0], w[1], w[2], w[3]}; yo[1] = (u32x4){w[4], w[5], w[6], w[7]}; }
        __syncthreads();
    }
}
__device__ __forceinline__ void dswa_combine(const Ctx& a, int gw, int NGW, int lane) {
    const bf16_t* dout = (const bf16_t*)(a.ws + WS_R3 + R3_DO); const float* lse = (const float*)(a.ws + WS_R3 + R3_LSE); bf16_t* yc = (bf16_t*)(a.ws + WS_R3 + R3_YC);
    const int hp = lane >> 5, e = 4 * (lane & 31);
    for (int row = gw; row < MTOK; row += NGW) {
        const float l0 = lse[(size_t)row * 6 + hp], l1 = lse[(size_t)row * 6 + 2 + hp], l2 = lse[(size_t)row * 6 + 4 + hp];
        const float mx = fmaxf(l0, fmaxf(l1, l2)); float w0 = expf(l0 - mx), w1 = expf(l1 - mx), w2 = expf(l2 - mx); const float inv = 1.f / (w0 + w1 + w2); w0 *= inv; w1 *= inv; w2 *= inv;
        const u32x2 a0 = *(const u32x2*)(dout + (size_t)row * 768 + hp * 128 + e), a1 = *(const u32x2*)(dout + (size_t)row * 768 + (2 + hp) * 128 + e), a2 = *(const u32x2*)(dout + (size_t)row * 768 + (4 + hp) * 128 + e);
        float o[4];
        o[0] = w0 * __uint_as_float(a0.x << 16) + w1 * __uint_as_float(a1.x << 16) + w2 * __uint_as_float(a2.x << 16);
        o[1] = w0 * __uint_as_float(a0.x & 0xffff0000u) + w1 * __uint_as_float(a1.x & 0xffff0000u) + w2 * __uint_as_float(a2.x & 0xffff0000u);
        o[2] = w0 * __uint_as_float(a0.y << 16) + w1 * __uint_as_float(a1.y << 16) + w2 * __uint_as_float(a2.y << 16);
        o[3] = w0 * __uint_as_float(a0.y & 0xffff0000u) + w1 * __uint_as_float(a1.y & 0xffff0000u) + w2 * __uint_as_float(a2.y & 0xffff0000u);
        u32x2 w; w.x = pk2(o[0], o[1]); w.y = pk2(o[2], o[3]); *(u32x2*)(yc + (size_t)row * 256 + hp * 128 + e) = w;
    }
}

constexpr int N_MLA_UNITS = 12 * 64, N_DSWA_UNITS = 12 * 64, N_ATT_UNITS = N_MLA_UNITS + N_DSWA_UNITS;
__device__ __forceinline__ void phase_attention(const Ctx& a, int l, LAS unsigned char* lds, volatile LAS unsigned* qword, const int wv) {
    const int tid0 = wv * 64 + lane_id_v();
    unsigned* head = (unsigned*)(a.ws + WS_CTL) + CW_QUEUE + 64 * l;
    const bf16_t* u1 = (const bf16_t*)(a.ws + WS_R2);
    for (;;) {
        if (tid0 == 0) *qword = __hip_atomic_fetch_add(head, 1u, __ATOMIC_RELAXED, __HIP_MEMORY_SCOPE_AGENT);
        __syncthreads();
        const int uid = (int)__builtin_amdgcn_readfirstlane(*qword);
        if (uid >= N_ATT_UNITS) break;
        att::AUnit u;
        if (uid < N_MLA_UNITS) {
            const int qb = 63 - uid / 12, bh = uid % 12, b = bh / 6, h = bh % 6;
            u.Q = (const bf16_t*)(a.ws + WS_QKV + QKV_Q) + ((size_t)bh * SEQ + 256 * qb) * 192; u.qpitch = 192;
            u.K = (const bf16_t*)(a.ws + WS_QKV + QKV_K) + (size_t)bh * SEQ * 192; u.kpitch = 192;
            u.V = (const bf16_t*)(a.ws + WS_QKV + QKV_V) + (size_t)bh * SEQ * 128; u.vpitch = 128;
            u.O = (bf16_t*)(a.ws + WS_R3 + R3_YA) + ((size_t)(b * SEQ + 256 * qb)) * 768 + h * 128; u.opitch = 768;
            u.lse = nullptr; u.lsepitch = 0; u.q0 = 256 * qb; u.j_lo = 0; u.j_hi = 4 * qb + 4; u.bias_c = 0.f;
            att::attn_unit<192, 0>(lds, u, wv);
        } else {
            const int v = uid - N_MLA_UNITS, b = v / 384, hh = (v / 64) % 6, idx = v % 64, g = hh >> 1, dil = g == 0 ? 1 : (g == 1 ? 4 : 16), nb = 64 / dil, r = idx / nb, qb = idx % nb;
            const size_t tok0 = (size_t)b * SEQ + r;
            u.Q = u1 + (tok0 + (size_t)256 * qb * dil) * U1W + C_QC + hh * 128; u.qpitch = (size_t)dil * U1W;
            u.K = u1 + tok0 * U1W + C_KC + hh * 128; u.kpitch = (size_t)dil * U1W;
            u.V = u1 + tok0 * U1W + C_VC + hh * 128; u.vpitch = (size_t)dil * U1W;
            u.O = (bf16_t*)(a.ws + WS_R3 + R3_DO) + (tok0 + (size_t)256 * qb * dil) * 768 + hh * 128; u.opitch = (size_t)dil * 768;
            u.lse = (float*)(a.ws + WS_R3 + R3_LSE) + (tok0 + (size_t)256 * qb * dil) * 6 + hh; u.lsepitch = (size_t)dil * 6;
            u.q0 = 256 * qb; u.j_lo = 4 * qb - 2 > 0 ? 4 * qb - 2 : 0; u.j_hi = 4 * qb + 4;
            u.bias_c = exp2f(-8.f * (float)(hh + 1) / 6.f) * (float)dil * LOG2E;
            att::attn_unit<128, 1>(lds, u, wv);
        }
    }
    __syncthreads();
}

constexpr int NPL = 12, NPH = 1 + NPL * DEPTH;
__global__ void __launch_bounds__(NTHR, 2) hybrid_fwd(Args args) {
    extern __shared__ __attribute__((aligned(16))) unsigned char lds_raw[];
    LAS unsigned char* lds = (LAS unsigned char*)lds_raw;
    const int tid = threadIdx.x;
    const int wv = __builtin_amdgcn_readfirstlane(tid >> 6);
    const int G = gridDim.x, bid = blockIdx.x, NGW = G * NWAVES;
#define LAUNDER() int tz_ = lane_id_v(); asm volatile("" : "+v"(tz_)); const int lane = tz_, wave = wv, gw = bid * NWAVES + wave
    volatile LAS unsigned* lctl = (volatile LAS unsigned*)(lds + LDSCTL_OFF);
    for (int u = tid; u < (LDS_BYTES - LDSCTL_OFF) / 4; u += NTHR) lctl[u] = 0u;
    __syncthreads();
    const int lo = args.ph_lo, hi = args.ph_hi;
    unsigned* ctl = (unsigned*)(args.ws + WS_CTL);
    XcdBarrier bar; bar.bar = ctl + CW_BAR; bar.x = 0; bar.st = lctl + 8; bar.wv = wv;
    if (hi - lo > 1) bar = xcd_barrier_post(ctl + CW_BAR, lctl + 8, wv);
#ifndef PH_MASK
#define PH_MASK 0xFFFF
#endif
#define IN(k) (lo <= (k) && (k) < hi)
#define EN(j) ((PH_MASK >> (j)) & 1)
#define SEAM(k) do { if (IN(k) && IN((k) + 1)) xcd_barrier(bar); } while (0)
    unsigned char* ws = args.ws;
    volatile LAS unsigned long long* ptab = (volatile LAS unsigned long long*)(lds + LDSCTL_OFF + 256);
    if (tid < 27) ptab[tid] = (unsigned long long)args.in[tid];
    __syncthreads();
    Ctx cx; cx.ws = ws; cx.ptab = ptab;
    bf16_t* W = (bf16_t*)(ws + WS_W);
    bf16_t* xb = (bf16_t*)(ws + WS_XB); float* ssq = (float*)(ws + WS_SSQ);
    bf16_t* h1 = (bf16_t*)(ws + WS_R1); bf16_t* u2 = (bf16_t*)(ws + WS_R1);
    bf16_t* u1 = (bf16_t*)(ws + WS_R2); float* m32 = (float*)(ws + WS_R2);
    bf16_t* mb = (bf16_t*)(ws + WS_QKV);
    float* qraw = (float*)(ws + WS_R3 + R3_QRAW); float* kvraw = (float*)(ws + WS_R3 + R3_KVRAW);
    bf16_t* ya = (bf16_t*)(ws + WS_R3 + R3_YA); bf16_t* yb = (bf16_t*)(ws + WS_R3 + R3_YB); bf16_t* yc = (bf16_t*)(ws + WS_R3 + R3_YC);
    float* xres = args.out;

    if (EN(12) && IN(0)) { LAUNDER(); phase_prologue(cx, gw, NGW, lane); phase_wconv(cx, 0, lds, gw, NGW, wave, lane); }
    SEAM(0);
    for (int l = 0; l < DEPTH; ++l) {
        const int pb = 1 + NPL * l;
        if (EN(0) && IN(pb + 0)) { LAUNDER(); if (l > 0) phase_wconv(cx, l, lds, gw, NGW, wave, lane); }
        SEAM(pb + 0);
        if (EN(1) && IN(pb + 1)) {
            pg8::Gemm g{xb, W + W_GU1, MTOK, NGU, DM, DM}; pg8::StaticOrder S; S.init(MTOK, NGU, G, bid);
            pg8::EpiSwiGLU E{ssq, h1, FF};
            pg8::gemm_phase<pg8::EpiSwiGLU, pg8::StaticOrder, true, true>(lds, g, S, E, wv);
        }
        SEAM(pb + 1);
        if (EN(2) && IN(pb + 2)) {
            pg8::Gemm g{h1, W + W_D1, MTOK, DM, FF, FF}; pg8::StaticOrder S; S.init(MTOK, DM, G, bid);
            pg8::EpiResid E{l == 0 ? cx.in(I_X) : (const float*)xres, xres, xb, ssq, 0.5f};
            pg8::gemm_phase<pg8::EpiResid, pg8::StaticOrder, true, true>(lds, g, S, E, wv);
        }
        SEAM(pb + 2);
        if (EN(3) && IN(pb + 3)) {
            pg8::Gemm g{xb, W + W_IN, MTOK, NIN, DM, DM}; pg8::StaticOrder S; S.init(MTOK, NIN, G, bid);
            pg8::EpiWin E{ssq, u1, u2, U1W, U2W};
            pg8::gemm_phase<pg8::EpiWin, pg8::StaticOrder, true, true>(lds, g, S, E, wv);
        }
        SEAM(pb + 3);
        if (EN(4) && IN(pb + 4)) {
            { pg8::Gemm g{u1 + C_CQ, W + W_UQ, MTOK, 1280, 512, U1W}; pg8::StaticOrder S; S.init(MTOK, 1280, G, bid);
              pg8::EpiF32 E{qraw, QRAW_LD};
              pg8::gemm_phase<pg8::EpiF32, pg8::StaticOrder, true, true>(lds, g, S, E, wv); }
            { pg8::Gemm g{u1 + C_CKV, W + W_UKV, MTOK, 1536, 256, U1W}; pg8::StaticOrder S; S.init(MTOK, 1536, G, bid);
              pg8::EpiF32 E{kvraw, KVRAW_LD};
              pg8::gemm_phase<pg8::EpiF32, pg8::StaticOrder, true, true>(lds, g, S, E, wv); }
        }
        SEAM(pb + 4);
        if (EN(5) && IN(pb + 5)) { LAUNDER(); phase_prep(cx, l, gw, NGW, lane); gla_local(cx, l, lds, G, bid, wv); }
        SEAM(pb + 5);
        if (EN(6) && IN(pb + 6)) { if (bid < 128) gla_scan(cx, bid, wv); phase_attention(cx, l, lds, lctl + 16, wv); }
        SEAM(pb + 6);
        if (EN(7) && IN(pb + 7)) { LAUNDER(); gla_out(cx, l, lds, G, bid, wv); dswa_combine(cx, gw, NGW, lane); }
        SEAM(pb + 7);
        if (EN(8) && IN(pb + 8)) {
            { pg8::Gemm g{ya, W + W_A, MTOK, DM, 768, 768}; pg8::StaticOrder S; S.init(MTOK, DM, G, bid);
              pg8::EpiMerge<0> E{u2, U2W, m32, mb};
              pg8::gemm_phase<pg8::EpiMerge<0>, pg8::StaticOrder, true, true>(lds, g, S, E, wv); }
            { pg8::Gemm g{yb, W + W_B, MTOK, DM, 512, 512}; pg8::StaticOrder S; S.init(MTOK, DM, G, bid);
              pg8::EpiMerge<1> E{u2 + 2048, U2W, m32, mb};
              pg8::gemm_phase<pg8::EpiMerge<1>, pg8::StaticOrder, true, true>(lds, g, S, E, wv); }
            { pg8::Gemm g{yc, W + W_C, MTOK, DM, 256, 256}; pg8::StaticOrder S; S.init(MTOK, DM, G, bid);
              pg8::EpiMerge<2> E{u2 + 4096, U2W, m32, mb};
              pg8::gemm_phase<pg8::EpiMerge<2>, pg8::StaticOrder, true, true>(lds, g, S, E, wv); }
        }
        SEAM(pb + 8);
        if (EN(9) && IN(pb + 9)) {
            pg8::Gemm g{mb, W + W_OUT, MTOK, DM, DM, DM}; pg8::StaticOrder S; S.init(MTOK, DM, G, bid);
            pg8::EpiResid E{xres, xres, xb, ssq, 1.0f};
            pg8::gemm_phase<pg8::EpiResid, pg8::StaticOrder, true, true>(lds, g, S, E, wv);
        }
        SEAM(pb + 9);
        if (EN(10) && IN(pb + 10)) {
            pg8::Gemm g{xb, W + W_GU2, MTOK, NGU, DM, DM}; pg8::StaticOrder S; S.init(MTOK, NGU, G, bid);
            pg8::EpiSwiGLU E{ssq, h1, FF};
            pg8::gemm_phase<pg8::EpiSwiGLU, pg8::StaticOrder, true, true>(lds, g, S, E, wv);
        }
        SEAM(pb + 10);
        if (EN(11) && IN(pb + 11)) {
            pg8::Gemm g{h1, W + W_D2, MTOK, DM, FF, FF}; pg8::StaticOrder S; S.init(MTOK, DM, G, bid);
            pg8::EpiResid E{xres, xres, xb, ssq, 0.5f};
            pg8::gemm_phase<pg8::EpiResid, pg8::StaticOrder, true, true>(lds, g, S, E, wv);
        }
        SEAM(pb + 11);
    }
#undef IN
#undef SEAM
}

extern "C" void kernel_launch(void* const* d_in, const int* in_sizes, int n_in, void* d_out, int out_size, void* d_ws, size_t ws_size, hipStream_t stream) {
    static int grid = 0;
    if (grid == 0) {
        if (n_in != 27 || out_size != MTOK * DM || ws_size < WS_END) { fprintf(stderr, "kernel_launch: unexpected problem: n_in %d out %d ws %zu (need %zu)\n", n_in, out_size, ws_size, (size_t)WS_END); grid = -1; return; }
        int dev = 0, cus = 0, per_cu = 0;
        if (hipGetDevice(&dev) != hipSuccess || hipDeviceGetAttribute(&cus, hipDeviceAttributeMultiprocessorCount, dev) != hipSuccess) { grid = -1; return; }
        if (hipFuncSetAttribute((const void*)hybrid_fwd, hipFuncAttributeMaxDynamicSharedMemorySize, LDS_BYTES) != hipSuccess) { fprintf(stderr, "kernel_launch: hipFuncSetAttribute failed\n"); grid = -1; return; }
        if (hipOccupancyMaxActiveBlocksPerMultiprocessor(&per_cu, (const void*)hybrid_fwd, NTHR, LDS_BYTES) != hipSuccess || per_cu < 1)
            fprintf(stderr, "kernel_launch: occupancy query reports %d workgroups per CU\n", per_cu);
        (void)hipGetLastError();
        grid = cus;
    }
    if (grid < 0) return;
    if (hipMemsetAsync((char*)d_ws + WS_CTL, 0, CTL_BYTES, stream) != hipSuccess) return;
    Args a{};
    for (int i = 0; i < 27; ++i) a.in[i] = (const float*)d_in[i];
    a.out = (float*)d_out; a.ws = (unsigned char*)d_ws;
#if MK_SINGLE
    a.ph_lo = 0; a.ph_hi = NPH;
    hipLaunchKernelGGL(hybrid_fwd, dim3(grid), dim3(NTHR), LDS_BYTES, stream, a);
#else
    for (int p = 0; p < NPH; ++p) { a.ph_lo = p; a.ph_hi = p + 1; hipLaunchKernelGGL(hybrid_fwd, dim3(grid), dim3(NTHR), LDS_BYTES, stream, a); }
#endif
    const hipError_t le = hipPeekAtLastError();
    if (le != hipSuccess) fprintf(stderr, "kernel_launch: launch failed: %s\n", hipGetErrorName(le));
}
```

```cpp
#include <hip/hip_runtime.h>
#include <cstdio>
#include <cstdint>

#ifndef PG8_ASM_STAGE
#define PG8_ASM_STAGE 0
#endif
#ifndef MK_SINGLE
#define MK_SINGLE 1
#endif

__device__ __forceinline__ int lane_id_v() { int x; asm volatile("v_mbcnt_lo_u32_b32 %0, -1, 0\n\tv_mbcnt_hi_u32_b32 %0, -1, %0" : "=v"(x)); return x; }
namespace pg8 {
#define PG8_LAS __attribute__((address_space(3)))
typedef unsigned short bf16_t;
typedef short bf16x8 __attribute__((ext_vector_type(8)));
typedef float f32x4 __attribute__((ext_vector_type(4)));
typedef unsigned u32x4 __attribute__((ext_vector_type(4)));
constexpr int BM = 256, BK = 64, HALF = 128, HTB = HALF * BK * 2  , STAGE_BYTES = 8 * HTB, NXCD = 8, WGM = 8;

__host__ __device__ __forceinline__ int lds_byte(int r, int c) { const int st = (r >> 4) * 2 + (c >> 5), rr = r & 15, cc = c & 31, ob = rr * 64 + cc * 2; return st * 1024 + (ob ^ (((ob >> 9) & 1) << 5)); }
__host__ __device__ __forceinline__ void stage_rc(int b, int& R, int& C) { const int st = b / 1024, sb = b % 1024, swz = sb ^ (((sb >> 9) & 1) << 5); R = (st >> 1) * 16 + swz / 64; C = (st & 1) * 32 + (swz % 64) / 2; }
__host__ __device__ __forceinline__ int perm32(int rho) { const int n = rho >> 4, i = rho & 15; return 8 * (i >> 2) + 4 * n + (i & 3); }

struct Unit { int pm, pn; };
struct Gemm { const bf16_t* A; const bf16_t* Bt; int M, N, K, lda; };

struct StaticOrder {
    int nM, nN, nwg, G, c;
    __host__ __device__ void init(int M, int N, int G_, int c_) { nM = M / BM; nN = N / BM; nwg = nM * nN; G = G_; c = c_; }
    __host__ __device__ bool next(int i, Unit& u) const {
        const long L = (long)i * G + c; if (L >= nwg) return false;
        int wgid = (int)L; { const int q = nwg / NXCD, r = nwg % NXCD, xcd = wgid % NXCD, off = wgid / NXCD; wgid = (xcd < r ? xcd * (q + 1) : r * (q + 1) + (xcd - r) * q) + off; }
        const int nig = WGM * nN, gid = wgid / nig, fm = gid * WGM, gsz = (nM - fm) < WGM ? (nM - fm) : WGM;
        u.pm = fm + ((wgid % nig) % gsz); u.pn = (wgid % nig) / gsz; return true;
    }
    __device__ __forceinline__ void a_ready(const Unit&) const {}
    __device__ __forceinline__ void done(const Unit&) const {}
};
__device__ __forceinline__ unsigned cvt_pk_bf16(float lo, float hi) { unsigned r; asm volatile("v_cvt_pk_bf16_f32 %0, %1, %2" : "=v"(r) : "v"(lo), "v"(hi)); return r; }

template <class Epi, class Sched, bool ALIGN_EPI = false, bool SP2 = false>
__device__ __forceinline__ void gemm_phase(PG8_LAS unsigned char* lds, const Gemm g, const Sched& S, const Epi& E, const int wv) {
    int tid_ = wv * 64 + lane_id_v(); asm volatile("" : "+v"(tid_));
    const int tid = tid_, wid = __builtin_amdgcn_readfirstlane(tid >> 6), lane = tid & 63, wr = wid >> 2, wc = wid & 3, fr = lane & 15, fq = lane >> 4;
    const int K = g.K, nt = K / BK;
    unsigned voffA[2], voffB[2];
#pragma unroll
    for (int i = 0; i < 2; ++i) { int R, C; stage_rc(tid * 16 + i * 8192, R, C); const int Rb = Epi::PERM ? ((R & ~31) + perm32(R & 31)) : R;
        voffA[i] = (unsigned)(R * g.lda + C) * 2u; voffB[i] = (unsigned)(Rb * K + C) * 2u; }
    const size_t kstep = (size_t)(BK * 2);
    const size_t hstep = (size_t)HALF * K * 2, hstepA = (size_t)HALF * g.lda * 2;
    const size_t tstep = 2 * hstep, tstepA = 2 * hstepA;
    const unsigned ldsw = (unsigned)wid * 1024u;
    const int aoff = lds_byte(wr * 64 + fr, fq * 8), boff = lds_byte(wc * 32 + fr, fq * 8);
#define PG8_SA(b, h) (((b) * 2 + (h)) * HTB)
#define PG8_SB(b, h) ((4 + (b) * 2 + (h)) * HTB)
#if PG8_ASM_STAGE
#define PG8_STAGE(bufoff, gbase, voff) do { const unsigned m0a_ = (unsigned)(size_t)(lds + (bufoff)) + ldsw; const char* gb_ = (const char*)(gbase); \
        asm volatile("s_mov_b32 m0, %2\n\ts_nop 0\n\tglobal_load_lds_dwordx4 %0, %1" :: "v"((voff)[0]), "s"(gb_), "s"(m0a_) : "memory", "m0"); \
        asm volatile("s_add_i32 m0, %2, 0x2000\n\ts_nop 0\n\tglobal_load_lds_dwordx4 %0, %1" :: "v"((voff)[1]), "s"(gb_), "s"(m0a_) : "memory", "m0", "scc"); } while (0)
#else
#define PG8_STAGE(bufoff, gbase, voff) do { _Pragma("unroll") for (int _i = 0; _i < 2; ++_i) \
        __builtin_amdgcn_global_load_lds((const unsigned*)((const char*)(gbase) + (voff)[_i]), (PG8_LAS unsigned*)(lds + (bufoff) + ldsw + _i * 8192), 16, 0, 0); } while (0)
#endif
#define PG8_LDA(dst, b, h) do { _Pragma("unroll") for (int m = 0; m < 4; ++m) _Pragma("unroll") for (int k = 0; k < 2; ++k) dst[m][k] = *(const PG8_LAS bf16x8*)(lds + PG8_SA(b, h) + aoff + m * 2048 + k * 1024); } while (0)
#define PG8_LDB(dst, b, h) do { _Pragma("unroll") for (int n = 0; n < 2; ++n) _Pragma("unroll") for (int k = 0; k < 2; ++k) dst[n][k] = *(const PG8_LAS bf16x8*)(lds + PG8_SB(b, h) + boff + n * 2048 + k * 1024); } while (0)
#define PG8_MMA(ai, bj, At, Bt) do { __builtin_amdgcn_s_setprio(1); _Pragma("unroll") for (int m = 0; m < 4; ++m) _Pragma("unroll") for (int n = 0; n < 2; ++n) _Pragma("unroll") for (int k = 0; k < 2; ++k) \
        acc[ai][bj][m][n] = __builtin_amdgcn_mfma_f32_16x16x32_bf16(Bt[n][k], At[m][k], acc[ai][bj][m][n], 0, 0, 0); __builtin_amdgcn_s_setprio(0); } while (0)
#define PG8_WAIT_V(n) asm volatile("s_waitcnt vmcnt(" #n ")" ::: "memory")
#define PG8_WAIT_L(n) asm volatile("s_waitcnt lgkmcnt(" #n ")" ::: "memory")
#define PG8_BAR __builtin_amdgcn_s_barrier()
#define PG8_SCHED __builtin_amdgcn_sched_barrier(0)
    Unit cur, nxt; int ui = 0;
    if (!S.next(0, cur)) return;
    f32x4 acc[2][2][4][2];
#pragma unroll
    for (int a = 0; a < 2; ++a)
#pragma unroll
        for (int b = 0; b < 2; ++b)
#pragma unroll
            for (int m = 0; m < 4; ++m)
#pragma unroll
                for (int n = 0; n < 2; ++n) acc[a][b][m][n] = (f32x4){0.f, 0.f, 0.f, 0.f};
    bf16x8 At[4][2], B0[2][2], B1[2][2];
    const char* cA = (const char*)g.A + (size_t)cur.pm * tstepA; const char* cB = (const char*)g.Bt + (size_t)cur.pn * tstep;
    S.a_ready(cur);
    if constexpr (SP2) {
        PG8_STAGE(PG8_SB(0, 0), cB, voffB); PG8_STAGE(PG8_SB(0, 1), cB + hstep, voffB); PG8_STAGE(PG8_SA(0, 0), cA, voffA); PG8_STAGE(PG8_SA(0, 1), cA + hstepA, voffA);
        if (wr == 1) PG8_BAR;
        PG8_WAIT_V(2); PG8_BAR;
        PG8_STAGE(PG8_SB(1, 0), cB + kstep, voffB); PG8_STAGE(PG8_SA(1, 0), cA + kstep, voffA); PG8_STAGE(PG8_SB(1, 1), cB + hstep + kstep, voffB);
        PG8_WAIT_V(6); PG8_BAR;
    } else {
        PG8_STAGE(PG8_SB(0, 0), cB, voffB); PG8_STAGE(PG8_SA(0, 0), cA, voffA); PG8_STAGE(PG8_SB(0, 1), cB + hstep, voffB); PG8_STAGE(PG8_SA(0, 1), cA + hstepA, voffA);
        if (wr == 1) PG8_BAR;
        PG8_WAIT_V(4); PG8_BAR;
        PG8_STAGE(PG8_SB(1, 0), cB + kstep, voffB); PG8_STAGE(PG8_SA(1, 0), cA + kstep, voffA); PG8_STAGE(PG8_SB(1, 1), cB + hstep + kstep, voffB);
        PG8_WAIT_V(6); PG8_BAR;
    }
    for (;;) {
        const bool has_next = S.next(ui + 1, nxt);
        const char* nA = has_next ? (const char*)g.A + (size_t)nxt.pm * tstepA : cA; const char* nB = has_next ? (const char*)g.Bt + (size_t)nxt.pn * tstep : cB;
        for (int t = 0; t < nt; t += 2) {
            const bool last = (t == nt - 2);
            const char* a1 = cA + (size_t)(t + 1) * kstep;
            const char* a2 = last ? nA : cA + (size_t)(t + 2) * kstep; const char* b2 = last ? nB : cB + (size_t)(t + 2) * kstep;
            const char* a3 = a2 + kstep; const char* b3 = b2 + kstep;
            if (last && has_next) S.a_ready(nxt);
            if constexpr (SP2) {
            PG8_LDB(B0, 0, 0); PG8_LDB(B1, 0, 1); PG8_SCHED; PG8_LDA(At, 0, 0); PG8_STAGE(PG8_SA(1, 1), a1 + hstepA, voffA);
            PG8_WAIT_V(8); PG8_WAIT_L(0); PG8_BAR; PG8_MMA(0, 0, At, B0); PG8_MMA(0, 1, At, B1); PG8_BAR; PG8_SCHED;
            PG8_LDA(At, 0, 1); PG8_STAGE(PG8_SB(0, 0), b2, voffB); PG8_STAGE(PG8_SB(0, 1), b2 + hstep, voffB); PG8_STAGE(PG8_SA(0, 0), a2, voffA);
            PG8_WAIT_V(8); PG8_WAIT_L(0); PG8_BAR; PG8_MMA(1, 0, At, B0); PG8_MMA(1, 1, At, B1); PG8_BAR; PG8_SCHED;
            PG8_LDB(B0, 1, 0); PG8_LDB(B1, 1, 1); PG8_SCHED; PG8_LDA(At, 1, 0); PG8_STAGE(PG8_SA(0, 1), a2 + hstepA, voffA);
            PG8_WAIT_V(8); PG8_WAIT_L(0); PG8_BAR; PG8_MMA(0, 0, At, B0); PG8_MMA(0, 1, At, B1); PG8_BAR; PG8_SCHED;
            PG8_LDA(At, 1, 1); PG8_STAGE(PG8_SB(1, 0), b3, voffB); PG8_STAGE(PG8_SB(1, 1), b3 + hstep, voffB); PG8_STAGE(PG8_SA(1, 0), a3, voffA);
            PG8_WAIT_V(8); PG8_WAIT_L(0); PG8_BAR; PG8_MMA(1, 0, At, B0); PG8_MMA(1, 1, At, B1); PG8_BAR; PG8_SCHED;
            } else {
            PG8_LDB(B0, 0, 0); PG8_SCHED; PG8_LDA(At, 0, 0); PG8_STAGE(PG8_SA(1, 1), a1 + hstepA, voffA);
            PG8_WAIT_L(8); PG8_BAR; PG8_WAIT_L(0); PG8_MMA(0, 0, At, B0); PG8_BAR; PG8_SCHED;
            PG8_LDB(B1, 0, 1); PG8_STAGE(PG8_SB(0, 0), b2, voffB);
            PG8_BAR; PG8_WAIT_L(0); PG8_MMA(0, 1, At, B1); PG8_BAR;
            PG8_LDA(At, 0, 1); PG8_STAGE(PG8_SA(0, 0), a2, voffA);
            PG8_BAR; PG8_WAIT_L(0); PG8_MMA(1, 0, At, B0); PG8_BAR; PG8_SCHED;
            PG8_STAGE(PG8_SB(0, 1), b2 + hstep, voffB);
            PG8_WAIT_V(6); PG8_BAR; PG8_MMA(1, 1, At, B1); PG8_BAR;
            PG8_LDB(B0, 1, 0); PG8_SCHED; PG8_LDA(At, 1, 0); PG8_STAGE(PG8_SA(0, 1), a2 + hstepA, voffA);
            PG8_WAIT_L(8); PG8_BAR; PG8_WAIT_L(0); PG8_MMA(0, 0, At, B0); PG8_BAR; PG8_SCHED;
            PG8_LDB(B1, 1, 1); PG8_STAGE(PG8_SB(1, 0), b3, voffB);
            PG8_BAR; PG8_WAIT_L(0); PG8_MMA(0, 1, At, B1); PG8_BAR;
            PG8_LDA(At, 1, 1); PG8_STAGE(PG8_SA(1, 0), a3, voffA);
            PG8_BAR; PG8_WAIT_L(0); PG8_MMA(1, 0, At, B0); PG8_BAR; PG8_SCHED;
            PG8_STAGE(PG8_SB(1, 1), b3 + hstep, voffB);
            PG8_WAIT_V(6); PG8_BAR; PG8_MMA(1, 1, At, B1); PG8_BAR;
            }
        }
        if constexpr (ALIGN_EPI) { if (wr == 0) PG8_BAR; }
        if constexpr (!Epi::AFTER_DRAIN) { const int ln_ = lane_id_v(); E(acc, cur, wr, wc, ln_ & 15, ln_ >> 4); S.done(cur); }
        if (!has_next) break;
#pragma unroll
        for (int a = 0; a < 2; ++a)
#pragma unroll
            for (int b = 0; b < 2; ++b)
#pragma unroll
                for (int m = 0; m < 4; ++m)
#pragma unroll
                    for (int n = 0; n < 2; ++n) acc[a][b][m][n] = (f32x4){0.f, 0.f, 0.f, 0.f};
        cur = nxt; cA = nA; cB = nB; ++ui;
        if constexpr (ALIGN_EPI) { if (wr == 1) PG8_BAR; }
    }
    PG8_WAIT_V(0);
    if constexpr (!ALIGN_EPI) { if (wr == 0) PG8_BAR; }
    PG8_BAR;
    if constexpr (Epi::AFTER_DRAIN) { E.fused(acc, cur, wr, wc, fr, fq, lds, wid, lane); S.done(cur); }
#undef PG8_SA
#undef PG8_SB
#undef PG8_STAGE
#undef PG8_LDA
#undef PG8_LDB
#undef PG8_MMA
#undef PG8_WAIT_V
#undef PG8_WAIT_L
#undef PG8_BAR
#undef PG8_SCHED
}

constexpr float NORM_EPS = 1e-6f;
__device__ __forceinline__ float row_rstd(const float* ssq, int row, int fq) {
    const f32x4 a = *(const f32x4*)(ssq + (size_t)row * 32 + fq * 8), b = *(const f32x4*)(ssq + (size_t)row * 32 + fq * 8 + 4);
    float s = ((a[0] + a[1]) + (a[2] + a[3])) + ((b[0] + b[1]) + (b[2] + b[3]));
    s += __shfl_xor(s, 16); s += __shfl_xor(s, 32);
    return rsqrtf(s * (1.0f / 2048.0f) + NORM_EPS);
}
__device__ __forceinline__ float fsigmoid(float x) { return __builtin_amdgcn_rcpf(1.0f + __expf(-x)); }
__device__ __forceinline__ u32x4 pack8(const f32x4 v0, const f32x4 v1) { u32x4 w; w.x = cvt_pk_bf16(v0[0], v0[1]); w.y = cvt_pk_bf16(v0[2], v0[3]); w.z = cvt_pk_bf16(v1[0], v1[1]); w.w = cvt_pk_bf16(v1[2], v1[3]); return w; }
__device__ __forceinline__ void unpack8(const u32x4 w, f32x4& v0, f32x4& v1) {
    v0[0] = __uint_as_float(w.x << 16); v0[1] = __uint_as_float(w.x & 0xffff0000u); v0[2] = __uint_as_float(w.y << 16); v0[3] = __uint_as_float(w.y & 0xffff0000u);
    v1[0] = __uint_as_float(w.z << 16); v1[1] = __uint_as_float(w.z & 0xffff0000u); v1[2] = __uint_as_float(w.w << 16); v1[3] = __uint_as_float(w.w & 0xffff0000u); }

struct EpiSwiGLU {
    static constexpr bool PERM = true, AFTER_DRAIN = false;
    const float* ssq; bf16_t* H; int ldh;
    __device__ __forceinline__ void operator()(const f32x4 (&acc)[2][2][4][2], const Unit& u, int wr, int wc, int fr, int fq) const {
        const int row0 = u.pm * BM + wr * 64 + fr, col0 = u.pn * HALF + wc * 32 + 8 * fq;
        float rs[2][4];
#pragma unroll
        for (int ai = 0; ai < 2; ++ai)
#pragma unroll
            for (int m = 0; m < 4; ++m) rs[ai][m] = row_rstd(ssq, row0 + ai * HALF + m * 16, fq);
#pragma unroll
        for (int ai = 0; ai < 2; ++ai)
#pragma unroll
            for (int m = 0; m < 4; ++m) { const int row = row0 + ai * HALF + m * 16; const float r = rs[ai][m];
                f32x4 h0, h1;
#pragma unroll
                for (int j = 0; j < 4; ++j) { const float g0 = acc[ai][0][m][0][j] * r, g1 = acc[ai][0][m][1][j] * r;
                    h0[j] = g0 * fsigmoid(g0) * (acc[ai][1][m][0][j] * r); h1[j] = g1 * fsigmoid(g1) * (acc[ai][1][m][1][j] * r); }
                *(u32x4*)(H + (size_t)row * ldh + col0) = pack8(h0, h1); }
    }
};
struct EpiResid {
    static constexpr bool PERM = true, AFTER_DRAIN = false;
    const float* base; float* out; bf16_t* xb; float* ssq; float alpha;
    __device__ __forceinline__ void operator()(const f32x4 (&acc)[2][2][4][2], const Unit& u, int wr, int wc, int fr, int fq) const {
        const int row0 = u.pm * BM + wr * 64 + fr, col0 = u.pn * BM + wc * 32 + 8 * fq;
#pragma unroll
        for (int ai = 0; ai < 2; ++ai) {
            f32x4 bv[4][2][2];
#pragma unroll
            for (int m = 0; m < 4; ++m)
#pragma unroll
                for (int bj = 0; bj < 2; ++bj) { const size_t off = (size_t)(row0 + ai * HALF + m * 16) * 2048 + col0 + bj * HALF;
                    bv[m][bj][0] = *(const f32x4*)(base + off); bv[m][bj][1] = *(const f32x4*)(base + off + 4); }
#pragma unroll
            for (int m = 0; m < 4; ++m) { const int row = row0 + ai * HALF + m * 16; float ss = 0.f;
#pragma unroll
                for (int bj = 0; bj < 2; ++bj) { const size_t off = (size_t)row * 2048 + col0 + bj * HALF;
                    const f32x4 v0 = bv[m][bj][0] + acc[ai][bj][m][0] * alpha, v1 = bv[m][bj][1] + acc[ai][bj][m][1] * alpha;
                    *(f32x4*)(out + off) = v0; *(f32x4*)(out + off + 4) = v1;
                    ss += ((v0[0] * v0[0] + v0[1] * v0[1]) + (v0[2] * v0[2] + v0[3] * v0[3])) + ((v1[0] * v1[0] + v1[1] * v1[1]) + (v1[2] * v1[2] + v1[3] * v1[3]));
                    *(u32x4*)(xb + off) = pack8(v0, v1); }
                ss += __shfl_xor(ss, 16); ss += __shfl_xor(ss, 32);
                if (fq == 0) ssq[(size_t)row * 32 + u.pn * 4 + wc] = ss; }
            asm volatile("" ::: "memory"); }
    }
};
struct EpiWin {
    static constexpr bool PERM = true, AFTER_DRAIN = false;
    const float* ssq; bf16_t* u1; bf16_t* u2; int ld1, ld2;
    __device__ __forceinline__ void operator()(const f32x4 (&acc)[2][2][4][2], const Unit& u, int wr, int wc, int fr, int fq) const {
        const int row0 = u.pm * BM + wr * 64 + fr; const int mode = u.pn < 17 ? 0 : (u.pn < 19 ? 1 : 2);
        bf16_t* dst = mode == 2 ? u2 : u1; const int ld = mode == 2 ? ld2 : ld1; const int col0 = (mode == 2 ? (u.pn - 19) : u.pn) * BM + wc * 32 + 8 * fq;
        float rsv[2][4];
#pragma unroll
        for (int ai = 0; ai < 2; ++ai)
#pragma unroll
            for (int m = 0; m < 4; ++m) rsv[ai][m] = row_rstd(ssq, row0 + ai * HALF + m * 16, fq);
#pragma unroll
        for (int ai = 0; ai < 2; ++ai)
#pragma unroll
            for (int m = 0; m < 4; ++m) { const int row = row0 + ai * HALF + m * 16; const float rs = rsv[ai][m];
#pragma unroll
                for (int bj = 0; bj < 2; ++bj) { f32x4 v0 = acc[ai][bj][m][0] * rs, v1 = acc[ai][bj][m][1] * rs;
                    if (mode == 1) {
#pragma unroll
                        for (int j = 0; j < 4; ++j) { v0[j] = v0[j] * fsigmoid(v0[j]); v1[j] = v1[j] * fsigmoid(v1[j]); } }
                    else if (mode == 2) {
#pragma unroll
                        for (int j = 0; j < 4; ++j) { v0[j] = fsigmoid(v0[j]); v1[j] = fsigmoid(v1[j]); } }
                    *(u32x4*)(dst + (size_t)row * ld + col0 + bj * HALF) = pack8(v0, v1); } }
    }
};
struct EpiF32 {
    static constexpr bool PERM = false, AFTER_DRAIN = false;
    float* C; int ldc;
    __device__ __forceinline__ void operator()(const f32x4 (&acc)[2][2][4][2], const Unit& u, int wr, int wc, int fr, int fq) const {
        const int row0 = u.pm * BM + wr * 64 + fr, col0 = u.pn * BM + wc * 32 + 4 * fq;
#pragma unroll
        for (int ai = 0; ai < 2; ++ai)
#pragma unroll
            for (int m = 0; m < 4; ++m) { float* rowp = C + (size_t)(row0 + ai * HALF + m * 16) * ldc + col0;
#pragma unroll
                for (int bj = 0; bj < 2; ++bj)
#pragma unroll
                    for (int n = 0; n < 2; ++n) *(f32x4*)(rowp + bj * HALF + n * 16) = acc[ai][bj][m][n]; }
    }
};
template <int MODE> struct EpiMerge {
    static constexpr bool PERM = true, AFTER_DRAIN = false;
    const bf16_t* gate; int ldg; float* m32; bf16_t* mb;
    __device__ __forceinline__ void operator()(const f32x4 (&acc)[2][2][4][2], const Unit& u, int wr, int wc, int fr, int fq) const {
        const int row0 = u.pm * BM + wr * 64 + fr, col0 = u.pn * BM + wc * 32 + 8 * fq;
#pragma unroll
        for (int ai = 0; ai < 2; ++ai)
#pragma unroll
            for (int mp = 0; mp < 2; ++mp) {
                u32x4 gw[2][2]; f32x4 mv[2][2][2];
#pragma unroll
                for (int mi = 0; mi < 2; ++mi)
#pragma unroll
                    for (int bj = 0; bj < 2; ++bj) { const int row = row0 + ai * HALF + (2 * mp + mi) * 16, col = col0 + bj * HALF; const size_t off = (size_t)row * 2048 + col;
                        gw[mi][bj] = *(const u32x4*)(gate + (size_t)row * ldg + col);
                        if (MODE >= 1) { mv[mi][bj][0] = *(const f32x4*)(m32 + off); mv[mi][bj][1] = *(const f32x4*)(m32 + off + 4); } }
#pragma unroll
                for (int mi = 0; mi < 2; ++mi)
#pragma unroll
                    for (int bj = 0; bj < 2; ++bj) { const int m = 2 * mp + mi; const int row = row0 + ai * HALF + m * 16, col = col0 + bj * HALF; const size_t off = (size_t)row * 2048 + col;
                        f32x4 g0, g1; unpack8(gw[mi][bj], g0, g1);
                        f32x4 v0 = g0 * acc[ai][bj][m][0], v1 = g1 * acc[ai][bj][m][1];
                        if (MODE >= 1) { v0 += mv[mi][bj][0]; v1 += mv[mi][bj][1]; }
                        if (MODE <= 1) { *(f32x4*)(m32 + off) = v0; *(f32x4*)(m32 + off + 4) = v1; }
                        else *(u32x4*)(mb + off) = pack8(v0, v1); }
                asm volatile("" ::: "memory"); }
    }
};
}

#define GAS __attribute__((address_space(1)))
#define LAS __attribute__((address_space(3)))
typedef unsigned short bf16_t;
typedef short bf16x8 __attribute__((ext_vector_type(8)));
typedef short s16x4 __attribute__((ext_vector_type(4)));
typedef float f32x4 __attribute__((ext_vector_type(4)));
typedef float f32x16 __attribute__((ext_vector_type(16)));
typedef unsigned u32x4 __attribute__((ext_vector_type(4)));
typedef unsigned u32x2 __attribute__((ext_vector_type(2)));
#define LDS_WAIT() asm volatile("s_waitcnt lgkmcnt(0)" ::: "memory")
#define VM_WAIT() asm volatile("s_waitcnt vmcnt(0)" ::: "memory")
#define SBAR() __builtin_amdgcn_sched_barrier(0)
__device__ __forceinline__ unsigned f2bf(float f) { unsigned u = __builtin_bit_cast(unsigned, f); return (u + 0x7fffu + ((u >> 16) & 1u)) >> 16; }
__device__ __forceinline__ float bf2f(bf16_t b) { return __uint_as_float(((unsigned)b) << 16); }
__device__ __forceinline__ unsigned pk2(float lo, float hi) { return f2bf(lo) | (f2bf(hi) << 16); }
__device__ __forceinline__ float wave_sum(float v) {
#pragma unroll
    for (int o = 1; o < 64; o <<= 1) v += __shfl_xor(v, o);
    return v;
}

constexpr int NB = 2, SEQ = 16384, MTOK = NB * SEQ, DM = 2048, FF = 5504, DEPTH = 4;
constexpr int NGU = 2 * FF, NIN = 11008, U1W = 4864, U2W = 6144;
constexpr int C_CQ = 0, C_CKV = 512, C_QB = 768, C_KB = 1024, C_VB = 1280, C_QC = 1792, C_KC = 2560, C_VC = 3328, C_KROPE = 4096, C_GLR = 4160, C_RB = 4352;
constexpr int QRAW_LD = 1280, KVRAW_LD = 1536;
constexpr float EPS = 1e-6f, LOG2E = 1.4426950408889634f, LN2 = 0.6931471805599453f;
constexpr float QS_MLA = 0.07216878364870322f * LOG2E;
constexpr float QS_DSWA = 0.08838834764831845f * LOG2E;

namespace att {
constexpr int SHM_V = 64 * 128 * 2;
constexpr int K_OFF = 2 * SHM_V;
template <int DQK> struct Geo { static constexpr int KP = DQK * 2 + 16, SHM_K = 64 * KP, NCH = DQK / 8, NKST = (64 * NCH) / 512, WS_OFF = K_OFF + 2 * SHM_K; };
__device__ __forceinline__ int v_st(int k, int c) { const int kk = (k & ~0xC) | ((k & 4) << 1) | ((k & 8) >> 1); return ((kk >> 3) * 4 + (c >> 5)) * 512 + ((kk & 7) * 32 + (c & 31)) * 2; }
__device__ __forceinline__ int v_rd_base(int lane) { return ((lane & 3) << 3) | (((lane >> 2) & 3) << 6) | (((lane >> 4) & 1) << 5) | (((lane >> 5) & 1) << 8); }
constexpr int v_rd_off(int d0, int ks, int half) { return d0 * 512 + ks * 4096 + half * 2048; }
__device__ __forceinline__ int crow(int r, int hi) { return (r & 3) + 8 * (r >> 2) + 4 * hi; }
__device__ __forceinline__ unsigned cvtpk(float lo, float hi) { unsigned r; asm volatile("v_cvt_pk_bf16_f32 %0, %1, %2" : "=v"(r) : "v"(lo), "v"(hi)); return r; }

__device__ __forceinline__ void pv_tile(f32x16* o, int vb, bf16x8 pa0, bf16x8 pa1, bf16x8 pa2, bf16x8 pa3) {
#define TRRD(dst, off) asm volatile("ds_read_b64_tr_b16 %0, %1 offset:%2" : "=&v"(dst) : "v"(vb), "i"(off) : "memory")
#define PV_D0(d0) do { s16x4 l0, l1, l2, l3, h0, h1, h2, h3; constexpr int b_ = v_rd_off(d0, 0, 0); \
        TRRD(l0, b_); TRRD(h0, b_ + 2048); TRRD(l1, b_ + 4096); TRRD(h1, b_ + 6144); TRRD(l2, b_ + 8192); TRRD(h2, b_ + 10240); TRRD(l3, b_ + 12288); TRRD(h3, b_ + 14336); \
        asm volatile("s_waitcnt lgkmcnt(0)" ::: "memory"); SBAR(); \
        o[d0] = __builtin_amdgcn_mfma_f32_32x32x16_bf16(pa0, (bf16x8){l0[0], l0[1], l0[2], l0[3], h0[0], h0[1], h0[2], h0[3]}, o[d0], 0, 0, 0); \
        o[d0] = __builtin_amdgcn_mfma_f32_32x32x16_bf16(pa1, (bf16x8){l1[0], l1[1], l1[2], l1[3], h1[0], h1[1], h1[2], h1[3]}, o[d0], 0, 0, 0); \
        o[d0] = __builtin_amdgcn_mfma_f32_32x32x16_bf16(pa2, (bf16x8){l2[0], l2[1], l2[2], l2[3], h2[0], h2[1], h2[2], h2[3]}, o[d0], 0, 0, 0); \
        o[d0] = __builtin_amdgcn_mfma_f32_32x32x16_bf16(pa3, (bf16x8){l3[0], l3[1], l3[2], l3[3], h3[0], h3[1], h3[2], h3[3]}, o[d0], 0, 0, 0); } while (0)
    PV_D0(0); PV_D0(1); PV_D0(2); PV_D0(3);
#undef PV_D0
#undef TRRD
}

struct AUnit { const bf16_t* Q; const bf16_t* K; const bf16_t* V; bf16_t* O; float* lse; size_t qpitch, kpitch, vpitch, opitch, lsepitch; int q0, j_lo, j_hi; float bias_c; };

template <int DQK, int MODE>
__device__ __forceinline__ void attn_unit(LAS unsigned char* lds, const AUnit& u, const int wv) {
    using G = Geo<DQK>;
    int tid_ = wv * 64 + lane_id_v(); asm volatile("" : "+v"(tid_));
    const int tid = tid_, wid = __builtin_amdgcn_readfirstlane(tid >> 6), lane = tid & 63, r32 = lane & 31, hi = lane >> 5;
    LAS unsigned char* V_lds = lds; LAS unsigned char* K_lds = lds + K_OFF;
    LAS float* wsl = (LAS float*)(lds + G::WS_OFF) + wid * 64; LAS float* li_l = wsl; LAS float* al_l = wsl + 32;
    bf16x8 qr[DQK / 16];
    { const bf16_t* qrow = u.Q + (size_t)(wid * 32 + r32) * u.qpitch + hi * 8;
#pragma unroll
      for (int d0 = 0; d0 < DQK / 16; ++d0) qr[d0] = *(const bf16x8*)(qrow + d0 * 16); }
    float m_reg = -1e30f, l_reg = 0.f; f32x16 o[4] = {};
    bf16x8 stk[G::NKST], stv0, stv1;
    const int sr = tid >> 4, sc = (tid & 15) * 8, vst0 = v_st(sr, sc), vst1 = v_st(32 + sr, sc);
    const int vb0 = (int)(size_t)V_lds + v_rd_base(lane);
    const int qlo = u.q0 + wid * 32, qj = qlo + r32;
#define ST_LOAD(t) do { const int k0_ = (t) * 64; _Pragma("unroll") for (int i_ = 0; i_ < G::NKST; ++i_) { const int cid_ = tid + 512 * i_, row_ = cid_ / G::NCH, ch_ = cid_ % G::NCH; \
            stk[i_] = *(const bf16x8*)(u.K + (size_t)(k0_ + row_) * u.kpitch + ch_ * 8); } \
        stv0 = *(const bf16x8*)(u.V + (size_t)(k0_ + sr) * u.vpitch + sc); stv1 = *(const bf16x8*)(u.V + (size_t)(k0_ + 32 + sr) * u.vpitch + sc); } while (0)
#define ST_WRITE(bf) do { _Pragma("unroll") for (int i_ = 0; i_ < G::NKST; ++i_) { const int cid_ = tid + 512 * i_, row_ = cid_ / G::NCH, ch_ = cid_ % G::NCH; \
            *(LAS bf16x8*)(K_lds + (bf) * G::SHM_K + row_ * G::KP + ch_ * 16) = stk[i_]; } \
        *(LAS bf16x8*)(V_lds + (bf) * SHM_V + vst0) = stv0; *(LAS bf16x8*)(V_lds + (bf) * SHM_V + vst1) = stv1; } while (0)
    ST_LOAD(u.j_lo);
    for (int t = u.j_lo; t < u.j_hi; ++t) {
        const int buf = (t - u.j_lo) & 1;
        VM_WAIT(); ST_WRITE(buf);
        __syncthreads();
        if (t + 1 < u.j_hi) ST_LOAD(t + 1);
        f32x16 p0 = {}, p1 = {};
        { const LAS unsigned char* kb = K_lds + buf * G::SHM_K + r32 * G::KP + hi * 16;
#pragma unroll
          for (int d0 = 0; d0 < DQK / 16; ++d0) { const bf16x8 b0 = *(const LAS bf16x8*)(kb + d0 * 32), b1 = *(const LAS bf16x8*)(kb + 32 * G::KP + d0 * 32);
              p0 = __builtin_amdgcn_mfma_f32_32x32x16_bf16(b0, qr[d0], p0, 0, 0, 0);
              p1 = __builtin_amdgcn_mfma_f32_32x32x16_bf16(b1, qr[d0], p1, 0, 0, 0); } }
        const float NEG = -__builtin_inff(); const int kb0 = t * 64;
        if (MODE == 0) {
            if (kb0 + 63 > qlo) {
#pragma unroll
                for (int r = 0; r < 16; ++r) { const int key = kb0 + (r & 3) + 8 * (r >> 2) + 4 * hi; if (key > qj) p0[r] = NEG; if (key + 32 > qj) p1[r] = NEG; } }
        } else {
#pragma unroll
            for (int r = 0; r < 16; ++r) { const int dist = qj - (kb0 + (r & 3) + 8 * (r >> 2) + 4 * hi), dist2 = dist - 32;
                p0[r] = ((unsigned)dist <= 128u) ? p0[r] - u.bias_c * (float)dist : NEG;
                p1[r] = ((unsigned)dist2 <= 128u) ? p1[r] - u.bias_c * (float)dist2 : NEG; }
        }
        float pmax = p0[0];
#pragma unroll
        for (int r = 1; r < 16; ++r) pmax = fmaxf(pmax, p0[r]);
#pragma unroll
        for (int r = 0; r < 16; ++r) pmax = fmaxf(pmax, p1[r]);
        { auto rr = __builtin_amdgcn_permlane32_swap(__float_as_uint(pmax), __float_as_uint(pmax), false, false); pmax = fmaxf(__uint_as_float(rr[0]), __uint_as_float(rr[1])); }
        const float mn = fmaxf(m_reg, pmax); const float alpha = __builtin_amdgcn_exp2f(m_reg - mn); m_reg = mn;
#pragma unroll
        for (int r = 0; r < 16; ++r) { p0[r] = __builtin_amdgcn_exp2f(p0[r] - mn); p1[r] = __builtin_amdgcn_exp2f(p1[r] - mn); }
        float ps = 0.f;
#pragma unroll
        for (int r = 0; r < 16; ++r) ps += p0[r] + p1[r];
        { auto rr = __builtin_amdgcn_permlane32_swap(__float_as_uint(ps), __float_as_uint(ps), false, false); ps = __uint_as_float(rr[0]) + __uint_as_float(rr[1]); }
        l_reg = l_reg * alpha + ps;
        bf16x8 pa0, pa1, pa2, pa3;
#define PK4(P, B_, OUT) do { unsigned a0 = cvtpk(P[B_ + 0], P[B_ + 1]), a1 = cvtpk(P[B_ + 2], P[B_ + 3]); unsigned b0 = cvtpk(P[B_ + 4], P[B_ + 5]), b1 = cvtpk(P[B_ + 6], P[B_ + 7]); \
        auto r0 = __builtin_amdgcn_permlane32_swap(a0, b0, false, false); auto r1 = __builtin_amdgcn_permlane32_swap(a1, b1, false, false); \
        u32x4 w = {r0[0], r1[0], r0[1], r1[1]}; OUT = *reinterpret_cast<bf16x8*>(&w); } while (0)
        PK4(p0, 0, pa0); PK4(p0, 8, pa1); PK4(p1, 0, pa2); PK4(p1, 8, pa3);
#undef PK4
        if (__any(alpha < 1.f)) { if (hi == 0) al_l[r32] = alpha; LDS_WAIT();
#pragma unroll
            for (int r = 0; r < 16; ++r) { const float a = al_l[(r & 3) + 8 * (r >> 2) + 4 * hi];
#pragma unroll
                for (int d = 0; d < 4; ++d) o[d][r] *= a; } }
        pv_tile(o, vb0 + buf * SHM_V, pa0, pa1, pa2, pa3);
    }
    if (hi == 0) li_l[r32] = l_reg; LDS_WAIT();
    float rli[16];
#pragma unroll
    for (int r = 0; r < 16; ++r) rli[r] = __builtin_amdgcn_rcpf(li_l[(r & 3) + 8 * (r >> 2) + 4 * hi]);
    bf16_t* Ow = u.O + (size_t)(wid * 32) * u.opitch;
#pragma unroll
    for (int r = 0; r < 16; ++r) { const int orow = (r & 3) + 8 * (r >> 2) + 4 * hi;
#pragma unroll
        for (int d0 = 0; d0 < 4; ++d0) { const float v = o[d0][r] * rli[r]; const float vn = __shfl_xor(v, 1);
            if ((r32 & 1) == 0) *(unsigned*)(Ow + (size_t)orow * u.opitch + d0 * 32 + r32) = cvtpk(v, vn); } }
    if (MODE == 1) { if (hi == 0) u.lse[(size_t)(wid * 32 + r32) * u.lsepitch] = (m_reg + __log2f(l_reg)) * LN2; }
    __syncthreads();
#undef ST_LOAD
#undef ST_WRITE
}
}

constexpr size_t al256(size_t x) { return (x + 255) & ~(size_t)255; }
constexpr size_t WS_CTL = 0, CTL_BYTES = 1u << 20;
constexpr size_t WS_ROPE = WS_CTL + CTL_BYTES;
constexpr size_t WS_SSQ = WS_ROPE + al256((size_t)MTOK * 64 * 4);
constexpr size_t WS_XB = WS_SSQ + al256((size_t)MTOK * 32 * 4);
constexpr size_t WS_W = WS_XB + al256((size_t)MTOK * DM * 2);
constexpr size_t W_GU1 = 0, W_D1 = W_GU1 + (size_t)NGU * DM, W_IN = W_D1 + (size_t)DM * FF, W_UQ = W_IN + (size_t)NIN * DM, W_UKV = W_UQ + (size_t)1280 * 512,
                 W_A = W_UKV + (size_t)1536 * 256, W_B = W_A + (size_t)DM * 768, W_C = W_B + (size_t)DM * 512, W_OUT = W_C + (size_t)DM * 256, W_GU2 = W_OUT + (size_t)DM * DM,
                 W_D2 = W_GU2 + (size_t)NGU * DM, W_END = W_D2 + (size_t)DM * FF;
constexpr size_t WS_R1 = WS_W + al256(W_END * 2);
constexpr size_t WS_R2 = WS_R1 + al256((size_t)MTOK * U2W * 2);
constexpr size_t WS_QKV = WS_R2 + al256((size_t)MTOK * U1W * 2);
constexpr size_t QKV_Q = 0, QKV_K = (size_t)NB * 6 * SEQ * 192 * 2, QKV_V = 2 * QKV_K, QKV_END = QKV_V + (size_t)NB * 6 * SEQ * 128 * 2;
constexpr size_t WS_R3 = WS_QKV + al256(QKV_END);
constexpr size_t R3_QRAW = 0, R3_KVRAW = (size_t)MTOK * QRAW_LD * 4, R3_END = R3_KVRAW + (size_t)MTOK * KVRAW_LD * 4;
constexpr size_t R3_YA = 0, R3_YB = R3_YA + (size_t)MTOK * 768 * 2, R3_YC = R3_YB + (size_t)MTOK * 512 * 2, R3_DO = R3_YC + (size_t)MTOK * 256 * 2, R3_LSE = R3_DO + (size_t)MTOK * 768 * 2;
static_assert(R3_LSE + (size_t)MTOK * 6 * 4 <= R3_END, "R3 overlay");
constexpr size_t WS_GLA = WS_R3 + al256(R3_END);
constexpr size_t GLA_DS = 0, GLA_BC = (size_t)2048 * 8192 * 4, GLA_DEC = GLA_BC + (size_t)MTOK * 256 * 4, GLA_END = GLA_DEC + (size_t)2048 * 64 * 4;
constexpr size_t WS_END = WS_GLA + al256(GLA_END);
constexpr int CW_BAR = 1024;
constexpr int CW_QUEUE = 16384;

constexpr int RING_BYTES = 131072, LDSCTL_OFF = RING_BYTES, LDS_BYTES = 147456;
constexpr int NWAVES = 8, NTHR = 512;

#define XB_TMO      128
#define XB_XCNT(j)  (256  + 64 * (j))
#define XB_XSUB(j)  (1280 + 64 * (j))
#define XB_XGEN(j)  (2304 + 64 * (j))
#define XB_TOP      3328
#define XB_TOPGEN   3392
#define XCD_BAR_WORDS 3456
#define XB_SPIN_CAP (1u << 20)
__device__ __forceinline__ unsigned xb_ld(unsigned* p)              { return __hip_atomic_load(p, __ATOMIC_RELAXED, __HIP_MEMORY_SCOPE_AGENT); }
__device__ __forceinline__ unsigned xb_add(unsigned* p, unsigned v) { return __hip_atomic_fetch_add(p, v, __ATOMIC_RELAXED, __HIP_MEMORY_SCOPE_AGENT); }
__device__ __forceinline__ unsigned xb_xcc_id() { return (unsigned)__builtin_amdgcn_s_getreg((3 << 11) | 20) & 0xFu; }
#define XB_SPIN(cond, bar) do { unsigned _sp = 0; while (cond) { __builtin_amdgcn_s_sleep(1); \
    if ((++_sp & 255u) == 0u) { if (xb_ld(&(bar)[XB_TMO])) break; if (_sp > XB_SPIN_CAP) { atomicAdd(&(bar)[XB_TMO], 1u); break; } } } } while (0)
struct XcdBarrier { unsigned* bar; unsigned x; volatile LAS unsigned* st; int wv; };
__device__ __forceinline__ bool xb_thread0(int wv) { return wv == 0 && lane_id_v() == 0; }
__device__ __forceinline__ XcdBarrier xcd_barrier_post(unsigned* bar, volatile LAS unsigned* st, int wv) {
    XcdBarrier b; b.bar = bar; b.x = xb_xcc_id(); b.st = st; b.wv = wv;
    if (xb_thread0(wv)) (void)xb_add(&bar[XB_XCNT(b.x)], 1u);
    return b;
}
__device__ __forceinline__ void xcd_barrier_complete(unsigned* bar, unsigned x, unsigned& nloc, unsigned& nx) {
    const unsigned G = gridDim.x * gridDim.y * gridDim.z;
    unsigned sum, cnt, mine, sp = 0u;
    for (;;) {
        sum = 0u; cnt = 0u; mine = 0u;
#pragma unroll
        for (unsigned j = 0; j < 16; ++j) { const unsigned c = xb_ld(&bar[XB_XCNT(j)]); sum += c; cnt += (c > 0u) ? 1u : 0u; mine = (j == x) ? c : mine; }
        if (sum == G) break;
        __builtin_amdgcn_s_sleep(1);
        if ((++sp & 255u) == 0u) { if (xb_ld(&bar[XB_TMO])) break; if (sp > XB_SPIN_CAP) { atomicAdd(&bar[XB_TMO], 1u); break; } }
    }
    nloc = mine > 0u ? mine : 1u; nx = cnt > 0u ? cnt : 1u;
}
template <bool FIRST> __device__ __forceinline__ void xcd_barrier(const XcdBarrier& b) {
    asm volatile("s_waitcnt vmcnt(0)" ::: "memory");
    __syncthreads();
    if (xb_thread0(b.wv)) {
        unsigned* bar = b.bar;
        __builtin_amdgcn_s_waitcnt(0);
        unsigned nloc = b.st[0], nx = b.st[1];
        if (FIRST) { xcd_barrier_complete(bar, b.x, nloc, nx); b.st[0] = nloc; b.st[1] = nx; }
        const unsigned old = xb_add(&bar[XB_XSUB(b.x)], 1u);
        const unsigned gen = old / nloc;
        if (old + 1u == (gen + 1u) * nloc) {
            __builtin_amdgcn_fence(__ATOMIC_RELEASE, "agent");
            asm volatile("s_waitcnt vmcnt(0)" ::: "memory");
            const unsigned og = xb_add(&bar[XB_TOP], 1u);
            const unsigned tg = og / nx;
            if (og + 1u == (tg + 1u) * nx) xb_add(&bar[XB_TOPGEN], 1u);
            else XB_SPIN(xb_ld(&bar[XB_TOPGEN]) == tg, bar);
            __builtin_amdgcn_fence(__ATOMIC_ACQUIRE, "agent");
            xb_add(&bar[XB_XGEN(b.x)], 1u);
            asm volatile("s_waitcnt vmcnt(0)" ::: "memory");
        } else {
            XB_SPIN(xb_ld(&bar[XB_XGEN(b.x)]) == gen, bar);
            __builtin_amdgcn_fence(__ATOMIC_ACQUIRE, "agent");
            asm volatile("s_waitcnt vmcnt(0)" ::: "memory");
        }
    }
    __syncthreads();
}

struct Args { const float* in[27]; float* out; unsigned char* ws; int ph_lo, ph_hi, qsel, pad; };
struct Ctx { unsigned char* ws; volatile LAS unsigned long long* ptab;
    __device__ __forceinline__ const float* in(int i) const { const unsigned long long v = ptab[i];
        const unsigned lo = __builtin_amdgcn_readfirstlane((unsigned)v), hi = __builtin_amdgcn_readfirstlane((unsigned)(v >> 32)); return (const float*)(((unsigned long long)hi << 32) | lo); } };
enum { I_X = 0, I_POS, I_F1N, I_F1G, I_F1U, I_F1D, I_MIXN, I_WIN, I_CQN, I_CKVN, I_WUQ, I_WUKV, I_QN, I_KN, I_WG2, I_BG2, I_ON, I_DQN, I_DKN, I_WA, I_WB, I_WC, I_WOUT, I_F2N, I_F2G, I_F2U, I_F2D };

__device__ __forceinline__ int win_map(int n) {
    if (n < 768) return n;
    if (n < 1024) return 832 + (n - 768);
    if (n < 1280) return 1088 + (n - 1024);
    if (n < 1792) return 1344 + (n - 1280);
    if (n < 2560) return 2384 + (n - 1792);
    if (n < 3328) return 3152 + (n - 2560);
    if (n < 4096) return 3920 + (n - 3328);
    if (n < 4160) return 768 + (n - 4096);
    if (n < 4176) return 1856 + (n - 4160);
    if (n < 4352) return -1;
    if (n < 4864) return 1872 + (n - 4352);
    return 4688 + (n - 4864);
}
struct WMat { const float* src; const float* src2; const float* gain; bf16_t* dst; int K, Nsrc, Ndst, kind; };
__device__ __forceinline__ void wconv_item(const WMat& w, int item, LAS float* scr, int lane) {
    const int nblk = w.Ndst / 32, kb = item / nblk, nb = item % nblk, k0 = 64 * kb, n0 = 32 * nb;
    const int cq = lane & 7, kr = lane >> 3, nn = n0 + 4 * cq;
    const float* sp = w.src; int scol = nn; bool valid = true;
    if (w.kind == 1) { const int tile = nn >> 8; int wi = nn & 255; if (wi >= 128) { sp = w.src2; wi -= 128; } scol = tile * 128 + wi; }
    else if (w.kind == 2) { scol = win_map(nn); valid = scol >= 0; }
    else valid = nn < w.Nsrc;
    if (!valid) scol = 0;
    f32x4 v[8]; float g[8];
#pragma unroll
    for (int i = 0; i < 8; ++i) { const int kk = 8 * i + kr; v[i] = *(const f32x4*)(sp + (size_t)(k0 + kk) * w.Nsrc + scol); g[i] = w.gain ? w.gain[k0 + kk] : 1.f; }
#pragma unroll
    for (int i = 0; i < 8; ++i) { const int kk = 8 * i + kr; LAS float* d = scr + kk * 33 + 4 * cq; const float gg = valid ? g[i] : 0.f;
        d[0] = v[i][0] * gg; d[1] = v[i][1] * gg; d[2] = v[i][2] * gg; d[3] = v[i][3] * gg; }
    LDS_WAIT(); asm volatile("" ::: "memory");
    const int c = lane & 7;
#pragma unroll
    for (int j = 0; j < 4; ++j) { const int n = (lane >> 3) + 8 * j; const LAS float* s = scr + (8 * c) * 33 + n;
        u32x4 o; o.x = pk2(s[0 * 33], s[1 * 33]); o.y = pk2(s[2 * 33], s[3 * 33]); o.z = pk2(s[4 * 33], s[5 * 33]); o.w = pk2(s[6 * 33], s[7 * 33]);
        *(u32x4*)(w.dst + (size_t)(n0 + n) * w.K + k0 + 8 * c) = o; }
    LDS_WAIT(); asm volatile("" ::: "memory");
}
constexpr int wc_items(int K, int Ndst) { return (K / 64) * (Ndst / 32); }
constexpr int WI_GU = wc_items(DM, NGU), WI_D = wc_items(FF, DM), WI_IN = wc_items(DM, NIN), WI_UQ = wc_items(512, 1280), WI_UKV = wc_items(256, 1536),
              WI_A = wc_items(768, DM), WI_B = wc_items(512, DM), WI_C = wc_items(256, DM), WI_OUT = wc_items(DM, DM);
constexpr int WI_TOTAL = 2 * WI_GU + 2 * WI_D + WI_IN + WI_UQ + WI_UKV + WI_A + WI_B + WI_C + WI_OUT;

__device__ __forceinline__ void phase_wconv(const Ctx& a, int l, LAS unsigned char* lds, int gw, int NGW, int wave, int lane) {
    LAS float* scr = (LAS float*)(lds + wave * 16384);
    bf16_t* W = (bf16_t*)(a.ws + WS_W);
    const size_t oFF = (size_t)l * DM * FF;
    for (int it = gw; it < WI_TOTAL; it += NGW) {
        int r = it; WMat w;
        if (r < WI_GU) { w = WMat{a.in(I_F1G) + oFF, a.in(I_F1U) + oFF, a.in(I_F1N) + (size_t)l * DM, W + W_GU1, DM, FF, NGU, 1}; }
        else if ((r -= WI_GU) < WI_GU) { w = WMat{a.in(I_F2G) + oFF, a.in(I_F2U) + oFF, a.in(I_F2N) + (size_t)l * DM, W + W_GU2, DM, FF, NGU, 1}; }
        else if ((r -= WI_GU) < WI_IN) { w = WMat{a.in(I_WIN) + (size_t)l * DM * 10832, nullptr, a.in(I_MIXN) + (size_t)l * DM, W + W_IN, DM, 10832, NIN, 2}; }
        else if ((r -= WI_IN) < WI_D) { w = WMat{a.in(I_F1D) + oFF, nullptr, nullptr, W + W_D1, FF, DM, DM, 0}; }
        else if ((r -= WI_D) < WI_D) { w = WMat{a.in(I_F2D) + oFF, nullptr, nullptr, W + W_D2, FF, DM, DM, 0}; }
        else if ((r -= WI_D) < WI_OUT) { w = WMat{a.in(I_WOUT) + (size_t)l * DM * DM, nullptr, nullptr, W + W_OUT, DM, DM, DM, 0}; }
        else if ((r -= WI_OUT) < WI_A) { w = WMat{a.in(I_WA) + (size_t)l * 768 * DM, nullptr, nullptr, W + W_A, 768, DM, DM, 0}; }
        else if ((r -= WI_A) < WI_B) { w = WMat{a.in(I_WB) + (size_t)l * 512 * DM, nullptr, nullptr, W + W_B, 512, DM, DM, 0}; }
        else if ((r -= WI_B) < WI_C) { w = WMat{a.in(I_WC) + (size_t)l * 256 * DM, nullptr, nullptr, W + W_C, 256, DM, DM, 0}; }
        else if ((r -= WI_C) < WI_UQ) { w = WMat{a.in(I_WUQ) + (size_t)l * 512 * 1152, nullptr, a.in(I_CQN) + (size_t)l * 512, W + W_UQ, 512, 1152, 1280, 0}; }
        else { r -= WI_UQ; w = WMat{a.in(I_WUKV) + (size_t)l * 256 * 1536, nullptr, a.in(I_CKVN) + (size_t)l * 256, W + W_UKV, 256, 1536, 1536, 0}; }
        wconv_item(w, r, scr, lane);
    }
}

__device__ __forceinline__ void phase_prologue(const Ctx& a, int gw, int NGW, int lane) {
    const int* pos = (const int*)a.in(I_POS);
    float* ropec = (float*)(a.ws + WS_ROPE); float* ropes = ropec + (size_t)MTOK * 32;
    const int i = lane & 31; const float invf = exp2f(-(float)i * 0.41524101186092029f);
    for (int p = gw; p < MTOK / 2; p += NGW) { const int tok = 2 * p + (lane >> 5); const float ang = (float)pos[tok] * invf; float sn, cs; sincosf(ang, &sn, &cs);
        ropec[(size_t)tok * 32 + i] = cs; ropes[(size_t)tok * 32 + i] = sn; }
    const float* x = a.in(I_X); bf16_t* xb = (bf16_t*)(a.ws + WS_XB); float* ssq = (float*)(a.ws + WS_SSQ);
    for (int m = gw; m < MTOK; m += NGW) { const f32x4* xr = (const f32x4*)(x + (size_t)m * DM) + lane; u32x2* o8 = (u32x2*)(xb + (size_t)m * DM) + lane; float s = 0.f;
#pragma unroll
        for (int j = 0; j < 8; ++j) { const f32x4 v = xr[64 * j]; s += (v[0] * v[0] + v[1] * v[1]) + (v[2] * v[2] + v[3] * v[3]); u32x2 w; w.x = pk2(v[0], v[1]); w.y = pk2(v[2], v[3]); o8[64 * j] = w; }
        s += __shfl_xor(s, 1); if ((lane & 1) == 0) ssq[(size_t)m * 32 + (lane >> 1)] = s; }
}

__device__ __forceinline__ void phase_prep(const Ctx& a, int l, int gw, int NGW, int lane, bool do_dswa) {
    bf16_t* u1 = (bf16_t*)(a.ws + WS_R2);
    const float* qraw = (const float*)(a.ws + WS_R3 + R3_QRAW); const float* kvraw = (const float*)(a.ws + WS_R3 + R3_KVRAW);
    const float* ropec = (const float*)(a.ws + WS_ROPE); const float* ropes = ropec + (size_t)MTOK * 32;
    bf16_t* Qo = (bf16_t*)(a.ws + WS_QKV + QKV_Q); bf16_t* Ko = (bf16_t*)(a.ws + WS_QKV + QKV_K); bf16_t* Vo = (bf16_t*)(a.ws + WS_QKV + QKV_V);
    const float* gq = a.in(I_QN) + (size_t)l * 192; const float* gk = a.in(I_KN) + (size_t)l * 192;
    const float gq0 = gq[lane], gq1 = gq[64 + lane], gq2 = gq[128 + lane], gk0 = gk[lane], gk1 = gk[64 + lane], gk2 = gk[128 + lane];
    const float* dq = a.in(I_DQN) + (size_t)l * 128; const float* dk = a.in(I_DKN) + (size_t)l * 128;
    const float dq0 = dq[2 * lane], dq1 = dq[2 * lane + 1], dk0 = dk[2 * lane], dk1 = dk[2 * lane + 1];
    for (int row = gw; row < MTOK; row += NGW) {
        bf16_t* ur = u1 + (size_t)row * U1W; const int b = row / SEQ, s = row % SEQ;
        float rstd_cq, rstd_ckv;
        { const bf16x8 v = *(const bf16x8*)(ur + C_CQ + lane * 8); float q = 0.f;
#pragma unroll
          for (int j = 0; j < 8; ++j) { const float f = bf2f((bf16_t)v[j]); q += f * f; }
          rstd_cq = rsqrtf(wave_sum(q) * (1.f / 512.f) + EPS); }
        { const s16x4 v = *(const s16x4*)(ur + C_CKV + lane * 4); float q = 0.f;
#pragma unroll
          for (int j = 0; j < 4; ++j) { const float f = bf2f((bf16_t)v[j]); q += f * f; }
          rstd_ckv = rsqrtf(wave_sum(q) * (1.f / 256.f) + EPS); }
        const float kr = bf2f(ur[C_KROPE + lane]); const float ssq_kr = wave_sum(kr * kr);
        const float cs = ropec[(size_t)row * 32 + (lane & 31)], sn = ropes[(size_t)row * 32 + (lane & 31)];
#pragma unroll 2
        for (int h = 0; h < 6; ++h) {
            const float* qp = qraw + (size_t)row * QRAW_LD + h * 192;
            float x0 = qp[lane] * rstd_cq, x1 = qp[64 + lane] * rstd_cq, x2 = qp[128 + lane] * rstd_cq;
            const float rq = rsqrtf(wave_sum(x0 * x0 + x1 * x1 + x2 * x2) * (1.f / 192.f) + EPS);
            x0 *= rq * gq0; x1 *= rq * gq1; x2 *= rq * gq2;
            const float xp = __shfl_xor(x2, 32); const float xr = lane < 32 ? x2 * cs - xp * sn : xp * sn + x2 * cs;
            bf16_t* qo = Qo + ((size_t)((b * 6 + h) * SEQ + s)) * 192;
            qo[lane] = (bf16_t)f2bf(x0 * QS_MLA); qo[64 + lane] = (bf16_t)f2bf(x1 * QS_MLA); qo[128 + lane] = (bf16_t)f2bf(xr * QS_MLA);
            const float* kp = kvraw + (size_t)row * KVRAW_LD + h * 256;
            float k0 = kp[lane] * rstd_ckv, k1 = kp[64 + lane] * rstd_ckv; const float v0 = kp[128 + lane] * rstd_ckv, v1 = kp[192 + lane] * rstd_ckv;
            const float rk = rsqrtf((wave_sum(k0 * k0 + k1 * k1) + ssq_kr) * (1.f / 192.f) + EPS);
            k0 *= rk * gk0; k1 *= rk * gk1; const float k2 = kr * rk * gk2;
            const float kx = __shfl_xor(k2, 32); const float kro = lane < 32 ? k2 * cs - kx * sn : kx * sn + k2 * cs;
            bf16_t* ko = Ko + ((size_t)((b * 6 + h) * SEQ + s)) * 192;
            ko[lane] = (bf16_t)f2bf(k0); ko[64 + lane] = (bf16_t)f2bf(k1); ko[128 + lane] = (bf16_t)f2bf(kro);
            bf16_t* vo = Vo + ((size_t)((b * 6 + h) * SEQ + s)) * 128;
            vo[lane] = (bf16_t)f2bf(v0); vo[64 + lane] = (bf16_t)f2bf(v1);
        }
        if (do_dswa)
#pragma unroll 2
        for (int h = 0; h < 6; ++h) {
            unsigned* qp = (unsigned*)(ur + C_QC + h * 128) + lane; unsigned* kp = (unsigned*)(ur + C_KC + h * 128) + lane;
            const unsigned qw = *qp, kw = *kp;
            float q0 = __uint_as_float(qw << 16), q1 = __uint_as_float(qw & 0xffff0000u), k0 = __uint_as_float(kw << 16), k1 = __uint_as_float(kw & 0xffff0000u);
            const float rq = rsqrtf(wave_sum(q0 * q0 + q1 * q1) * (1.f / 128.f) + EPS) * QS_DSWA, rk = rsqrtf(wave_sum(k0 * k0 + k1 * k1) * (1.f / 128.f) + EPS);
            *qp = pk2(q0 * rq * dq0, q1 * rq * dq1); *kp = pk2(k0 * rk * dk0, k1 * rk * dk1);
        }
    }
}

__device__ __forceinline__ float logsigmoidf_(float z) { return fminf(z, 0.f) - log1pf(expf(-fabsf(z))); }
__device__ __forceinline__ int crow32(int r, int hi) { return (r & 3) + 8 * (r >> 2) + 4 * hi; }
__device__ __forceinline__ void gla_local(const Ctx& a, int l, LAS unsigned char* lds, int G, int bid, const int wv) {
    int tid_ = wv * 64 + lane_id_v(); asm volatile("" : "+v"(tid_));
    const int tid = tid_, wid = __builtin_amdgcn_readfirstlane(tid >> 6), lane = tid & 63, l32 = lane & 31, hi = lane >> 5;
    LAS float* kd = (LAS float*)lds; LAS float* vv = (LAS float*)(lds + 16640); LAS float* tot = (LAS float*)(lds + 16640 + 32768);
    const bf16_t* u1 = (const bf16_t*)(a.ws + WS_R2);
    float* dS = (float*)(a.ws + WS_GLA + GLA_DS); float* bcum = (float*)(a.ws + WS_GLA + GLA_BC); float* dec = (float*)(a.ws + WS_GLA + GLA_DEC);
    const float* w2 = a.in(I_WG2) + (size_t)l * 16 * 256; const float* b2 = a.in(I_BG2) + (size_t)l * 256;
    const int d = lane, tg = wid;
    for (int ci = bid; ci < 2048; ci += G) {
        const int bh = ci >> 8, c = ci & 255, b = bh >> 2, h = bh & 3, row0 = b * SEQ + 64 * c;
        float w2c[16];
#pragma unroll
        for (int j = 0; j < 16; ++j) w2c[j] = w2[j * 256 + h * 64 + d];
        const float bias = b2[h * 64 + d];
        float bcv[8]; float run = 0.f;
#pragma unroll
        for (int i = 0; i < 8; ++i) { const int t = tg * 8 + i; const bf16_t* gl = u1 + (size_t)(row0 + t) * U1W + C_GLR;
            const bf16x8 g0 = *(const bf16x8*)gl, g1 = *(const bf16x8*)(gl + 8); float z = bias;
#pragma unroll
            for (int j = 0; j < 8; ++j) { z += bf2f((bf16_t)g0[j]) * w2c[j]; z += bf2f((bf16_t)g1[j]) * w2c[8 + j]; }
            run += logsigmoidf_(z) * (1.f / 16.f); bcv[i] = run; }
        tot[tg * 64 + d] = run;
        { const int t = tid >> 3, c0 = (tid & 7) * 16; const bf16_t* vp = u1 + (size_t)(row0 + t) * U1W + C_VB + h * 128 + c0;
          const bf16x8 v0 = *(const bf16x8*)vp, v1 = *(const bf16x8*)(vp + 8);
#pragma unroll
          for (int j = 0; j < 8; ++j) { vv[t * 128 + c0 + j] = bf2f((bf16_t)v0[j]); vv[t * 128 + c0 + 8 + j] = bf2f((bf16_t)v1[j]); } }
        __syncthreads();
        float off = 0.f, bend = 0.f;
#pragma unroll
        for (int g = 0; g < 8; ++g) { const float x = tot[g * 64 + d]; bend += x; if (g < tg) off += x; }
#pragma unroll
        for (int i = 0; i < 8; ++i) { const int t = tg * 8 + i; const float bc = bcv[i] + off;
            bcum[(size_t)(row0 + t) * 256 + h * 64 + d] = bc;
            const float kk = bf2f(u1[(size_t)(row0 + t) * U1W + C_KB + h * 64 + d]);
            kd[t * 65 + d] = kk * expf(bend - bc); }
        if (tg == 0) dec[(size_t)ci * 64 + d] = expf(bend);
        __syncthreads();
        { const int di = wid >> 2, ei = wid & 3; f32x16 acc = {};
#pragma unroll 8
          for (int s0 = 0; s0 < 64; s0 += 2) { const float av = kd[(s0 + hi) * 65 + 32 * di + l32], bv = vv[(s0 + hi) * 128 + 32 * ei + l32];
              acc = __builtin_amdgcn_mfma_f32_32x32x2f32(av, bv, acc, 0, 0, 0); }
          float* dst = dS + (size_t)ci * 8192;
#pragma unroll
          for (int r = 0; r < 16; ++r) dst[(32 * di + crow32(r, hi)) * 128 + 32 * ei + l32] = acc[r]; }
        __syncthreads();
    }
}
__device__ __forceinline__ void gla_scan(const Ctx& a, int bid, const int wv) {
    float* dS = (float*)(a.ws + WS_GLA + GLA_DS); const float* dec = (const float*)(a.ws + WS_GLA + GLA_DEC);
    int tid_ = wv * 64 + lane_id_v(); asm volatile("" : "+v"(tid_));
    const int gid = bid * NTHR + tid_, bh = gid >> 13, de = gid & 8191, d = de >> 7;
    float st = 0.f; float* p = dS + (size_t)bh * 256 * 8192 + de; const float* dc = dec + (size_t)bh * 256 * 64 + d;
    for (int c = 0; c < 256; c += 8) { float x[8], g[8];
#pragma unroll
        for (int i = 0; i < 8; ++i) { x[i] = p[(size_t)(c + i) * 8192]; g[i] = dc[(c + i) * 64]; }
#pragma unroll
        for (int i = 0; i < 8; ++i) { p[(size_t)(c + i) * 8192] = st; st = g[i] * st + x[i]; } }
}
__device__ __forceinline__ void gla_out(const Ctx& a, int l, LAS unsigned char* lds, int G, int bid, const int wv) {
    int tid_ = wv * 64 + lane_id_v(); asm volatile("" : "+v"(tid_));
    const int tid = tid_, wid = __builtin_amdgcn_readfirstlane(tid >> 6), lane = tid & 63, l32 = lane & 31, hi = lane >> 5;
    LAS float* qe = (LAS float*)lds; LAS float* ke = (LAS float*)(lds + 16640); LAS float* At = (LAS float*)(lds + 33280);
    LAS float* vv = (LAS float*)(lds + 49920); LAS float* Sp = (LAS float*)(lds + 82688);
    const bf16_t* u1 = (const bf16_t*)(a.ws + WS_R2);
    const float* dS = (const float*)(a.ws + WS_GLA + GLA_DS); const float* bcum = (const float*)(a.ws + WS_GLA + GLA_BC);
    bf16_t* yb = (bf16_t*)(a.ws + WS_R3 + R3_YB); const float* go = a.in(I_ON) + (size_t)l * 128;
    for (int ci = bid; ci < 2048; ci += G) {
        const int bh = ci >> 8, c = ci & 255, b = bh >> 2, h = bh & 3, row0 = b * SEQ + 64 * c;
        { const int d = lane, tg = wid;
#pragma unroll
          for (int i = 0; i < 8; ++i) { const int t = tg * 8 + i; const float bc = bcum[(size_t)(row0 + t) * 256 + h * 64 + d];
              const float q = bf2f(u1[(size_t)(row0 + t) * U1W + C_QB + h * 64 + d]), k = bf2f(u1[(size_t)(row0 + t) * U1W + C_KB + h * 64 + d]);
              qe[t * 65 + d] = q * 0.125f * expf(bc); ke[t * 65 + d] = k * expf(-bc); } }
        { const int t = tid >> 3, c0 = (tid & 7) * 16; const bf16_t* vp = u1 + (size_t)(row0 + t) * U1W + C_VB + h * 128 + c0;
          const bf16x8 v0 = *(const bf16x8*)vp, v1 = *(const bf16x8*)(vp + 8);
#pragma unroll
          for (int j = 0; j < 8; ++j) { vv[t * 128 + c0 + j] = bf2f((bf16_t)v0[j]); vv[t * 128 + c0 + 8 + j] = bf2f((bf16_t)v1[j]); }
          const f32x4* sp = (const f32x4*)(dS + (size_t)ci * 8192) + tid * 4;
#pragma unroll
          for (int j = 0; j < 4; ++j) *(LAS f32x4*)(Sp + tid * 16 + j * 4) = sp[j]; }
        __syncthreads();
        if (wid < 4) {
            if (wid < 3) { const int ti = wid == 0 ? 0 : 1, si = wid == 2 ? 1 : 0; f32x16 acc = {};
#pragma unroll 8
                for (int d0 = 0; d0 < 64; d0 += 2) { const float av = qe[(32 * ti + l32) * 65 + d0 + hi], bv = ke[(32 * si + l32) * 65 + d0 + hi];
                    acc = __builtin_amdgcn_mfma_f32_32x32x2f32(av, bv, acc, 0, 0, 0); }
#pragma unroll
                for (int r = 0; r < 16; ++r) { const int t = 32 * ti + crow32(r, hi), s = 32 * si + l32; At[t * 65 + s] = (s <= t) ? acc[r] : 0.f; } }
            else {
#pragma unroll
                for (int r = 0; r < 16; ++r) At[crow32(r, hi) * 65 + 32 + l32] = 0.f; }
        }
        __syncthreads();
        f32x16 acc = {}; const int ti = wid >> 2, ei = wid & 3;
#pragma unroll 8
        for (int s0 = 0; s0 < 64; s0 += 2) { const float av = At[(32 * ti + l32) * 65 + s0 + hi], bv = vv[(s0 + hi) * 128 + 32 * ei + l32];
            acc = __builtin_amdgcn_mfma_f32_32x32x2f32(av, bv, acc, 0, 0, 0); }
#pragma unroll 8
        for (int d0 = 0; d0 < 64; d0 += 2) { const float av = qe[(32 * ti + l32) * 65 + d0 + hi], bv = Sp[(d0 + hi) * 128 + 32 * ei + l32];
            acc = __builtin_amdgcn_mfma_f32_32x32x2f32(av, bv, acc, 0, 0, 0); }
        __syncthreads();
#pragma unroll
        for (int r = 0; r < 16; ++r) Sp[(32 * ti + crow32(r, hi)) * 128 + 32 * ei + l32] = acc[r];
        __syncthreads();
        { const int t = tid >> 3, e0 = (tid & 7) * 16; float ov[16]; float ss = 0.f;
#pragma unroll
          for (int j = 0; j < 4; ++j) { const f32x4 x = *(const LAS f32x4*)(Sp + t * 128 + e0 + 4 * j); ov[4 * j] = x[0]; ov[4 * j + 1] = x[1]; ov[4 * j + 2] = x[2]; ov[4 * j + 3] = x[3];
              ss += (x[0] * x[0] + x[1] * x[1]) + (x[2] * x[2] + x[3] * x[3]); }
          ss += __shfl_xor(ss, 1); ss += __shfl_xor(ss, 2); ss += __shfl_xor(ss, 4);
          const float rs = rsqrtf(ss * (1.f / 128.f) + EPS);
          const bf16_t* rp = u1 + (size_t)(row0 + t) * U1W + C_RB + h * 128 + e0; const bf16x8 r0 = *(const bf16x8*)rp, r1 = *(const bf16x8*)(rp + 8);
          unsigned w[8];
#pragma unroll
          for (int j = 0; j < 4; ++j) { w[j] = pk2(ov[2 * j] * rs * go[e0 + 2 * j] * bf2f((bf16_t)r0[2 * j]), ov[2 * j + 1] * rs * go[e0 + 2 * j + 1] * bf2f((bf16_t)r0[2 * j + 1]));
              w[4 + j] = pk2(ov[8 + 2 * j] * rs * go[e0 + 8 + 2 * j] * bf2f((bf16_t)r1[2 * j]), ov[8 + 2 * j + 1] * rs * go[e0 + 8 + 2 * j + 1] * bf2f((bf16_t)r1[2 * j + 1])); }
          u32x4* yo = (u32x4*)(yb + (size_t)(row0 + t) * 512 + h * 128 + e0);
          yo[0] = (u32x4){w[0], w[1], w[2], w[3]}; yo[1] = (u32x4){w[4], w[5], w[6], w[7]}; }
        __syncthreads();
    }
}
__device__ __forceinline__ void dswa_combine(const Ctx& a, int gw, int NGW, int lane) {
    const bf16_t* dout = (const bf16_t*)(a.ws + WS_R3 + R3_DO); const float* lse = (const float*)(a.ws + WS_R3 + R3_LSE); bf16_t* yc = (bf16_t*)(a.ws + WS_R3 + R3_YC);
    const int hp = lane >> 5, e = 4 * (lane & 31);
    for (int row = gw; row < MTOK; row += NGW) {
        const float l0 = lse[(size_t)row * 6 + hp], l1 = lse[(size_t)row * 6 + 2 + hp], l2 = lse[(size_t)row * 6 + 4 + hp];
        const float mx = fmaxf(l0, fmaxf(l1, l2)); float w0 = expf(l0 - mx), w1 = expf(l1 - mx), w2 = expf(l2 - mx); const float inv = 1.f / (w0 + w1 + w2); w0 *= inv; w1 *= inv; w2 *= inv;
        const u32x2 a0 = *(const u32x2*)(dout + (size_t)row * 768 + hp * 128 + e), a1 = *(const u32x2*)(dout + (size_t)row * 768 + (2 + hp) * 128 + e), a2 = *(const u32x2*)(dout + (size_t)row * 768 + (4 + hp) * 128 + e);
        float o[4];
        o[0] = w0 * __uint_as_float(a0.x << 16) + w1 * __uint_as_float(a1.x << 16) + w2 * __uint_as_float(a2.x << 16);
        o[1] = w0 * __uint_as_float(a0.x & 0xffff0000u) + w1 * __uint_as_float(a1.x & 0xffff0000u) + w2 * __uint_as_float(a2.x & 0xffff0000u);
        o[2] = w0 * __uint_as_float(a0.y << 16) + w1 * __uint_as_float(a1.y << 16) + w2 * __uint_as_float(a2.y << 16);
        o[3] = w0 * __uint_as_float(a0.y & 0xffff0000u) + w1 * __uint_as_float(a1.y & 0xffff0000u) + w2 * __uint_as_float(a2.y & 0xffff0000u);
        u32x2 w; w.x = pk2(o[0], o[1]); w.y = pk2(o[2], o[3]); *(u32x2*)(yc + (size_t)row * 256 + hp * 128 + e) = w;
    }
}

constexpr int N_MLA_UNITS = 12 * 64, N_DSWA_UNITS = 12 * 64, N_ATT_UNITS = N_MLA_UNITS + N_DSWA_UNITS;
__device__ __forceinline__ void phase_attention(const Ctx& a, int l, LAS unsigned char* lds, volatile LAS unsigned* qword, const int wv, const int qsel) {
    const int tid0 = wv * 64 + lane_id_v();
    unsigned* head = (unsigned*)(a.ws + WS_CTL) + CW_QUEUE + 64 * l + 1024 * qsel;
    const bf16_t* u1 = (const bf16_t*)(a.ws + WS_R2);
    for (;;) {
        if (tid0 == 0) *qword = __hip_atomic_fetch_add(head, 1u, __ATOMIC_RELAXED, __HIP_MEMORY_SCOPE_AGENT);
        __syncthreads();
        const int uid = (int)__builtin_amdgcn_readfirstlane(*qword);
        if (uid >= N_ATT_UNITS) break;
        att::AUnit u;
        if (uid < N_MLA_UNITS) {
            const int qb = 63 - uid / 12, bh = uid % 12, b = bh / 6, h = bh % 6;
            u.Q = (const bf16_t*)(a.ws + WS_QKV + QKV_Q) + ((size_t)bh * SEQ + 256 * qb) * 192; u.qpitch = 192;
            u.K = (const bf16_t*)(a.ws + WS_QKV + QKV_K) + (size_t)bh * SEQ * 192; u.kpitch = 192;
            u.V = (const bf16_t*)(a.ws + WS_QKV + QKV_V) + (size_t)bh * SEQ * 128; u.vpitch = 128;
            u.O = (bf16_t*)(a.ws + WS_R3 + R3_YA) + ((size_t)(b * SEQ + 256 * qb)) * 768 + h * 128; u.opitch = 768;
            u.lse = nullptr; u.lsepitch = 0; u.q0 = 256 * qb; u.j_lo = 0; u.j_hi = 4 * qb + 4; u.bias_c = 0.f;
            att::attn_unit<192, 0>(lds, u, wv);
        } else {
            const int v = uid - N_MLA_UNITS, b = v / 384, hh = (v / 64) % 6, idx = v % 64, g = hh >> 1, dil = g == 0 ? 1 : (g == 1 ? 4 : 16), nb = 64 / dil, r = idx / nb, qb = idx % nb;
            const size_t tok0 = (size_t)b * SEQ + r;
            u.Q = u1 + (tok0 + (size_t)256 * qb * dil) * U1W + C_QC + hh * 128; u.qpitch = (size_t)dil * U1W;
            u.K = u1 + tok0 * U1W + C_KC + hh * 128; u.kpitch = (size_t)dil * U1W;
            u.V = u1 + tok0 * U1W + C_VC + hh * 128; u.vpitch = (size_t)dil * U1W;
            u.O = (bf16_t*)(a.ws + WS_R3 + R3_DO) + (tok0 + (size_t)256 * qb * dil) * 768 + hh * 128; u.opitch = (size_t)dil * 768;
            u.lse = (float*)(a.ws + WS_R3 + R3_LSE) + (tok0 + (size_t)256 * qb * dil) * 6 + hh; u.lsepitch = (size_t)dil * 6;
            u.q0 = 256 * qb; u.j_lo = 4 * qb - 2 > 0 ? 4 * qb - 2 : 0; u.j_hi = 4 * qb + 4;
            u.bias_c = exp2f(-8.f * (float)(hh + 1) / 6.f) * (float)dil * LOG2E;
            att::attn_unit<128, 1>(lds, u, wv);
        }
    }
    __syncthreads();
}

constexpr int NPL = 12, NPH = 1 + NPL * DEPTH;
__global__ void __launch_bounds__(NTHR, 2) hybrid_fwd(Args args) {
    extern __shared__ __attribute__((aligned(16))) unsigned char lds_raw[];
    LAS unsigned char* lds = (LAS unsigned char*)lds_raw;
    const int tid = threadIdx.x;
    const int wv = __builtin_amdgcn_readfirstlane(tid >> 6);
    const int G = gridDim.x, bid = blockIdx.x, NGW = G * NWAVES;
#define LAUNDER() int tz_ = lane_id_v(); asm volatile("" : "+v"(tz_)); const int lane = tz_, wave = wv, gw = bid * NWAVES + wave
    volatile LAS unsigned* lctl = (volatile LAS unsigned*)(lds + LDSCTL_OFF);
    for (int u = tid; u < (LDS_BYTES - LDSCTL_OFF) / 4; u += NTHR) lctl[u] = 0u;
    __syncthreads();
    const int lo = args.ph_lo, hi = args.ph_hi;
    unsigned* ctl = (unsigned*)(args.ws + WS_CTL);
    XcdBarrier bar; bar.bar = ctl + CW_BAR; bar.x = 0; bar.st = lctl + 8; bar.wv = wv;
    if (hi - lo > 1) bar = xcd_barrier_post(ctl + CW_BAR, lctl + 8, wv);
#ifndef PH_MASK
#define PH_MASK 0xFFFF
#endif
#define IN(k) (lo <= (k) && (k) < hi)
#define EN(j) ((PH_MASK >> (j)) & 1)
#define DUMMY_OUT(p) (args.qsel ? (float*)(wz + WS_R3) : (p))
#define DUMMY_XB(p) (args.qsel ? (bf16_t*)(wz + WS_QKV) : (p))
#define DUMMY_XB2(p) (args.qsel ? (bf16_t*)(wz + WS_R2) : (p))
#define DUMMY_SSQ(p) (args.qsel ? (float*)(wz + WS_GLA) : (p))
#define SEAM(k) do { if (IN(k) && IN((k) + 1)) xcd_barrier<false>(bar); } while (0)
    unsigned char* ws = args.ws;
    volatile LAS unsigned long long* ptab = (volatile LAS unsigned long long*)(lds + LDSCTL_OFF + 256);
    if (tid < 27) ptab[tid] = (unsigned long long)args.in[tid];
    __syncthreads();
    Ctx cx; cx.ws = ws; cx.ptab = ptab;
    float* xres = args.out;
#define WSP() unsigned char* wz = ws; asm volatile("" : "+s"(wz)); \
    bf16_t* W = (bf16_t*)(wz + WS_W); bf16_t* xb = (bf16_t*)(wz + WS_XB); float* ssq = (float*)(wz + WS_SSQ); bf16_t* h1 = (bf16_t*)(wz + WS_R1); bf16_t* u2 = (bf16_t*)(wz + WS_R1); \
    bf16_t* u1 = (bf16_t*)(wz + WS_R2); float* m32 = (float*)(wz + WS_R2); bf16_t* mb = (bf16_t*)(wz + WS_QKV); float* qraw = (float*)(wz + WS_R3 + R3_QRAW); float* kvraw = (float*)(wz + WS_R3 + R3_KVRAW); \
    bf16_t* ya = (bf16_t*)(wz + WS_R3 + R3_YA); bf16_t* yb = (bf16_t*)(wz + WS_R3 + R3_YB); bf16_t* yc = (bf16_t*)(wz + WS_R3 + R3_YC); \
    (void)W; (void)xb; (void)ssq; (void)h1; (void)u2; (void)u1; (void)m32; (void)mb; (void)qraw; (void)kvraw; (void)ya; (void)yb; (void)yc

    if (EN(12) && IN(0)) { LAUNDER(); phase_prologue(cx, gw, NGW, lane); phase_wconv(cx, 0, lds, gw, NGW, wave, lane); }
    if (IN(0) && IN(1)) xcd_barrier<true>(bar);
    for (int l = 0; l < DEPTH; ++l) {
        const int pb = 1 + NPL * l;
        if (EN(0) && IN(pb + 0)) { LAUNDER(); if (l > 0) phase_wconv(cx, l, lds, gw, NGW, wave, lane); }
        SEAM(pb + 0);
        if (EN(1) && IN(pb + 1)) { WSP();
            pg8::Gemm g{xb, W + W_GU1, MTOK, NGU, DM, DM}; pg8::StaticOrder S; S.init(MTOK, NGU, G, bid);
            pg8::EpiSwiGLU E{ssq, h1, FF};
            pg8::gemm_phase<pg8::EpiSwiGLU, pg8::StaticOrder, true, true>(lds, g, S, E, wv);
        }
        SEAM(pb + 1);
        if (EN(2) && IN(pb + 2)) { WSP();
            pg8::Gemm g{h1, W + W_D1, MTOK, DM, FF, FF}; pg8::StaticOrder S; S.init(MTOK, DM, G, bid);
            pg8::EpiResid E{l == 0 ? cx.in(I_X) : (const float*)xres, DUMMY_OUT(xres), DUMMY_XB(xb), DUMMY_SSQ(ssq), 0.5f};
            pg8::gemm_phase<pg8::EpiResid, pg8::StaticOrder, true, true>(lds, g, S, E, wv);
        }
        SEAM(pb + 2);
        if (EN(3) && IN(pb + 3)) { WSP();
            pg8::Gemm g{xb, W + W_IN, MTOK, NIN, DM, DM}; pg8::StaticOrder S; S.init(MTOK, NIN, G, bid);
            pg8::EpiWin E{ssq, u1, u2, U1W, U2W};
            pg8::gemm_phase<pg8::EpiWin, pg8::StaticOrder, true, true>(lds, g, S, E, wv);
        }
        SEAM(pb + 3);
        if (EN(4) && IN(pb + 4)) { WSP();
            { pg8::Gemm g{u1 + C_CQ, W + W_UQ, MTOK, 1280, 512, U1W}; pg8::StaticOrder S; S.init(MTOK, 1280, G, bid);
              pg8::EpiF32 E{qraw, QRAW_LD};
              pg8::gemm_phase<pg8::EpiF32, pg8::StaticOrder, true, true>(lds, g, S, E, wv); }
            { pg8::Gemm g{u1 + C_CKV, W + W_UKV, MTOK, 1536, 256, U1W}; pg8::StaticOrder S; S.init(MTOK, 1536, G, bid);
              pg8::EpiF32 E{kvraw, KVRAW_LD};
              pg8::gemm_phase<pg8::EpiF32, pg8::StaticOrder, true, true>(lds, g, S, E, wv); }
        }
        SEAM(pb + 4);
        if (EN(5) && IN(pb + 5)) { LAUNDER(); phase_prep(cx, l, gw, NGW, lane, args.qsel == 0); gla_local(cx, l, lds, G, bid, wv); }
        SEAM(pb + 5);
        if (EN(6) && IN(pb + 6)) { if (bid < 128 && args.qsel == 0) gla_scan(cx, bid, wv); phase_attention(cx, l, lds, lctl + 16, wv, args.qsel); }
        SEAM(pb + 6);
        if (EN(7) && IN(pb + 7)) { LAUNDER(); gla_out(cx, l, lds, G, bid, wv); dswa_combine(cx, gw, NGW, lane); }
        SEAM(pb + 7);
        if (EN(8) && IN(pb + 8)) { WSP();
            { pg8::Gemm g{ya, W + W_A, MTOK, DM, 768, 768}; pg8::StaticOrder S; S.init(MTOK, DM, G, bid);
              pg8::EpiMerge<0> E{u2, U2W, m32, mb};
              pg8::gemm_phase<pg8::EpiMerge<0>, pg8::StaticOrder, true, true>(lds, g, S, E, wv); }
            { pg8::Gemm g{yb, W + W_B, MTOK, DM, 512, 512}; pg8::StaticOrder S; S.init(MTOK, DM, G, bid);
              pg8::EpiMerge<1> E{u2 + 2048, U2W, m32, mb};
              pg8::gemm_phase<pg8::EpiMerge<1>, pg8::StaticOrder, true, true>(lds, g, S, E, wv); }
            { pg8::Gemm g{yc, W + W_C, MTOK, DM, 256, 256}; pg8::StaticOrder S; S.init(MTOK, DM, G, bid);
              pg8::EpiMerge<2> E{u2 + 4096, U2W, m32, mb};
              pg8::gemm_phase<pg8::EpiMerge<2>, pg8::StaticOrder, true, true>(lds, g, S, E, wv); }
        }
        SEAM(pb + 8);
        if (EN(9) && IN(pb + 9)) { WSP();
            pg8::Gemm g{mb, W + W_OUT, MTOK, DM, DM, DM}; pg8::StaticOrder S; S.init(MTOK, DM, G, bid);
            pg8::EpiResid E{xres, DUMMY_OUT(xres), DUMMY_XB2(xb), DUMMY_SSQ(ssq), 1.0f};
            pg8::gemm_phase<pg8::EpiResid, pg8::StaticOrder, true, true>(lds, g, S, E, wv);
        }
        SEAM(pb + 9);
        if (EN(10) && IN(pb + 10)) { WSP();
            pg8::Gemm g{xb, W + W_GU2, MTOK, NGU, DM, DM}; pg8::StaticOrder S; S.init(MTOK, NGU, G, bid);
            pg8::EpiSwiGLU E{ssq, h1, FF};
            pg8::gemm_phase<pg8::EpiSwiGLU, pg8::StaticOrder, true, true>(lds, g, S, E, wv);
        }
        SEAM(pb + 10);
        if (EN(11) && IN(pb + 11)) { WSP();
            pg8::Gemm g{h1, W + W_D2, MTOK, DM, FF, FF}; pg8::StaticOrder S; S.init(MTOK, DM, G, bid);
            pg8::EpiResid E{xres, DUMMY_OUT(xres), DUMMY_XB(xb), DUMMY_SSQ(ssq), 0.5f};
            pg8::gemm_phase<pg8::EpiResid, pg8::StaticOrder, true, true>(lds, g, S, E, wv);
        }
        SEAM(pb + 11);
    }
#undef IN
#undef SEAM
}

extern "C" void kernel_launch(void* const* d_in, const int* in_sizes, int n_in, void* d_out, int out_size, void* d_ws, size_t ws_size, hipStream_t stream) {
    static int grid = 0;
    if (grid == 0) {
        if (n_in != 27 || out_size != MTOK * DM || ws_size < WS_END) { fprintf(stderr, "kernel_launch: unexpected problem: n_in %d out %d ws %zu (need %zu)\n", n_in, out_size, ws_size, (size_t)WS_END); grid = -1; return; }
        int dev = 0, cus = 0, per_cu = 0;
        if (hipGetDevice(&dev) != hipSuccess || hipDeviceGetAttribute(&cus, hipDeviceAttributeMultiprocessorCount, dev) != hipSuccess) { grid = -1; return; }
        if (hipFuncSetAttribute((const void*)hybrid_fwd, hipFuncAttributeMaxDynamicSharedMemorySize, LDS_BYTES) != hipSuccess) { fprintf(stderr, "kernel_launch: hipFuncSetAttribute failed\n"); grid = -1; return; }
        if (hipOccupancyMaxActiveBlocksPerMultiprocessor(&per_cu, (const void*)hybrid_fwd, NTHR, LDS_BYTES) != hipSuccess || per_cu < 1)
            fprintf(stderr, "kernel_launch: occupancy query reports %d workgroups per CU\n", per_cu);
        (void)hipGetLastError();
        grid = cus;
    }
    if (grid < 0) return;
    if (hipMemsetAsync((char*)d_ws + WS_CTL, 0, CTL_BYTES, stream) != hipSuccess) return;
    Args a{};
    for (int i = 0; i < 27; ++i) a.in[i] = (const float*)d_in[i];
    a.out = (float*)d_out; a.ws = (unsigned char*)d_ws;
#if MK_SINGLE
    a.ph_lo = 0; a.ph_hi = NPH;
    hipLaunchKernelGGL(hybrid_fwd, dim3(grid), dim3(NTHR), LDS_BYTES, stream, a);
#else
    for (int p = 0; p < NPH; ++p) { a.ph_lo = p; a.ph_hi = p + 1; a.qsel = 0; hipLaunchKernelGGL(hybrid_fwd, dim3(grid), dim3(NTHR), LDS_BYTES, stream, a);
#ifdef PROBE_DUP
        if (p >= 1 && ((PROBE_DUP >> ((p - 1) % NPL)) & 1)) { a.qsel = 1; hipLaunchKernelGGL(hybrid_fwd, dim3(grid), dim3(NTHR), LDS_BYTES, stream, a); }
#endif
    }
#endif
    const hipError_t le = hipPeekAtLastError();
    if (le != hipSuccess) fprintf(stderr, "kernel_launch: launch failed: %s\n", hipGetErrorName(le));
}
```

```cpp
#include <hip/hip_runtime.h>
#include <cstdio>
#include <cstdint>

#ifndef PG8_ASM_STAGE
#define PG8_ASM_STAGE 0
#endif
#ifndef MK_SINGLE
#define MK_SINGLE 1
#endif

__device__ __forceinline__ int lane_id_v() { int x; asm volatile("v_mbcnt_lo_u32_b32 %0, -1, 0\n\tv_mbcnt_hi_u32_b32 %0, -1, %0" : "=v"(x)); return x; }
namespace pg8 {
#define PG8_LAS __attribute__((address_space(3)))
typedef unsigned short bf16_t;
typedef short bf16x8 __attribute__((ext_vector_type(8)));
typedef float f32x4 __attribute__((ext_vector_type(4)));
typedef unsigned u32x4 __attribute__((ext_vector_type(4)));
constexpr int BM = 256, BK = 64, HALF = 128, HTB = HALF * BK * 2  , STAGE_BYTES = 8 * HTB, NXCD = 8, WGM = 8;

__host__ __device__ __forceinline__ int lds_byte(int r, int c) { const int st = (r >> 4) * 2 + (c >> 5), rr = r & 15, cc = c & 31, ob = rr * 64 + cc * 2; return st * 1024 + (ob ^ (((ob >> 9) & 1) << 5)); }
__host__ __device__ __forceinline__ void stage_rc(int b, int& R, int& C) { const int st = b / 1024, sb = b % 1024, swz = sb ^ (((sb >> 9) & 1) << 5); R = (st >> 1) * 16 + swz / 64; C = (st & 1) * 32 + (swz % 64) / 2; }
__host__ __device__ __forceinline__ int perm32(int rho) { const int n = rho >> 4, i = rho & 15; return 8 * (i >> 2) + 4 * n + (i & 3); }

struct Unit { int pm, pn; };
struct Gemm { const bf16_t* A; const bf16_t* Bt; int M, N, K, lda; };

struct StaticOrder {
    int nM, nN, nwg, G, c;
    __host__ __device__ void init(int M, int N, int G_, int c_) { nM = M / BM; nN = N / BM; nwg = nM * nN; G = G_; c = c_; }
    __host__ __device__ bool next(int i, Unit& u) const {
        const long L = (long)i * G + c; if (L >= nwg) return false;
        int wgid = (int)L; { const int q = nwg / NXCD, r = nwg % NXCD, xcd = wgid % NXCD, off = wgid / NXCD; wgid = (xcd < r ? xcd * (q + 1) : r * (q + 1) + (xcd - r) * q) + off; }
        const int nig = WGM * nN, gid = wgid / nig, fm = gid * WGM, gsz = (nM - fm) < WGM ? (nM - fm) : WGM;
        u.pm = fm + ((wgid % nig) % gsz); u.pn = (wgid % nig) / gsz; return true;
    }
    __device__ __forceinline__ void a_ready(const Unit&) const {}
    __device__ __forceinline__ void done(const Unit&) const {}
};
__device__ __forceinline__ unsigned cvt_pk_bf16(float lo, float hi) { unsigned r; asm volatile("v_cvt_pk_bf16_f32 %0, %1, %2" : "=v"(r) : "v"(lo), "v"(hi)); return r; }

template <class Epi, class Sched, bool ALIGN_EPI = false, bool SP2 = false>
__device__ __forceinline__ void gemm_phase(PG8_LAS unsigned char* lds, const Gemm g, const Sched& S, const Epi& E, const int wv) {
    int tid_ = wv * 64 + lane_id_v(); asm volatile("" : "+v"(tid_));
    const int tid = tid_, wid = __builtin_amdgcn_readfirstlane(tid >> 6), lane = tid & 63, wr = wid >> 2, wc = wid & 3, fr = lane & 15, fq = lane >> 4;
    const int K = g.K, nt = K / BK;
    unsigned voffA[2], voffB[2];
#pragma unroll
    for (int i = 0; i < 2; ++i) { int R, C; stage_rc(tid * 16 + i * 8192, R, C); const int Rb = Epi::PERM ? ((R & ~31) + perm32(R & 31)) : R;
        voffA[i] = (unsigned)(R * g.lda + C) * 2u; voffB[i] = (unsigned)(Rb * K + C) * 2u; }
    const size_t kstep = (size_t)(BK * 2);
    const size_t hstep = (size_t)HALF * K * 2, hstepA = (size_t)HALF * g.lda * 2;
    const size_t tstep = 2 * hstep, tstepA = 2 * hstepA;
    const unsigned ldsw = (unsigned)wid * 1024u;
    const int aoff = lds_byte(wr * 64 + fr, fq * 8), boff = lds_byte(wc * 32 + fr, fq * 8);
#define PG8_SA(b, h) (((b) * 2 + (h)) * HTB)
#define PG8_SB(b, h) ((4 + (b) * 2 + (h)) * HTB)
#if PG8_ASM_STAGE
#define PG8_STAGE(bufoff, gbase, voff) do { const unsigned m0a_ = (unsigned)(size_t)(lds + (bufoff)) + ldsw; const char* gb_ = (const char*)(gbase); \
        asm volatile("s_mov_b32 m0, %2\n\ts_nop 0\n\tglobal_load_lds_dwordx4 %0, %1" :: "v"((voff)[0]), "s"(gb_), "s"(m0a_) : "memory", "m0"); \
        asm volatile("s_add_i32 m0, %2, 0x2000\n\ts_nop 0\n\tglobal_load_lds_dwordx4 %0, %1" :: "v"((voff)[1]), "s"(gb_), "s"(m0a_) : "memory", "m0", "scc"); } while (0)
#else
#define PG8_STAGE(bufoff, gbase, voff) do { _Pragma("unroll") for (int _i = 0; _i < 2; ++_i) \
        __builtin_amdgcn_global_load_lds((const unsigned*)((const char*)(gbase) + (voff)[_i]), (PG8_LAS unsigned*)(lds + (bufoff) + ldsw + _i * 8192), 16, 0, 0); } while (0)
#endif
#define PG8_LDA(dst, b, h) do { _Pragma("unroll") for (int m = 0; m < 4; ++m) _Pragma("unroll") for (int k = 0; k < 2; ++k) dst[m][k] = *(const PG8_LAS bf16x8*)(lds + PG8_SA(b, h) + aoff + m * 2048 + k * 1024); } while (0)
#define PG8_LDB(dst, b, h) do { _Pragma("unroll") for (int n = 0; n < 2; ++n) _Pragma("unroll") for (int k = 0; k < 2; ++k) dst[n][k] = *(const PG8_LAS bf16x8*)(lds + PG8_SB(b, h) + boff + n * 2048 + k * 1024); } while (0)
#define PG8_MMA(ai, bj, At, Bt) do { __builtin_amdgcn_s_setprio(1); _Pragma("unroll") for (int m = 0; m < 4; ++m) _Pragma("unroll") for (int n = 0; n < 2; ++n) _Pragma("unroll") for (int k = 0; k < 2; ++k) \
        acc[ai][bj][m][n] = __builtin_amdgcn_mfma_f32_16x16x32_bf16(Bt[n][k], At[m][k], acc[ai][bj][m][n], 0, 0, 0); __builtin_amdgcn_s_setprio(0); } while (0)
#define PG8_WAIT_V(n) asm volatile("s_waitcnt vmcnt(" #n ")" ::: "memory")
#define PG8_WAIT_L(n) asm volatile("s_waitcnt lgkmcnt(" #n ")" ::: "memory")
#define PG8_BAR __builtin_amdgcn_s_barrier()
#define PG8_SCHED __builtin_amdgcn_sched_barrier(0)
    Unit cur, nxt; int ui = 0;
    if (!S.next(0, cur)) return;
    f32x4 acc[2][2][4][2];
#pragma unroll
    for (int a = 0; a < 2; ++a)
#pragma unroll
        for (int b = 0; b < 2; ++b)
#pragma unroll
            for (int m = 0; m < 4; ++m)
#pragma unroll
                for (int n = 0; n < 2; ++n) acc[a][b][m][n] = (f32x4){0.f, 0.f, 0.f, 0.f};
    bf16x8 At[4][2], B0[2][2], B1[2][2];
    const char* cA = (const char*)g.A + (size_t)cur.pm * tstepA; const char* cB = (const char*)g.Bt + (size_t)cur.pn * tstep;
    S.a_ready(cur);
    if constexpr (SP2) {
        PG8_STAGE(PG8_SB(0, 0), cB, voffB); PG8_STAGE(PG8_SB(0, 1), cB + hstep, voffB); PG8_STAGE(PG8_SA(0, 0), cA, voffA); PG8_STAGE(PG8_SA(0, 1), cA + hstepA, voffA);
        if (wr == 1) PG8_BAR;
        PG8_WAIT_V(2); PG8_BAR;
        PG8_STAGE(PG8_SB(1, 0), cB + kstep, voffB); PG8_STAGE(PG8_SA(1, 0), cA + kstep, voffA); PG8_STAGE(PG8_SB(1, 1), cB + hstep + kstep, voffB);
        PG8_WAIT_V(6); PG8_BAR;
    } else {
        PG8_STAGE(PG8_SB(0, 0), cB, voffB); PG8_STAGE(PG8_SA(0, 0), cA, voffA); PG8_STAGE(PG8_SB(0, 1), cB + hstep, voffB); PG8_STAGE(PG8_SA(0, 1), cA + hstepA, voffA);
        if (wr == 1) PG8_BAR;
        PG8_WAIT_V(4); PG8_BAR;
        PG8_STAGE(PG8_SB(1, 0), cB + kstep, voffB); PG8_STAGE(PG8_SA(1, 0), cA + kstep, voffA); PG8_STAGE(PG8_SB(1, 1), cB + hstep + kstep, voffB);
        PG8_WAIT_V(6); PG8_BAR;
    }
    for (;;) {
        const bool has_next = S.next(ui + 1, nxt);
        const char* nA = has_next ? (const char*)g.A + (size_t)nxt.pm * tstepA : cA; const char* nB = has_next ? (const char*)g.Bt + (size_t)nxt.pn * tstep : cB;
        for (int t = 0; t < nt; t += 2) {
            const bool last = (t == nt - 2);
            const char* a1 = cA + (size_t)(t + 1) * kstep;
            const char* a2 = last ? nA : cA + (size_t)(t + 2) * kstep; const char* b2 = last ? nB : cB + (size_t)(t + 2) * kstep;
            const char* a3 = a2 + kstep; const char* b3 = b2 + kstep;
            if (last && has_next) S.a_ready(nxt);
            if constexpr (SP2) {
            PG8_LDB(B0, 0, 0); PG8_LDB(B1, 0, 1); PG8_SCHED; PG8_LDA(At, 0, 0); PG8_STAGE(PG8_SA(1, 1), a1 + hstepA, voffA);
            PG8_WAIT_V(8); PG8_WAIT_L(0); PG8_BAR; PG8_MMA(0, 0, At, B0); PG8_MMA(0, 1, At, B1); PG8_BAR; PG8_SCHED;
            PG8_LDA(At, 0, 1); PG8_STAGE(PG8_SB(0, 0), b2, voffB); PG8_STAGE(PG8_SB(0, 1), b2 + hstep, voffB); PG8_STAGE(PG8_SA(0, 0), a2, voffA);
            PG8_WAIT_V(8); PG8_WAIT_L(0); PG8_BAR; PG8_MMA(1, 0, At, B0); PG8_MMA(1, 1, At, B1); PG8_BAR; PG8_SCHED;
            PG8_LDB(B0, 1, 0); PG8_LDB(B1, 1, 1); PG8_SCHED; PG8_LDA(At, 1, 0); PG8_STAGE(PG8_SA(0, 1), a2 + hstepA, voffA);
            PG8_WAIT_V(8); PG8_WAIT_L(0); PG8_BAR; PG8_MMA(0, 0, At, B0); PG8_MMA(0, 1, At, B1); PG8_BAR; PG8_SCHED;
            PG8_LDA(At, 1, 1); PG8_STAGE(PG8_SB(1, 0), b3, voffB); PG8_STAGE(PG8_SB(1, 1), b3 + hstep, voffB); PG8_STAGE(PG8_SA(1, 0), a3, voffA);
            PG8_WAIT_V(8); PG8_WAIT_L(0); PG8_BAR; PG8_MMA(1, 0, At, B0); PG8_MMA(1, 1, At, B1); PG8_BAR; PG8_SCHED;
            } else {
            PG8_LDB(B0, 0, 0); PG8_SCHED; PG8_LDA(At, 0, 0); PG8_STAGE(PG8_SA(1, 1), a1 + hstepA, voffA);
            PG8_WAIT_L(8); PG8_BAR; PG8_WAIT_L(0); PG8_MMA(0, 0, At, B0); PG8_BAR; PG8_SCHED;
            PG8_LDB(B1, 0, 1); PG8_STAGE(PG8_SB(0, 0), b2, voffB);
            PG8_BAR; PG8_WAIT_L(0); PG8_MMA(0, 1, At, B1); PG8_BAR;
            PG8_LDA(At, 0, 1); PG8_STAGE(PG8_SA(0, 0), a2, voffA);
            PG8_BAR; PG8_WAIT_L(0); PG8_MMA(1, 0, At, B0); PG8_BAR; PG8_SCHED;
            PG8_STAGE(PG8_SB(0, 1), b2 + hstep, voffB);
            PG8_WAIT_V(6); PG8_BAR; PG8_MMA(1, 1, At, B1); PG8_BAR;
            PG8_LDB(B0, 1, 0); PG8_SCHED; PG8_LDA(At, 1, 0); PG8_STAGE(PG8_SA(0, 1), a2 + hstepA, voffA);
            PG8_WAIT_L(8); PG8_BAR; PG8_WAIT_L(0); PG8_MMA(0, 0, At, B0); PG8_BAR; PG8_SCHED;
            PG8_LDB(B1, 1, 1); PG8_STAGE(PG8_SB(1, 0), b3, voffB);
            PG8_BAR; PG8_WAIT_L(0); PG8_MMA(0, 1, At, B1); PG8_BAR;
            PG8_LDA(At, 1, 1); PG8_STAGE(PG8_SA(1, 0), a3, voffA);
            PG8_BAR; PG8_WAIT_L(0); PG8_MMA(1, 0, At, B0); PG8_BAR; PG8_SCHED;
            PG8_STAGE(PG8_SB(1, 1), b3 + hstep, voffB);
            PG8_WAIT_V(6); PG8_BAR; PG8_MMA(1, 1, At, B1); PG8_BAR;
            }
        }
        if constexpr (ALIGN_EPI) { if (wr == 0) PG8_BAR; }
        if constexpr (!Epi::AFTER_DRAIN) { const int ln_ = lane_id_v(); E(acc, cur, wr, wc, ln_ & 15, ln_ >> 4); S.done(cur); }
        if (!has_next) break;
#pragma unroll
        for (int a = 0; a < 2; ++a)
#pragma unroll
            for (int b = 0; b < 2; ++b)
#pragma unroll
                for (int m = 0; m < 4; ++m)
#pragma unroll
                    for (int n = 0; n < 2; ++n) acc[a][b][m][n] = (f32x4){0.f, 0.f, 0.f, 0.f};
        cur = nxt; cA = nA; cB = nB; ++ui;
        if constexpr (ALIGN_EPI) { if (wr == 1) PG8_BAR; }
    }
    PG8_WAIT_V(0);
    if constexpr (!ALIGN_EPI) { if (wr == 0) PG8_BAR; }
    PG8_BAR;
    if constexpr (Epi::AFTER_DRAIN) { E.fused(acc, cur, wr, wc, fr, fq, lds, wid, lane); S.done(cur); }
#undef PG8_SA
#undef PG8_SB
#undef PG8_STAGE
#undef PG8_LDA
#undef PG8_LDB
#undef PG8_MMA
#undef PG8_WAIT_V
#undef PG8_WAIT_L
#undef PG8_BAR
#undef PG8_SCHED
}

constexpr float NORM_EPS = 1e-6f;
__device__ __forceinline__ float row_rstd(const float* ssq, int row, int fq) {
    const f32x4 a = *(const f32x4*)(ssq + (size_t)row * 32 + fq * 8), b = *(const f32x4*)(ssq + (size_t)row * 32 + fq * 8 + 4);
    float s = ((a[0] + a[1]) + (a[2] + a[3])) + ((b[0] + b[1]) + (b[2] + b[3]));
    s += __shfl_xor(s, 16); s += __shfl_xor(s, 32);
    return rsqrtf(s * (1.0f / 2048.0f) + NORM_EPS);
}
__device__ __forceinline__ float fsigmoid(float x) { return __builtin_amdgcn_rcpf(1.0f + __expf(-x)); }
__device__ __forceinline__ u32x4 pack8(const f32x4 v0, const f32x4 v1) { u32x4 w; w.x = cvt_pk_bf16(v0[0], v0[1]); w.y = cvt_pk_bf16(v0[2], v0[3]); w.z = cvt_pk_bf16(v1[0], v1[1]); w.w = cvt_pk_bf16(v1[2], v1[3]); return w; }
__device__ __forceinline__ void unpack8(const u32x4 w, f32x4& v0, f32x4& v1) {
    v0[0] = __uint_as_float(w.x << 16); v0[1] = __uint_as_float(w.x & 0xffff0000u); v0[2] = __uint_as_float(w.y << 16); v0[3] = __uint_as_float(w.y & 0xffff0000u);
    v1[0] = __uint_as_float(w.z << 16); v1[1] = __uint_as_float(w.z & 0xffff0000u); v1[2] = __uint_as_float(w.w << 16); v1[3] = __uint_as_float(w.w & 0xffff0000u); }

struct EpiSwiGLU {
    static constexpr bool PERM = true, AFTER_DRAIN = false;
    const float* ssq; bf16_t* H; int ldh;
    __device__ __forceinline__ void operator()(const f32x4 (&acc)[2][2][4][2], const Unit& u, int wr, int wc, int fr, int fq) const {
        const int row0 = u.pm * BM + wr * 64 + fr, col0 = u.pn * HALF + wc * 32 + 8 * fq;
        float rs[2][4];
#pragma unroll
        for (int ai = 0; ai < 2; ++ai)
#pragma unroll
            for (int m = 0; m < 4; ++m) rs[ai][m] = row_rstd(ssq, row0 + ai * HALF + m * 16, fq);
#pragma unroll
        for (int ai = 0; ai < 2; ++ai)
#pragma unroll
            for (int m = 0; m < 4; ++m) { const int row = row0 + ai * HALF + m * 16; const float r = rs[ai][m];
                f32x4 h0, h1;
#pragma unroll
                for (int j = 0; j < 4; ++j) { const float g0 = acc[ai][0][m][0][j] * r, g1 = acc[ai][0][m][1][j] * r;
                    h0[j] = g0 * fsigmoid(g0) * (acc[ai][1][m][0][j] * r); h1[j] = g1 * fsigmoid(g1) * (acc[ai][1][m][1][j] * r); }
                *(u32x4*)(H + (size_t)row * ldh + col0) = pack8(h0, h1); }
    }
};
struct EpiResid {
    static constexpr bool PERM = true, AFTER_DRAIN = false;
    const float* base; float* out; bf16_t* xb; float* ssq; float alpha;
    __device__ __forceinline__ void operator()(const f32x4 (&acc)[2][2][4][2], const Unit& u, int wr, int wc, int fr, int fq) const {
        const int row0 = u.pm * BM + wr * 64 + fr, col0 = u.pn * BM + wc * 32 + 8 * fq;
#pragma unroll
        for (int ai = 0; ai < 2; ++ai) {
            f32x4 bv[4][2][2];
#pragma unroll
            for (int m = 0; m < 4; ++m)
#pragma unroll
                for (int bj = 0; bj < 2; ++bj) { const size_t off = (size_t)(row0 + ai * HALF + m * 16) * 2048 + col0 + bj * HALF;
                    bv[m][bj][0] = *(const f32x4*)(base + off); bv[m][bj][1] = *(const f32x4*)(base + off + 4); }
#pragma unroll
            for (int m = 0; m < 4; ++m) { const int row = row0 + ai * HALF + m * 16; float ss = 0.f;
#pragma unroll
                for (int bj = 0; bj < 2; ++bj) { const size_t off = (size_t)row * 2048 + col0 + bj * HALF;
                    const f32x4 v0 = bv[m][bj][0] + acc[ai][bj][m][0] * alpha, v1 = bv[m][bj][1] + acc[ai][bj][m][1] * alpha;
                    *(f32x4*)(out + off) = v0; *(f32x4*)(out + off + 4) = v1;
                    ss += ((v0[0] * v0[0] + v0[1] * v0[1]) + (v0[2] * v0[2] + v0[3] * v0[3])) + ((v1[0] * v1[0] + v1[1] * v1[1]) + (v1[2] * v1[2] + v1[3] * v1[3]));
                    *(u32x4*)(xb + off) = pack8(v0, v1); }
                ss += __shfl_xor(ss, 16); ss += __shfl_xor(ss, 32);
                if (fq == 0) ssq[(size_t)row * 32 + u.pn * 4 + wc] = ss; }
            asm volatile("" ::: "memory"); }
    }
};
struct EpiWin {
    static constexpr bool PERM = true, AFTER_DRAIN = false;
    const float* ssq; bf16_t* u1; bf16_t* u2; int ld1, ld2;
    __device__ __forceinline__ void operator()(const f32x4 (&acc)[2][2][4][2], const Unit& u, int wr, int wc, int fr, int fq) const {
        const int row0 = u.pm * BM + wr * 64 + fr; const int mode = u.pn < 17 ? 0 : (u.pn < 19 ? 1 : 2);
        bf16_t* dst = mode == 2 ? u2 : u1; const int ld = mode == 2 ? ld2 : ld1; const int col0 = (mode == 2 ? (u.pn - 19) : u.pn) * BM + wc * 32 + 8 * fq;
        float rsv[2][4];
#pragma unroll
        for (int ai = 0; ai < 2; ++ai)
#pragma unroll
            for (int m = 0; m < 4; ++m) rsv[ai][m] = row_rstd(ssq, row0 + ai * HALF + m * 16, fq);
#pragma unroll
        for (int ai = 0; ai < 2; ++ai)
#pragma unroll
            for (int m = 0; m < 4; ++m) { const int row = row0 + ai * HALF + m * 16; const float rs = rsv[ai][m];
#pragma unroll
                for (int bj = 0; bj < 2; ++bj) { f32x4 v0 = acc[ai][bj][m][0] * rs, v1 = acc[ai][bj][m][1] * rs;
                    if (mode == 1) {
#pragma unroll
                        for (int j = 0; j < 4; ++j) { v0[j] = v0[j] * fsigmoid(v0[j]); v1[j] = v1[j] * fsigmoid(v1[j]); } }
                    else if (mode == 2) {
#pragma unroll
                        for (int j = 0; j < 4; ++j) { v0[j] = fsigmoid(v0[j]); v1[j] = fsigmoid(v1[j]); } }
                    *(u32x4*)(dst + (size_t)row * ld + col0 + bj * HALF) = pack8(v0, v1); } }
    }
};
struct EpiBf16 {
    static constexpr bool PERM = true, AFTER_DRAIN = false;
    bf16_t* O; int ldc;
    __device__ __forceinline__ void operator()(const f32x4 (&acc)[2][2][4][2], const Unit& u, int wr, int wc, int fr, int fq) const {
        const int row0 = u.pm * BM + wr * 64 + fr, col0 = u.pn * BM + wc * 32 + 8 * fq;
#pragma unroll
        for (int ai = 0; ai < 2; ++ai)
#pragma unroll
            for (int m = 0; m < 4; ++m) { bf16_t* rowp = O + (size_t)(row0 + ai * HALF + m * 16) * ldc + col0;
#pragma unroll
                for (int bj = 0; bj < 2; ++bj) *(u32x4*)(rowp + bj * HALF) = pack8(acc[ai][bj][m][0], acc[ai][bj][m][1]); }
    }
};
struct EpiF32 {
    static constexpr bool PERM = false, AFTER_DRAIN = false;
    float* C; int ldc;
    __device__ __forceinline__ void operator()(const f32x4 (&acc)[2][2][4][2], const Unit& u, int wr, int wc, int fr, int fq) const {
        const int row0 = u.pm * BM + wr * 64 + fr, col0 = u.pn * BM + wc * 32 + 4 * fq;
#pragma unroll
        for (int ai = 0; ai < 2; ++ai)
#pragma unroll
            for (int m = 0; m < 4; ++m) { float* rowp = C + (size_t)(row0 + ai * HALF + m * 16) * ldc + col0;
#pragma unroll
                for (int bj = 0; bj < 2; ++bj)
#pragma unroll
                    for (int n = 0; n < 2; ++n) *(f32x4*)(rowp + bj * HALF + n * 16) = acc[ai][bj][m][n]; }
    }
};
template <int MODE> struct EpiMerge {
    static constexpr bool PERM = true, AFTER_DRAIN = false;
    const bf16_t* gate; int ldg; float* m32; bf16_t* mb;
    __device__ __forceinline__ void operator()(const f32x4 (&acc)[2][2][4][2], const Unit& u, int wr, int wc, int fr, int fq) const {
        const int row0 = u.pm * BM + wr * 64 + fr, col0 = u.pn * BM + wc * 32 + 8 * fq;
#pragma unroll
        for (int ai = 0; ai < 2; ++ai)
#pragma unroll
            for (int mp = 0; mp < 2; ++mp) {
                u32x4 gw[2][2]; f32x4 mv[2][2][2];
#pragma unroll
                for (int mi = 0; mi < 2; ++mi)
#pragma unroll
                    for (int bj = 0; bj < 2; ++bj) { const int row = row0 + ai * HALF + (2 * mp + mi) * 16, col = col0 + bj * HALF; const size_t off = (size_t)row * 2048 + col;
                        gw[mi][bj] = *(const u32x4*)(gate + (size_t)row * ldg + col);
                        if (MODE >= 1) { mv[mi][bj][0] = *(const f32x4*)(m32 + off); mv[mi][bj][1] = *(const f32x4*)(m32 + off + 4); } }
#pragma unroll
                for (int mi = 0; mi < 2; ++mi)
#pragma unroll
                    for (int bj = 0; bj < 2; ++bj) { const int m = 2 * mp + mi; const int row = row0 + ai * HALF + m * 16, col = col0 + bj * HALF; const size_t off = (size_t)row * 2048 + col;
                        f32x4 g0, g1; unpack8(gw[mi][bj], g0, g1);
                        f32x4 v0 = g0 * acc[ai][bj][m][0], v1 = g1 * acc[ai][bj][m][1];
                        if (MODE >= 1) { v0 += mv[mi][bj][0]; v1 += mv[mi][bj][1]; }
                        if (MODE <= 1) { *(f32x4*)(m32 + off) = v0; *(f32x4*)(m32 + off + 4) = v1; }
                        else *(u32x4*)(mb + off) = pack8(v0, v1); }
                asm volatile("" ::: "memory"); }
    }
};
}

#define GAS __attribute__((address_space(1)))
#define LAS __attribute__((address_space(3)))
typedef unsigned short bf16_t;
typedef short bf16x8 __attribute__((ext_vector_type(8)));
typedef short s16x4 __attribute__((ext_vector_type(4)));
typedef float f32x4 __attribute__((ext_vector_type(4)));
typedef float f32x16 __attribute__((ext_vector_type(16)));
typedef unsigned u32x4 __attribute__((ext_vector_type(4)));
typedef unsigned u32x2 __attribute__((ext_vector_type(2)));
#define LDS_WAIT() asm volatile("s_waitcnt lgkmcnt(0)" ::: "memory")
#define VM_WAIT() asm volatile("s_waitcnt vmcnt(0)" ::: "memory")
#define SBAR() __builtin_amdgcn_sched_barrier(0)
__device__ __forceinline__ unsigned f2bf(float f) { unsigned u = __builtin_bit_cast(unsigned, f); return (u + 0x7fffu + ((u >> 16) & 1u)) >> 16; }
__device__ __forceinline__ float bf2f(bf16_t b) { return __uint_as_float(((unsigned)b) << 16); }
__device__ __forceinline__ unsigned pk2(float lo, float hi) { return f2bf(lo) | (f2bf(hi) << 16); }
__device__ __forceinline__ float wave_sum(float v) {
#pragma unroll
    for (int o = 1; o < 64; o <<= 1) v += __shfl_xor(v, o);
    return v;
}

constexpr int NB = 2, SEQ = 16384, MTOK = NB * SEQ, DM = 2048, FF = 5504, DEPTH = 4;
constexpr int NGU = 2 * FF, NIN = 11008, U1W = 4864, U2W = 6144;
constexpr int C_CQ = 0, C_CKV = 512, C_QB = 768, C_KB = 1024, C_VB = 1280, C_QC = 1792, C_KC = 2560, C_VC = 3328, C_KROPE = 4096, C_GLR = 4160, C_RB = 4352;
constexpr int QRAW_LD = 1280, KVRAW_LD = 1536;
constexpr float EPS = 1e-6f, LOG2E = 1.4426950408889634f, LN2 = 0.6931471805599453f;
constexpr float QS_MLA = 0.07216878364870322f * LOG2E;
constexpr float QS_DSWA = 0.08838834764831845f * LOG2E;

namespace att {
constexpr int SHM_V = 64 * 128 * 2;
constexpr int K_OFF = 2 * SHM_V;
template <int DQK> struct Geo { static constexpr int KP = DQK * 2 + 16, SHM_K = 64 * KP, NCH = DQK / 8, NKST = (64 * NCH) / 512, WS_OFF = K_OFF + 2 * SHM_K; };
__device__ __forceinline__ int v_st(int k, int c) { const int kk = (k & ~0xC) | ((k & 4) << 1) | ((k & 8) >> 1); return ((kk >> 3) * 4 + (c >> 5)) * 512 + ((kk & 7) * 32 + (c & 31)) * 2; }
__device__ __forceinline__ int v_rd_base(int lane) { return ((lane & 3) << 3) | (((lane >> 2) & 3) << 6) | (((lane >> 4) & 1) << 5) | (((lane >> 5) & 1) << 8); }
constexpr int v_rd_off(int d0, int ks, int half) { return d0 * 512 + ks * 4096 + half * 2048; }
__device__ __forceinline__ int crow(int r, int hi) { return (r & 3) + 8 * (r >> 2) + 4 * hi; }
__device__ __forceinline__ unsigned cvtpk(float lo, float hi) { unsigned r; asm volatile("v_cvt_pk_bf16_f32 %0, %1, %2" : "=v"(r) : "v"(lo), "v"(hi)); return r; }

__device__ __forceinline__ void pv_tile(f32x16* o, int vb, bf16x8 pa0, bf16x8 pa1, bf16x8 pa2, bf16x8 pa3) {
#define TRRD(dst, off) asm volatile("ds_read_b64_tr_b16 %0, %1 offset:%2" : "=&v"(dst) : "v"(vb), "i"(off) : "memory")
#define PV_D0(d0) do { s16x4 l0, l1, l2, l3, h0, h1, h2, h3; constexpr int b_ = v_rd_off(d0, 0, 0); \
        TRRD(l0, b_); TRRD(h0, b_ + 2048); TRRD(l1, b_ + 4096); TRRD(h1, b_ + 6144); TRRD(l2, b_ + 8192); TRRD(h2, b_ + 10240); TRRD(l3, b_ + 12288); TRRD(h3, b_ + 14336); \
        asm volatile("s_waitcnt lgkmcnt(0)" ::: "memory"); SBAR(); \
        o[d0] = __builtin_amdgcn_mfma_f32_32x32x16_bf16(pa0, (bf16x8){l0[0], l0[1], l0[2], l0[3], h0[0], h0[1], h0[2], h0[3]}, o[d0], 0, 0, 0); \
        o[d0] = __builtin_amdgcn_mfma_f32_32x32x16_bf16(pa1, (bf16x8){l1[0], l1[1], l1[2], l1[3], h1[0], h1[1], h1[2], h1[3]}, o[d0], 0, 0, 0); \
        o[d0] = __builtin_amdgcn_mfma_f32_32x32x16_bf16(pa2, (bf16x8){l2[0], l2[1], l2[2], l2[3], h2[0], h2[1], h2[2], h2[3]}, o[d0], 0, 0, 0); \
        o[d0] = __builtin_amdgcn_mfma_f32_32x32x16_bf16(pa3, (bf16x8){l3[0], l3[1], l3[2], l3[3], h3[0], h3[1], h3[2], h3[3]}, o[d0], 0, 0, 0); } while (0)
    PV_D0(0); PV_D0(1); PV_D0(2); PV_D0(3);
#undef PV_D0
#undef TRRD
}

struct AUnit { const bf16_t* Q; const bf16_t* K; const bf16_t* V; bf16_t* O; float* lse; size_t qpitch, kpitch, vpitch, opitch, lsepitch; int q0, j_lo, j_hi; float bias_c; };

template <int DQK, int MODE>
__device__ __forceinline__ void attn_unit(LAS unsigned char* lds, const AUnit& u, const int wv) {
    using G = Geo<DQK>;
    int tid_ = wv * 64 + lane_id_v(); asm volatile("" : "+v"(tid_));
    const int tid = tid_, wid = __builtin_amdgcn_readfirstlane(tid >> 6), lane = tid & 63, r32 = lane & 31, hi = lane >> 5;
    LAS unsigned char* V_lds = lds; LAS unsigned char* K_lds = lds + K_OFF;
    LAS float* wsl = (LAS float*)(lds + G::WS_OFF) + wid * 64; LAS float* li_l = wsl; LAS float* al_l = wsl + 32;
    bf16x8 qr[DQK / 16];
    { const bf16_t* qrow = u.Q + (size_t)(wid * 32 + r32) * u.qpitch + hi * 8;
#pragma unroll
      for (int d0 = 0; d0 < DQK / 16; ++d0) qr[d0] = *(const bf16x8*)(qrow + d0 * 16); }
    float m_reg = -1e30f, l_reg = 0.f; f32x16 o[4] = {};
    bf16x8 stk[G::NKST], stv0, stv1;
    const int sr = tid >> 4, sc = (tid & 15) * 8, vst0 = v_st(sr, sc), vst1 = v_st(32 + sr, sc);
    const int vb0 = (int)(size_t)V_lds + v_rd_base(lane);
    const int qlo = u.q0 + wid * 32, qj = qlo + r32;
#define ST_LOAD(t) do { const int k0_ = (t) * 64; _Pragma("unroll") for (int i_ = 0; i_ < G::NKST; ++i_) { const int cid_ = tid + 512 * i_, row_ = cid_ / G::NCH, ch_ = cid_ % G::NCH; \
            stk[i_] = *(const bf16x8*)(u.K + (size_t)(k0_ + row_) * u.kpitch + ch_ * 8); } \
        stv0 = *(const bf16x8*)(u.V + (size_t)(k0_ + sr) * u.vpitch + sc); stv1 = *(const bf16x8*)(u.V + (size_t)(k0_ + 32 + sr) * u.vpitch + sc); } while (0)
#define ST_WRITE(bf) do { _Pragma("unroll") for (int i_ = 0; i_ < G::NKST; ++i_) { const int cid_ = tid + 512 * i_, row_ = cid_ / G::NCH, ch_ = cid_ % G::NCH; \
            *(LAS bf16x8*)(K_lds + (bf) * G::SHM_K + row_ * G::KP + ch_ * 16) = stk[i_]; } \
        *(LAS bf16x8*)(V_lds + (bf) * SHM_V + vst0) = stv0; *(LAS bf16x8*)(V_lds + (bf) * SHM_V + vst1) = stv1; } while (0)
    ST_LOAD(u.j_lo);
    for (int t = u.j_lo; t < u.j_hi; ++t) {
        const int buf = (t - u.j_lo) & 1;
        VM_WAIT(); ST_WRITE(buf);
        __syncthreads();
        if (t + 1 < u.j_hi) ST_LOAD(t + 1);
        f32x16 p0 = {}, p1 = {};
        { const LAS unsigned char* kb = K_lds + buf * G::SHM_K + r32 * G::KP + hi * 16;
#pragma unroll
          for (int d0 = 0; d0 < DQK / 16; ++d0) { const bf16x8 b0 = *(const LAS bf16x8*)(kb + d0 * 32), b1 = *(const LAS bf16x8*)(kb + 32 * G::KP + d0 * 32);
              p0 = __builtin_amdgcn_mfma_f32_32x32x16_bf16(b0, qr[d0], p0, 0, 0, 0);
              p1 = __builtin_amdgcn_mfma_f32_32x32x16_bf16(b1, qr[d0], p1, 0, 0, 0); } }
        const float NEG = -__builtin_inff(); const int kb0 = t * 64;
        if (MODE == 0) {
            if (kb0 + 63 > qlo) {
#pragma unroll
                for (int r = 0; r < 16; ++r) { const int key = kb0 + (r & 3) + 8 * (r >> 2) + 4 * hi; if (key > qj) p0[r] = NEG; if (key + 32 > qj) p1[r] = NEG; } }
        } else {
#pragma unroll
            for (int r = 0; r < 16; ++r) { const int dist = qj - (kb0 + (r & 3) + 8 * (r >> 2) + 4 * hi), dist2 = dist - 32;
                p0[r] = ((unsigned)dist <= 128u) ? p0[r] - u.bias_c * (float)dist : NEG;
                p1[r] = ((unsigned)dist2 <= 128u) ? p1[r] - u.bias_c * (float)dist2 : NEG; }
        }
        float pmax = p0[0];
#pragma unroll
        for (int r = 1; r < 16; ++r) pmax = fmaxf(pmax, p0[r]);
#pragma unroll
        for (int r = 0; r < 16; ++r) pmax = fmaxf(pmax, p1[r]);
        { auto rr = __builtin_amdgcn_permlane32_swap(__float_as_uint(pmax), __float_as_uint(pmax), false, false); pmax = fmaxf(__uint_as_float(rr[0]), __uint_as_float(rr[1])); }
        const float mn = fmaxf(m_reg, pmax); const float alpha = __builtin_amdgcn_exp2f(m_reg - mn); m_reg = mn;
#pragma unroll
        for (int r = 0; r < 16; ++r) { p0[r] = __builtin_amdgcn_exp2f(p0[r] - mn); p1[r] = __builtin_amdgcn_exp2f(p1[r] - mn); }
        float ps = 0.f;
#pragma unroll
        for (int r = 0; r < 16; ++r) ps += p0[r] + p1[r];
        { auto rr = __builtin_amdgcn_permlane32_swap(__float_as_uint(ps), __float_as_uint(ps), false, false); ps = __uint_as_float(rr[0]) + __uint_as_float(rr[1]); }
        l_reg = l_reg * alpha + ps;
        bf16x8 pa0, pa1, pa2, pa3;
#define PK4(P, B_, OUT) do { unsigned a0 = cvtpk(P[B_ + 0], P[B_ + 1]), a1 = cvtpk(P[B_ + 2], P[B_ + 3]); unsigned b0 = cvtpk(P[B_ + 4], P[B_ + 5]), b1 = cvtpk(P[B_ + 6], P[B_ + 7]); \
        auto r0 = __builtin_amdgcn_permlane32_swap(a0, b0, false, false); auto r1 = __builtin_amdgcn_permlane32_swap(a1, b1, false, false); \
        u32x4 w = {r0[0], r1[0], r0[1], r1[1]}; OUT = *reinterpret_cast<bf16x8*>(&w); } while (0)
        PK4(p0, 0, pa0); PK4(p0, 8, pa1); PK4(p1, 0, pa2); PK4(p1, 8, pa3);
#undef PK4
        if (__any(alpha < 1.f)) { if (hi == 0) al_l[r32] = alpha; LDS_WAIT();
#pragma unroll
            for (int r = 0; r < 16; ++r) { const float a = al_l[(r & 3) + 8 * (r >> 2) + 4 * hi];
#pragma unroll
                for (int d = 0; d < 4; ++d) o[d][r] *= a; } }
        pv_tile(o, vb0 + buf * SHM_V, pa0, pa1, pa2, pa3);
    }
    if (hi == 0) li_l[r32] = l_reg; LDS_WAIT();
    float rli[16];
#pragma unroll
    for (int r = 0; r < 16; ++r) rli[r] = __builtin_amdgcn_rcpf(li_l[(r & 3) + 8 * (r >> 2) + 4 * hi]);
    bf16_t* Ow = u.O + (size_t)(wid * 32) * u.opitch;
#pragma unroll
    for (int r = 0; r < 16; ++r) { const int orow = (r & 3) + 8 * (r >> 2) + 4 * hi;
#pragma unroll
        for (int d0 = 0; d0 < 4; ++d0) { const float v = o[d0][r] * rli[r]; const float vn = __shfl_xor(v, 1);
            if ((r32 & 1) == 0) *(unsigned*)(Ow + (size_t)orow * u.opitch + d0 * 32 + r32) = cvtpk(v, vn); } }
    if (MODE == 1) { if (hi == 0) u.lse[(size_t)(wid * 32 + r32) * u.lsepitch] = (m_reg + __log2f(l_reg)) * LN2; }
    __syncthreads();
#undef ST_LOAD
#undef ST_WRITE
}
}

constexpr size_t al256(size_t x) { return (x + 255) & ~(size_t)255; }
constexpr size_t WS_CTL = 0, CTL_BYTES = 1u << 20;
constexpr size_t WS_ROPE = WS_CTL + CTL_BYTES;
constexpr size_t WS_SSQ = WS_ROPE + al256((size_t)MTOK * 64 * 4);
constexpr size_t WS_XB = WS_SSQ + al256((size_t)MTOK * 32 * 4);
constexpr size_t WS_W = WS_XB + al256((size_t)MTOK * DM * 2);
constexpr size_t W_GU1 = 0, W_D1 = W_GU1 + (size_t)NGU * DM, W_IN = W_D1 + (size_t)DM * FF, W_UQ = W_IN + (size_t)NIN * DM, W_UKV = W_UQ + (size_t)1280 * 512,
                 W_A = W_UKV + (size_t)1536 * 256, W_B = W_A + (size_t)DM * 768, W_C = W_B + (size_t)DM * 512, W_OUT = W_C + (size_t)DM * 256, W_GU2 = W_OUT + (size_t)DM * DM,
                 W_D2 = W_GU2 + (size_t)NGU * DM, W_END = W_D2 + (size_t)DM * FF;
constexpr size_t WS_R1 = WS_W + al256(W_END * 2);
constexpr size_t WS_R2 = WS_R1 + al256((size_t)MTOK * U2W * 2);
constexpr size_t WS_QKV = WS_R2 + al256((size_t)MTOK * U1W * 2);
constexpr size_t QKV_Q = 0, QKV_K = (size_t)NB * 6 * SEQ * 192 * 2, QKV_V = 2 * QKV_K, QKV_END = QKV_V + (size_t)NB * 6 * SEQ * 128 * 2;
constexpr size_t WS_R3 = WS_QKV + al256(QKV_END);
constexpr size_t R3_QRAW = 0, R3_KVRAW = (size_t)MTOK * QRAW_LD * 2, R3_RAW_END = R3_KVRAW + (size_t)MTOK * KVRAW_LD * 2;
constexpr size_t R3_YA = 0, R3_YB = R3_YA + (size_t)MTOK * 768 * 2, R3_YC = R3_YB + (size_t)MTOK * 512 * 2, R3_DO = R3_YC + (size_t)MTOK * 256 * 2, R3_LSE = R3_DO + (size_t)MTOK * 768 * 2;
constexpr size_t R3_END = (R3_LSE + (size_t)MTOK * 6 * 4) > R3_RAW_END ? (R3_LSE + (size_t)MTOK * 6 * 4) : R3_RAW_END;
constexpr size_t WS_GLA = WS_R3 + al256(R3_END);
constexpr size_t GLA_DS = 0, GLA_BC = (size_t)2048 * 8192 * 4, GLA_DEC = GLA_BC + (size_t)MTOK * 256 * 4, GLA_END = GLA_DEC + (size_t)2048 * 64 * 4;
constexpr size_t WS_END = WS_GLA + al256(GLA_END);
constexpr int CW_BAR = 1024;
constexpr int CW_QUEUE = 16384;

constexpr int RING_BYTES = 131072, LDSCTL_OFF = RING_BYTES, LDS_BYTES = 147456;
constexpr int NWAVES = 8, NTHR = 512;

#define XB_TMO      128
#define XB_XCNT(j)  (256  + 64 * (j))
#define XB_XSUB(j)  (1280 + 64 * (j))
#define XB_XGEN(j)  (2304 + 64 * (j))
#define XB_TOP      3328
#define XB_TOPGEN   3392
#define XCD_BAR_WORDS 3456
#define XB_SPIN_CAP (1u << 20)
__device__ __forceinline__ unsigned xb_ld(unsigned* p)              { return __hip_atomic_load(p, __ATOMIC_RELAXED, __HIP_MEMORY_SCOPE_AGENT); }
__device__ __forceinline__ unsigned xb_add(unsigned* p, unsigned v) { return __hip_atomic_fetch_add(p, v, __ATOMIC_RELAXED, __HIP_MEMORY_SCOPE_AGENT); }
__device__ __forceinline__ unsigned xb_xcc_id() { return (unsigned)__builtin_amdgcn_s_getreg((3 << 11) | 20) & 0xFu; }
#define XB_SPIN(cond, bar) do { unsigned _sp = 0; while (cond) { __builtin_amdgcn_s_sleep(1); \
    if ((++_sp & 255u) == 0u) { if (xb_ld(&(bar)[XB_TMO])) break; if (_sp > XB_SPIN_CAP) { atomicAdd(&(bar)[XB_TMO], 1u); break; } } } } while (0)
struct XcdBarrier { unsigned* bar; unsigned x; volatile LAS unsigned* st; int wv; };
__device__ __forceinline__ bool xb_thread0(int wv) { return wv == 0 && lane_id_v() == 0; }
__device__ __forceinline__ XcdBarrier xcd_barrier_post(unsigned* bar, volatile LAS unsigned* st, int wv) {
    XcdBarrier b; b.bar = bar; b.x = xb_xcc_id(); b.st = st; b.wv = wv;
    if (xb_thread0(wv)) (void)xb_add(&bar[XB_XCNT(b.x)], 1u);
    return b;
}
__device__ __forceinline__ void xcd_barrier_complete(unsigned* bar, unsigned x, unsigned& nloc, unsigned& nx) {
    const unsigned G = gridDim.x * gridDim.y * gridDim.z;
    unsigned sum, cnt, mine, sp = 0u;
    for (;;) {
        sum = 0u; cnt = 0u; mine = 0u;
#pragma unroll
        for (unsigned j = 0; j < 16; ++j) { const unsigned c = xb_ld(&bar[XB_XCNT(j)]); sum += c; cnt += (c > 0u) ? 1u : 0u; mine = (j == x) ? c : mine; }
        if (sum == G) break;
        __builtin_amdgcn_s_sleep(1);
        if ((++sp & 255u) == 0u) { if (xb_ld(&bar[XB_TMO])) break; if (sp > XB_SPIN_CAP) { atomicAdd(&bar[XB_TMO], 1u); break; } }
    }
    nloc = mine > 0u ? mine : 1u; nx = cnt > 0u ? cnt : 1u;
}
template <bool FIRST> __device__ __forceinline__ void xcd_barrier(const XcdBarrier& b) {
    asm volatile("s_waitcnt vmcnt(0)" ::: "memory");
    __syncthreads();
    if (xb_thread0(b.wv)) {
        unsigned* bar = b.bar;
        __builtin_amdgcn_s_waitcnt(0);
        unsigned nloc = b.st[0], nx = b.st[1];
        if (FIRST) { xcd_barrier_complete(bar, b.x, nloc, nx); b.st[0] = nloc; b.st[1] = nx; }
        const unsigned old = xb_add(&bar[XB_XSUB(b.x)], 1u);
        const unsigned gen = old / nloc;
        if (old + 1u == (gen + 1u) * nloc) {
            __builtin_amdgcn_fence(__ATOMIC_RELEASE, "agent");
            asm volatile("s_waitcnt vmcnt(0)" ::: "memory");
            const unsigned og = xb_add(&bar[XB_TOP], 1u);
            const unsigned tg = og / nx;
            if (og + 1u == (tg + 1u) * nx) xb_add(&bar[XB_TOPGEN], 1u);
            else XB_SPIN(xb_ld(&bar[XB_TOPGEN]) == tg, bar);
            __builtin_amdgcn_fence(__ATOMIC_ACQUIRE, "agent");
            xb_add(&bar[XB_XGEN(b.x)], 1u);
            asm volatile("s_waitcnt vmcnt(0)" ::: "memory");
        } else {
            XB_SPIN(xb_ld(&bar[XB_XGEN(b.x)]) == gen, bar);
            __builtin_amdgcn_fence(__ATOMIC_ACQUIRE, "agent");
            asm volatile("s_waitcnt vmcnt(0)" ::: "memory");
        }
    }
    __syncthreads();
}

struct Args { const float* in[27]; float* out; unsigned char* ws; int ph_lo, ph_hi, qsel, pad; };
struct Ctx { unsigned char* ws; volatile LAS unsigned long long* ptab;
    __device__ __forceinline__ const float* in(int i) const { const unsigned long long v = ptab[i];
        const unsigned lo = __builtin_amdgcn_readfirstlane((unsigned)v), hi = __builtin_amdgcn_readfirstlane((unsigned)(v >> 32)); return (const float*)(((unsigned long long)hi << 32) | lo); } };
enum { I_X = 0, I_POS, I_F1N, I_F1G, I_F1U, I_F1D, I_MIXN, I_WIN, I_CQN, I_CKVN, I_WUQ, I_WUKV, I_QN, I_KN, I_WG2, I_BG2, I_ON, I_DQN, I_DKN, I_WA, I_WB, I_WC, I_WOUT, I_F2N, I_F2G, I_F2U, I_F2D };

__device__ __forceinline__ int win_map(int n) {
    if (n < 768) return n;
    if (n < 1024) return 832 + (n - 768);
    if (n < 1280) return 1088 + (n - 1024);
    if (n < 1792) return 1344 + (n - 1280);
    if (n < 2560) return 2384 + (n - 1792);
    if (n < 3328) return 3152 + (n - 2560);
    if (n < 4096) return 3920 + (n - 3328);
    if (n < 4160) return 768 + (n - 4096);
    if (n < 4176) return 1856 + (n - 4160);
    if (n < 4352) return -1;
    if (n < 4864) return 1872 + (n - 4352);
    return 4688 + (n - 4864);
}
struct WMat { const float* src; const float* src2; const float* gain; bf16_t* dst; int K, Nsrc, Ndst, kind; };
__device__ __forceinline__ void wconv_item(const WMat& w, int item, LAS float* scr, int lane) {
    const int nblk = w.Ndst / 32, kb = item / nblk, nb = item % nblk, k0 = 64 * kb, n0 = 32 * nb;
    const int cq = lane & 7, kr = lane >> 3, nn = n0 + 4 * cq;
    const float* sp = w.src; int scol = nn; bool valid = true;
    if (w.kind == 1) { const int tile = nn >> 8; int wi = nn & 255; if (wi >= 128) { sp = w.src2; wi -= 128; } scol = tile * 128 + wi; }
    else if (w.kind == 2) { scol = win_map(nn); valid = scol >= 0; }
    else valid = nn < w.Nsrc;
    if (!valid) scol = 0;
    f32x4 v[8]; float g[8];
#pragma unroll
    for (int i = 0; i < 8; ++i) { const int kk = 8 * i + kr; v[i] = *(const f32x4*)(sp + (size_t)(k0 + kk) * w.Nsrc + scol); g[i] = w.gain ? w.gain[k0 + kk] : 1.f; }
#pragma unroll
    for (int i = 0; i < 8; ++i) { const int kk = 8 * i + kr; LAS float* d = scr + kk * 33 + 4 * cq; const float gg = valid ? g[i] : 0.f;
        d[0] = v[i][0] * gg; d[1] = v[i][1] * gg; d[2] = v[i][2] * gg; d[3] = v[i][3] * gg; }
    LDS_WAIT(); asm volatile("" ::: "memory");
    const int c = lane & 7;
#pragma unroll
    for (int j = 0; j < 4; ++j) { const int n = (lane >> 3) + 8 * j; const LAS float* s = scr + (8 * c) * 33 + n;
        u32x4 o; o.x = pk2(s[0 * 33], s[1 * 33]); o.y = pk2(s[2 * 33], s[3 * 33]); o.z = pk2(s[4 * 33], s[5 * 33]); o.w = pk2(s[6 * 33], s[7 * 33]);
        *(u32x4*)(w.dst + (size_t)(n0 + n) * w.K + k0 + 8 * c) = o; }
    LDS_WAIT(); asm volatile("" ::: "memory");
}
constexpr int wc_items(int K, int Ndst) { return (K / 64) * (Ndst / 32); }
constexpr int WI_GU = wc_items(DM, NGU), WI_D = wc_items(FF, DM), WI_IN = wc_items(DM, NIN), WI_UQ = wc_items(512, 1280), WI_UKV = wc_items(256, 1536),
              WI_A = wc_items(768, DM), WI_B = wc_items(512, DM), WI_C = wc_items(256, DM), WI_OUT = wc_items(DM, DM);
constexpr int WI_TOTAL = 2 * WI_GU + 2 * WI_D + WI_IN + WI_UQ + WI_UKV + WI_A + WI_B + WI_C + WI_OUT;

__device__ __forceinline__ void phase_wconv(const Ctx& a, int l, LAS unsigned char* lds, int gw, int NGW, int wave, int lane) {
    LAS float* scr = (LAS float*)(lds + wave * 16384);
    bf16_t* W = (bf16_t*)(a.ws + WS_W);
    const size_t oFF = (size_t)l * DM * FF;
    for (int it = gw; it < WI_TOTAL; it += NGW) {
        int r = it; WMat w;
        if (r < WI_GU) { w = WMat{a.in(I_F1G) + oFF, a.in(I_F1U) + oFF, a.in(I_F1N) + (size_t)l * DM, W + W_GU1, DM, FF, NGU, 1}; }
        else if ((r -= WI_GU) < WI_GU) { w = WMat{a.in(I_F2G) + oFF, a.in(I_F2U) + oFF, a.in(I_F2N) + (size_t)l * DM, W + W_GU2, DM, FF, NGU, 1}; }
        else if ((r -= WI_GU) < WI_IN) { w = WMat{a.in(I_WIN) + (size_t)l * DM * 10832, nullptr, a.in(I_MIXN) + (size_t)l * DM, W + W_IN, DM, 10832, NIN, 2}; }
        else if ((r -= WI_IN) < WI_D) { w = WMat{a.in(I_F1D) + oFF, nullptr, nullptr, W + W_D1, FF, DM, DM, 0}; }
        else if ((r -= WI_D) < WI_D) { w = WMat{a.in(I_F2D) + oFF, nullptr, nullptr, W + W_D2, FF, DM, DM, 0}; }
        else if ((r -= WI_D) < WI_OUT) { w = WMat{a.in(I_WOUT) + (size_t)l * DM * DM, nullptr, nullptr, W + W_OUT, DM, DM, DM, 0}; }
        else if ((r -= WI_OUT) < WI_A) { w = WMat{a.in(I_WA) + (size_t)l * 768 * DM, nullptr, nullptr, W + W_A, 768, DM, DM, 0}; }
        else if ((r -= WI_A) < WI_B) { w = WMat{a.in(I_WB) + (size_t)l * 512 * DM, nullptr, nullptr, W + W_B, 512, DM, DM, 0}; }
        else if ((r -= WI_B) < WI_C) { w = WMat{a.in(I_WC) + (size_t)l * 256 * DM, nullptr, nullptr, W + W_C, 256, DM, DM, 0}; }
        else if ((r -= WI_C) < WI_UQ) { w = WMat{a.in(I_WUQ) + (size_t)l * 512 * 1152, nullptr, a.in(I_CQN) + (size_t)l * 512, W + W_UQ, 512, 1152, 1280, 0}; }
        else { r -= WI_UQ; w = WMat{a.in(I_WUKV) + (size_t)l * 256 * 1536, nullptr, a.in(I_CKVN) + (size_t)l * 256, W + W_UKV, 256, 1536, 1536, 0}; }
        wconv_item(w, r, scr, lane);
    }
}

__device__ __forceinline__ void phase_prologue(const Ctx& a, int gw, int NGW, int lane) {
    const int* pos = (const int*)a.in(I_POS);
    float* ropec = (float*)(a.ws + WS_ROPE); float* ropes = ropec + (size_t)MTOK * 32;
    const int i = lane & 31; const float invf = exp2f(-(float)i * 0.41524101186092029f);
    for (int p = gw; p < MTOK / 2; p += NGW) { const int tok = 2 * p + (lane >> 5); const float ang = (float)pos[tok] * invf; float sn, cs; sincosf(ang, &sn, &cs);
        ropec[(size_t)tok * 32 + i] = cs; ropes[(size_t)tok * 32 + i] = sn; }
    const float* x = a.in(I_X); bf16_t* xb = (bf16_t*)(a.ws + WS_XB); float* ssq = (float*)(a.ws + WS_SSQ);
    for (int m = gw; m < MTOK; m += NGW) { const f32x4* xr = (const f32x4*)(x + (size_t)m * DM) + lane; u32x2* o8 = (u32x2*)(xb + (size_t)m * DM) + lane; float s = 0.f;
#pragma unroll
        for (int j = 0; j < 8; ++j) { const f32x4 v = xr[64 * j]; s += (v[0] * v[0] + v[1] * v[1]) + (v[2] * v[2] + v[3] * v[3]); u32x2 w; w.x = pk2(v[0], v[1]); w.y = pk2(v[2], v[3]); o8[64 * j] = w; }
        s += __shfl_xor(s, 1); if ((lane & 1) == 0) ssq[(size_t)m * 32 + (lane >> 1)] = s; }
}

template <int CTRL> __device__ __forceinline__ float dppf(float x) { return __builtin_bit_cast(float, __builtin_amdgcn_mov_dpp(__builtin_bit_cast(int, x), CTRL, 0xf, 0xf, true)); }
__device__ __forceinline__ float row16_sum(float x) { x += dppf<0xB1>(x); x += dppf<0x4E>(x); x += dppf<0x141>(x); x += dppf<0x128>(x); return x; }
__device__ __forceinline__ void unpk4(const u32x2 w, float (&f)[4]) { f[0] = __uint_as_float(w.x << 16); f[1] = __uint_as_float(w.x & 0xffff0000u); f[2] = __uint_as_float(w.y << 16); f[3] = __uint_as_float(w.y & 0xffff0000u); }
__device__ __forceinline__ void unpk8(const u32x4 w, float (&f)[8]) { f[0] = __uint_as_float(w.x << 16); f[1] = __uint_as_float(w.x & 0xffff0000u); f[2] = __uint_as_float(w.y << 16); f[3] = __uint_as_float(w.y & 0xffff0000u);
    f[4] = __uint_as_float(w.z << 16); f[5] = __uint_as_float(w.z & 0xffff0000u); f[6] = __uint_as_float(w.w << 16); f[7] = __uint_as_float(w.w & 0xffff0000u); }
__device__ __forceinline__ float ssq8(const u32x4 w) { float f[8]; unpk8(w, f); return ((f[0] * f[0] + f[1] * f[1]) + (f[2] * f[2] + f[3] * f[3])) + ((f[4] * f[4] + f[5] * f[5]) + (f[6] * f[6] + f[7] * f[7])); }
__device__ __forceinline__ void rope4(float (&x)[4], const f32x4 cs, const f32x4 sn, bool first) {
#pragma unroll
    for (int e = 0; e < 4; ++e) { const float xp = dppf<0x128>(x[e]); x[e] = first ? x[e] * cs[e] - xp * sn[e] : xp * sn[e] + x[e] * cs[e]; }
}
__device__ __forceinline__ void phase_prep(const Ctx& a, int l, int gw, int NGW, int lane, bool do_dswa) {
    bf16_t* u1 = (bf16_t*)(a.ws + WS_R2);
    const bf16_t* qraw = (const bf16_t*)(a.ws + WS_R3 + R3_QRAW); const bf16_t* kvraw = (const bf16_t*)(a.ws + WS_R3 + R3_KVRAW);
    const float* ropec = (const float*)(a.ws + WS_ROPE); const float* ropes = ropec + (size_t)MTOK * 32;
    bf16_t* Qo = (bf16_t*)(a.ws + WS_QKV + QKV_Q); bf16_t* Ko = (bf16_t*)(a.ws + WS_QKV + QKV_K); bf16_t* Vo = (bf16_t*)(a.ws + WS_QKV + QKV_V);
    const int t = lane & 15, g4 = lane >> 4; const bool first = t < 8;
    const float* gq = a.in(I_QN) + (size_t)l * 192; const float* gk = a.in(I_KN) + (size_t)l * 192;
    const f32x4 gq0 = *(const f32x4*)(gq + 4 * t), gq1 = *(const f32x4*)(gq + 64 + 4 * t), gq2 = *(const f32x4*)(gq + 128 + 4 * t);
    const f32x4 gka = *(const f32x4*)(gk + 8 * t), gkb = *(const f32x4*)(gk + 8 * t + 4), gkr = *(const f32x4*)(gk + 128 + 4 * t);
    const float* dq = a.in(I_DQN) + (size_t)l * 128; const float* dk = a.in(I_DKN) + (size_t)l * 128;
    const f32x4 dqa = *(const f32x4*)(dq + 8 * t), dqb = *(const f32x4*)(dq + 8 * t + 4), dka = *(const f32x4*)(dk + 8 * t), dkb = *(const f32x4*)(dk + 8 * t + 4);
    for (int qd = gw; qd < MTOK / 4; qd += NGW) {
        const int row = 4 * qd + g4; bf16_t* ur = u1 + (size_t)row * U1W; const int b = row / SEQ, s = row % SEQ;
        float q = 0.f;
#pragma unroll
        for (int j = 0; j < 4; ++j) q += ssq8(*(const u32x4*)(ur + C_CQ + 8 * t + 128 * j));
        const float rstd_cq = rsqrtf(row16_sum(q) * (1.f / 512.f) + EPS);
        q = ssq8(*(const u32x4*)(ur + C_CKV + 8 * t)) + ssq8(*(const u32x4*)(ur + C_CKV + 128 + 8 * t));
        const float rstd_ckv = rsqrtf(row16_sum(q) * (1.f / 256.f) + EPS);
        float kr[4]; unpk4(*(const u32x2*)(ur + C_KROPE + 4 * t), kr);
        const float ssq_kr = row16_sum((kr[0] * kr[0] + kr[1] * kr[1]) + (kr[2] * kr[2] + kr[3] * kr[3]));
        const f32x4 cs = *(const f32x4*)(ropec + (size_t)row * 32 + 4 * (t & 7)), sn = *(const f32x4*)(ropes + (size_t)row * 32 + 4 * (t & 7));
#pragma unroll 2
        for (int h = 0; h < 6; ++h) {
            const bf16_t* qp = qraw + (size_t)row * QRAW_LD + h * 192 + 4 * t;
            float x0[4], x1[4], x2[4]; unpk4(*(const u32x2*)qp, x0); unpk4(*(const u32x2*)(qp + 64), x1); unpk4(*(const u32x2*)(qp + 128), x2);
            float ss = 0.f;
#pragma unroll
            for (int e = 0; e < 4; ++e) { x0[e] *= rstd_cq; x1[e] *= rstd_cq; x2[e] *= rstd_cq; ss += x0[e] * x0[e] + x1[e] * x1[e] + x2[e] * x2[e]; }
            const float rq = rsqrtf(row16_sum(ss) * (1.f / 192.f) + EPS);
#pragma unroll
            for (int e = 0; e < 4; ++e) { x0[e] *= rq * gq0[e]; x1[e] *= rq * gq1[e]; x2[e] *= rq * gq2[e]; }
            rope4(x2, cs, sn, first);
            bf16_t* qo = Qo + ((size_t)((b * 6 + h) * SEQ + s)) * 192 + 4 * t;
            { u32x2 w; w.x = pk2(x0[0] * QS_MLA, x0[1] * QS_MLA); w.y = pk2(x0[2] * QS_MLA, x0[3] * QS_MLA); *(u32x2*)qo = w;
              w.x = pk2(x1[0] * QS_MLA, x1[1] * QS_MLA); w.y = pk2(x1[2] * QS_MLA, x1[3] * QS_MLA); *(u32x2*)(qo + 64) = w;
              w.x = pk2(x2[0] * QS_MLA, x2[1] * QS_MLA); w.y = pk2(x2[2] * QS_MLA, x2[3] * QS_MLA); *(u32x2*)(qo + 128) = w; }
            const bf16_t* kp = kvraw + (size_t)row * KVRAW_LD + h * 256 + 8 * t;
            float kn[8], vv[8]; unpk8(*(const u32x4*)kp, kn); unpk8(*(const u32x4*)(kp + 128), vv);
            ss = 0.f;
#pragma unroll
            for (int e = 0; e < 8; ++e) { kn[e] *= rstd_ckv; vv[e] *= rstd_ckv; ss += kn[e] * kn[e]; }
            const float rk = rsqrtf((row16_sum(ss) + ssq_kr) * (1.f / 192.f) + EPS);
            float kx[4];
#pragma unroll
            for (int e = 0; e < 4; ++e) { kn[e] *= rk * gka[e]; kn[4 + e] *= rk * gkb[e]; kx[e] = kr[e] * rk * gkr[e]; }
            rope4(kx, cs, sn, first);
            bf16_t* ko = Ko + ((size_t)((b * 6 + h) * SEQ + s)) * 192;
            { u32x4 w; w.x = pk2(kn[0], kn[1]); w.y = pk2(kn[2], kn[3]); w.z = pk2(kn[4], kn[5]); w.w = pk2(kn[6], kn[7]); *(u32x4*)(ko + 8 * t) = w;
              u32x2 w2; w2.x = pk2(kx[0], kx[1]); w2.y = pk2(kx[2], kx[3]); *(u32x2*)(ko + 128 + 4 * t) = w2;
              w.x = pk2(vv[0], vv[1]); w.y = pk2(vv[2], vv[3]); w.z = pk2(vv[4], vv[5]); w.w = pk2(vv[6], vv[7]);
              *(u32x4*)(Vo + ((size_t)((b * 6 + h) * SEQ + s)) * 128 + 8 * t) = w; }
        }
        if (do_dswa)
#pragma unroll 2
        for (int h = 0; h < 6; ++h) {
            u32x4* qp = (u32x4*)(ur + C_QC + h * 128 + 8 * t); u32x4* kp = (u32x4*)(ur + C_KC + h * 128 + 8 * t);
            float qv[8], kv[8]; unpk8(*qp, qv); unpk8(*kp, kv);
            float sq = 0.f, sk = 0.f;
#pragma unroll
            for (int e = 0; e < 8; ++e) { sq += qv[e] * qv[e]; sk += kv[e] * kv[e]; }
            const float rq = rsqrtf(row16_sum(sq) * (1.f / 128.f) + EPS) * QS_DSWA, rk = rsqrtf(row16_sum(sk) * (1.f / 128.f) + EPS);
            u32x4 w; w.x = pk2(qv[0] * rq * dqa[0], qv[1] * rq * dqa[1]); w.y = pk2(qv[2] * rq * dqa[2], qv[3] * rq * dqa[3]); w.z = pk2(qv[4] * rq * dqb[0], qv[5] * rq * dqb[1]); w.w = pk2(qv[6] * rq * dqb[2], qv[7] * rq * dqb[3]); *qp = w;
            w.x = pk2(kv[0] * rk * dka[0], kv[1] * rk * dka[1]); w.y = pk2(kv[2] * rk * dka[2], kv[3] * rk * dka[3]); w.z = pk2(kv[4] * rk * dkb[0], kv[5] * rk * dkb[1]); w.w = pk2(kv[6] * rk * dkb[2], kv[7] * rk * dkb[3]); *kp = w;
        }
    }
}

__device__ __forceinline__ float logsigmoidf_(float z) { return fminf(z, 0.f) - log1pf(expf(-fabsf(z))); }
__device__ __forceinline__ int crow32(int r, int hi) { return (r & 3) + 8 * (r >> 2) + 4 * hi; }
__device__ __forceinline__ void gla_local(const Ctx& a, int l, LAS unsigned char* lds, int G, int bid, const int wv) {
    int tid_ = wv * 64 + lane_id_v(); asm volatile("" : "+v"(tid_));
    const int tid = tid_, wid = __builtin_amdgcn_readfirstlane(tid >> 6), lane = tid & 63, l32 = lane & 31, hi = lane >> 5;
    LAS float* kd = (LAS float*)lds; LAS float* vv = (LAS float*)(lds + 16640); LAS float* tot = (LAS float*)(lds + 16640 + 32768);
    const bf16_t* u1 = (const bf16_t*)(a.ws + WS_R2);
    float* dS = (float*)(a.ws + WS_GLA + GLA_DS); float* bcum = (float*)(a.ws + WS_GLA + GLA_BC); float* dec = (float*)(a.ws + WS_GLA + GLA_DEC);
    const float* w2 = a.in(I_WG2) + (size_t)l * 16 * 256; const float* b2 = a.in(I_BG2) + (size_t)l * 256;
    const int d = lane, tg = wid;
    for (int ci = bid; ci < 2048; ci += G) {
        const int bh = ci >> 8, c = ci & 255, b = bh >> 2, h = bh & 3, row0 = b * SEQ + 64 * c;
        float w2c[16];
#pragma unroll
        for (int j = 0; j < 16; ++j) w2c[j] = w2[j * 256 + h * 64 + d];
        const float bias = b2[h * 64 + d];
        float bcv[8]; float run = 0.f;
#pragma unroll
        for (int i = 0; i < 8; ++i) { const int t = tg * 8 + i; const bf16_t* gl = u1 + (size_t)(row0 + t) * U1W + C_GLR;
            const bf16x8 g0 = *(const bf16x8*)gl, g1 = *(const bf16x8*)(gl + 8); float z = bias;
#pragma unroll
            for (int j = 0; j < 8; ++j) { z += bf2f((bf16_t)g0[j]) * w2c[j]; z += bf2f((bf16_t)g1[j]) * w2c[8 + j]; }
            run += logsigmoidf_(z) * (1.f / 16.f); bcv[i] = run; }
        tot[tg * 64 + d] = run;
        { const int t = tid >> 3, c0 = (tid & 7) * 16; const bf16_t* vp = u1 + (size_t)(row0 + t) * U1W + C_VB + h * 128 + c0;
          const bf16x8 v0 = *(const bf16x8*)vp, v1 = *(const bf16x8*)(vp + 8);
#pragma unroll
          for (int j = 0; j < 8; ++j) { vv[t * 128 + c0 + j] = bf2f((bf16_t)v0[j]); vv[t * 128 + c0 + 8 + j] = bf2f((bf16_t)v1[j]); } }
        __syncthreads();
        float off = 0.f, bend = 0.f;
#pragma unroll
        for (int g = 0; g < 8; ++g) { const float x = tot[g * 64 + d]; bend += x; if (g < tg) off += x; }
#pragma unroll
        for (int i = 0; i < 8; ++i) { const int t = tg * 8 + i; const float bc = bcv[i] + off;
            bcum[(size_t)(row0 + t) * 256 + h * 64 + d] = bc;
            const float kk = bf2f(u1[(size_t)(row0 + t) * U1W + C_KB + h * 64 + d]);
            kd[t * 65 + d] = kk * expf(bend - bc); }
        if (tg == 0) dec[(size_t)ci * 64 + d] = expf(bend);
        __syncthreads();
        { const int di = wid >> 2, ei = wid & 3; f32x16 acc = {};
#pragma unroll 8
          for (int s0 = 0; s0 < 64; s0 += 2) { const float av = kd[(s0 + hi) * 65 + 32 * di + l32], bv = vv[(s0 + hi) * 128 + 32 * ei + l32];
              acc = __builtin_amdgcn_mfma_f32_32x32x2f32(av, bv, acc, 0, 0, 0); }
          float* dst = dS + (size_t)ci * 8192;
#pragma unroll
          for (int r = 0; r < 16; ++r) dst[(32 * di + crow32(r, hi)) * 128 + 32 * ei + l32] = acc[r]; }
        __syncthreads();
    }
}
__device__ __forceinline__ void gla_scan(const Ctx& a, int bid, const int wv) {
    float* dS = (float*)(a.ws + WS_GLA + GLA_DS); const float* dec = (const float*)(a.ws + WS_GLA + GLA_DEC);
    int tid_ = wv * 64 + lane_id_v(); asm volatile("" : "+v"(tid_));
    const int gid = bid * NTHR + tid_, bh = gid >> 13, de = gid & 8191, d = de >> 7;
    float st = 0.f; float* p = dS + (size_t)bh * 256 * 8192 + de; const float* dc = dec + (size_t)bh * 256 * 64 + d;
    for (int c = 0; c < 256; c += 8) { float x[8], g[8];
#pragma unroll
        for (int i = 0; i < 8; ++i) { x[i] = p[(size_t)(c + i) * 8192]; g[i] = dc[(c + i) * 64]; }
#pragma unroll
        for (int i = 0; i < 8; ++i) { p[(size_t)(c + i) * 8192] = st; st = g[i] * st + x[i]; } }
}
__device__ __forceinline__ void gla_out(const Ctx& a, int l, LAS unsigned char* lds, int G, int bid, const int wv) {
    int tid_ = wv * 64 + lane_id_v(); asm volatile("" : "+v"(tid_));
    const int tid = tid_, wid = __builtin_amdgcn_readfirstlane(tid >> 6), lane = tid & 63, l32 = lane & 31, hi = lane >> 5;
    LAS float* qe = (LAS float*)lds; LAS float* ke = (LAS float*)(lds + 16640); LAS float* At = (LAS float*)(lds + 33280);
    LAS float* vv = (LAS float*)(lds + 49920); LAS float* Sp = (LAS float*)(lds + 82688);
    const bf16_t* u1 = (const bf16_t*)(a.ws + WS_R2);
    const float* dS = (const float*)(a.ws + WS_GLA + GLA_DS); const float* bcum = (const float*)(a.ws + WS_GLA + GLA_BC);
    bf16_t* yb = (bf16_t*)(a.ws + WS_R3 + R3_YB); const float* go = a.in(I_ON) + (size_t)l * 128;
    for (int ci = bid; ci < 2048; ci += G) {
        const int bh = ci >> 8, c = ci & 255, b = bh >> 2, h = bh & 3, row0 = b * SEQ + 64 * c;
        { const int d = lane, tg = wid;
#pragma unroll
          for (int i = 0; i < 8; ++i) { const int t = tg * 8 + i; const float bc = bcum[(size_t)(row0 + t) * 256 + h * 64 + d];
              const float q = bf2f(u1[(size_t)(row0 + t) * U1W + C_QB + h * 64 + d]), k = bf2f(u1[(size_t)(row0 + t) * U1W + C_KB + h * 64 + d]);
              qe[t * 65 + d] = q * 0.125f * expf(bc); ke[t * 65 + d] = k * expf(-bc); } }
        { const int t = tid >> 3, c0 = (tid & 7) * 16; const bf16_t* vp = u1 + (size_t)(row0 + t) * U1W + C_VB + h * 128 + c0;
          const bf16x8 v0 = *(const bf16x8*)vp, v1 = *(const bf16x8*)(vp + 8);
#pragma unroll
          for (int j = 0; j < 8; ++j) { vv[t * 128 + c0 + j] = bf2f((bf16_t)v0[j]); vv[t * 128 + c0 + 8 + j] = bf2f((bf16_t)v1[j]); }
          const f32x4* sp = (const f32x4*)(dS + (size_t)ci * 8192) + tid * 4;
#pragma unroll
          for (int j = 0; j < 4; ++j) *(LAS f32x4*)(Sp + tid * 16 + j * 4) = sp[j]; }
        __syncthreads();
        if (wid < 4) {
            if (wid < 3) { const int ti = wid == 0 ? 0 : 1, si = wid == 2 ? 1 : 0; f32x16 acc = {};
#pragma unroll 8
                for (int d0 = 0; d0 < 64; d0 += 2) { const float av = qe[(32 * ti + l32) * 65 + d0 + hi], bv = ke[(32 * si + l32) * 65 + d0 + hi];
                    acc = __builtin_amdgcn_mfma_f32_32x32x2f32(av, bv, acc, 0, 0, 0); }
#pragma unroll
                for (int r = 0; r < 16; ++r) { const int t = 32 * ti + crow32(r, hi), s = 32 * si + l32; At[t * 65 + s] = (s <= t) ? acc[r] : 0.f; } }
            else {
#pragma unroll
                for (int r = 0; r < 16; ++r) At[crow32(r, hi) * 65 + 32 + l32] = 0.f; }
        }
        __syncthreads();
        f32x16 acc = {}; const int ti = wid >> 2, ei = wid & 3;
#pragma unroll 8
        for (int s0 = 0; s0 < 64; s0 += 2) { const float av = At[(32 * ti + l32) * 65 + s0 + hi], bv = vv[(s0 + hi) * 128 + 32 * ei + l32];
            acc = __builtin_amdgcn_mfma_f32_32x32x2f32(av, bv, acc, 0, 0, 0); }
#pragma unroll 8
        for (int d0 = 0; d0 < 64; d0 += 2) { const float av = qe[(32 * ti + l32) * 65 + d0 + hi], bv = Sp[(d0 + hi) * 128 + 32 * ei + l32];
            acc = __builtin_amdgcn_mfma_f32_32x32x2f32(av, bv, acc, 0, 0, 0); }
        __syncthreads();
#pragma unroll
        for (int r = 0; r < 16; ++r) Sp[(32 * ti + crow32(r, hi)) * 128 + 32 * ei + l32] = acc[r];
        __syncthreads();
        { const int t = tid >> 3, e0 = (tid & 7) * 16; float ov[16]; float ss = 0.f;
#pragma unroll
          for (int j = 0; j < 4; ++j) { const f32x4 x = *(const LAS f32x4*)(Sp + t * 128 + e0 + 4 * j); ov[4 * j] = x[0]; ov[4 * j + 1] = x[1]; ov[4 * j + 2] = x[2]; ov[4 * j + 3] = x[3];
              ss += (x[0] * x[0] + x[1] * x[1]) + (x[2] * x[2] + x[3] * x[3]); }
          ss += __shfl_xor(ss, 1); ss += __shfl_xor(ss, 2); ss += __shfl_xor(ss, 4);
          const float rs = rsqrtf(ss * (1.f / 128.f) + EPS);
          const bf16_t* rp = u1 + (size_t)(row0 + t) * U1W + C_RB + h * 128 + e0; const bf16x8 r0 = *(const bf16x8*)rp, r1 = *(const bf16x8*)(rp + 8);
          unsigned w[8];
#pragma unroll
          for (int j = 0; j < 4; ++j) { w[j] = pk2(ov[2 * j] * rs * go[e0 + 2 * j] * bf2f((bf16_t)r0[2 * j]), ov[2 * j + 1] * rs * go[e0 + 2 * j + 1] * bf2f((bf16_t)r0[2 * j + 1]));
              w[4 + j] = pk2(ov[8 + 2 * j] * rs * go[e0 + 8 + 2 * j] * bf2f((bf16_t)r1[2 * j]), ov[8 + 2 * j + 1] * rs * go[e0 + 8 + 2 * j + 1] * bf2f((bf16_t)r1[2 * j + 1])); }
          u32x4* yo = (u32x4*)(yb + (size_t)(row0 + t) * 512 + h * 128 + e0);
          yo[0] = (u32x4){w[0], w[1], w[2], w[3]}; yo[1] = (u32x4){w[4], w[5], w[6], w[7]}; }
        __syncthreads();
    }
}
__device__ __forceinline__ void dswa_combine(const Ctx& a, int gw, int NGW, int lane) {
    const bf16_t* dout = (const bf16_t*)(a.ws + WS_R3 + R3_DO); const float* lse = (const float*)(a.ws + WS_R3 + R3_LSE); bf16_t* yc = (bf16_t*)(a.ws + WS_R3 + R3_YC);
    const int hp = lane >> 5, e = 4 * (lane & 31);
    for (int row = gw; row < MTOK; row += NGW) {
        const float l0 = lse[(size_t)row * 6 + hp], l1 = lse[(size_t)row * 6 + 2 + hp], l2 = lse[(size_t)row * 6 + 4 + hp];
        const float mx = fmaxf(l0, fmaxf(l1, l2)); float w0 = expf(l0 - mx), w1 = expf(l1 - mx), w2 = expf(l2 - mx); const float inv = 1.f / (w0 + w1 + w2); w0 *= inv; w1 *= inv; w2 *= inv;
        const u32x2 a0 = *(const u32x2*)(dout + (size_t)row * 768 + hp * 128 + e), a1 = *(const u32x2*)(dout + (size_t)row * 768 + (2 + hp) * 128 + e), a2 = *(const u32x2*)(dout + (size_t)row * 768 + (4 + hp) * 128 + e);
        float o[4];
        o[0] = w0 * __uint_as_float(a0.x << 16) + w1 * __uint_as_float(a1.x << 16) + w2 * __uint_as_float(a2.x << 16);
        o[1] = w0 * __uint_as_float(a0.x & 0xffff0000u) + w1 * __uint_as_float(a1.x & 0xffff0000u) + w2 * __uint_as_float(a2.x & 0xffff0000u);
        o[2] = w0 * __uint_as_float(a0.y << 16) + w1 * __uint_as_float(a1.y << 16) + w2 * __uint_as_float(a2.y << 16);
        o[3] = w0 * __uint_as_float(a0.y & 0xffff0000u) + w1 * __uint_as_float(a1.y & 0xffff0000u) + w2 * __uint_as_float(a2.y & 0xffff0000u);
        u32x2 w; w.x = pk2(o[0], o[1]); w.y = pk2(o[2], o[3]); *(u32x2*)(yc + (size_t)row * 256 + hp * 128 + e) = w;
    }
}

constexpr int N_MLA_UNITS = 12 * 64, N_DSWA_UNITS = 12 * 64, N_ATT_UNITS = N_MLA_UNITS + N_DSWA_UNITS;
__device__ __forceinline__ void phase_attention(const Ctx& a, int l, LAS unsigned char* lds, volatile LAS unsigned* qword, const int wv, const int qsel) {
    const int tid0 = wv * 64 + lane_id_v();
    unsigned* head = (unsigned*)(a.ws + WS_CTL) + CW_QUEUE + 64 * l + 1024 * qsel;
    const bf16_t* u1 = (const bf16_t*)(a.ws + WS_R2);
    for (;;) {
        if (tid0 == 0) *qword = __hip_atomic_fetch_add(head, 1u, __ATOMIC_RELAXED, __HIP_MEMORY_SCOPE_AGENT);
        __syncthreads();
        const int uid = (int)__builtin_amdgcn_readfirstlane(*qword);
        if (uid >= N_ATT_UNITS) break;
        att::AUnit u;
        if (uid < N_MLA_UNITS) {
            const int qb = 63 - uid / 12, bh = uid % 12, b = bh / 6, h = bh % 6;
            u.Q = (const bf16_t*)(a.ws + WS_QKV + QKV_Q) + ((size_t)bh * SEQ + 256 * qb) * 192; u.qpitch = 192;
            u.K = (const bf16_t*)(a.ws + WS_QKV + QKV_K) + (size_t)bh * SEQ * 192; u.kpitch = 192;
            u.V = (const bf16_t*)(a.ws + WS_QKV + QKV_V) + (size_t)bh * SEQ * 128; u.vpitch = 128;
            u.O = (bf16_t*)(a.ws + WS_R3 + R3_YA) + ((size_t)(b * SEQ + 256 * qb)) * 768 + h * 128; u.opitch = 768;
            u.lse = nullptr; u.lsepitch = 0; u.q0 = 256 * qb; u.j_lo = 0; u.j_hi = 4 * qb + 4; u.bias_c = 0.f;
            att::attn_unit<192, 0>(lds, u, wv);
        } else {
            const int v = uid - N_MLA_UNITS, b = v / 384, hh = (v / 64) % 6, idx = v % 64, g = hh >> 1, dil = g == 0 ? 1 : (g == 1 ? 4 : 16), nb = 64 / dil, r = idx / nb, qb = idx % nb;
            const size_t tok0 = (size_t)b * SEQ + r;
            u.Q = u1 + (tok0 + (size_t)256 * qb * dil) * U1W + C_QC + hh * 128; u.qpitch = (size_t)dil * U1W;
            u.K = u1 + tok0 * U1W + C_KC + hh * 128; u.kpitch = (size_t)dil * U1W;
            u.V = u1 + tok0 * U1W + C_VC + hh * 128; u.vpitch = (size_t)dil * U1W;
            u.O = (bf16_t*)(a.ws + WS_R3 + R3_DO) + (tok0 + (size_t)256 * qb * dil) * 768 + hh * 128; u.opitch = (size_t)dil * 768;
            u.lse = (float*)(a.ws + WS_R3 + R3_LSE) + (tok0 + (size_t)256 * qb * dil) * 6 + hh; u.lsepitch = (size_t)dil * 6;
            u.q0 = 256 * qb; u.j_lo = 4 * qb - 2 > 0 ? 4 * qb - 2 : 0; u.j_hi = 4 * qb + 4;
            u.bias_c = exp2f(-8.f * (float)(hh + 1) / 6.f) * (float)dil * LOG2E;
            att::attn_unit<128, 1>(lds, u, wv);
        }
    }
    __syncthreads();
}

constexpr int NPL = 12, NPH = 1 + NPL * DEPTH;
__global__ void __launch_bounds__(NTHR, 2) hybrid_fwd(Args args) {
    extern __shared__ __attribute__((aligned(16))) unsigned char lds_raw[];
    LAS unsigned char* lds = (LAS unsigned char*)lds_raw;
    const int tid = threadIdx.x;
    const int wv = __builtin_amdgcn_readfirstlane(tid >> 6);
    const int G = gridDim.x, bid = blockIdx.x, NGW = G * NWAVES;
#define LAUNDER() int tz_ = lane_id_v(); asm volatile("" : "+v"(tz_)); const int lane = tz_, wave = wv, gw = bid * NWAVES + wave
    volatile LAS unsigned* lctl = (volatile LAS unsigned*)(lds + LDSCTL_OFF);
    for (int u = tid; u < (LDS_BYTES - LDSCTL_OFF) / 4; u += NTHR) lctl[u] = 0u;
    __syncthreads();
    const int lo = args.ph_lo, hi = args.ph_hi;
    unsigned* ctl = (unsigned*)(args.ws + WS_CTL);
    XcdBarrier bar; bar.bar = ctl + CW_BAR; bar.x = 0; bar.st = lctl + 8; bar.wv = wv;
    if (hi - lo > 1) bar = xcd_barrier_post(ctl + CW_BAR, lctl + 8, wv);
#ifndef PH_MASK
#define PH_MASK 0xFFFF
#endif
#define IN(k) (lo <= (k) && (k) < hi)
#define EN(j) ((PH_MASK >> (j)) & 1)
#define DUMMY_OUT(p) (args.qsel ? (float*)(wz + WS_R3) : (p))
#define DUMMY_XB(p) (args.qsel ? (bf16_t*)(wz + WS_QKV) : (p))
#define DUMMY_XB2(p) (args.qsel ? (bf16_t*)(wz + WS_R2) : (p))
#define DUMMY_SSQ(p) (args.qsel ? (float*)(wz + WS_GLA) : (p))
#define SEAM(k) do { if (IN(k) && IN((k) + 1)) xcd_barrier<false>(bar); } while (0)
    unsigned char* ws = args.ws;
    volatile LAS unsigned long long* ptab = (volatile LAS unsigned long long*)(lds + LDSCTL_OFF + 256);
    if (tid < 27) ptab[tid] = (unsigned long long)args.in[tid];
    __syncthreads();
    Ctx cx; cx.ws = ws; cx.ptab = ptab;
    float* xres = args.out;
#define WSP() unsigned char* wz = ws; asm volatile("" : "+s"(wz)); \
    bf16_t* W = (bf16_t*)(wz + WS_W); bf16_t* xb = (bf16_t*)(wz + WS_XB); float* ssq = (float*)(wz + WS_SSQ); bf16_t* h1 = (bf16_t*)(wz + WS_R1); bf16_t* u2 = (bf16_t*)(wz + WS_R1); \
    bf16_t* u1 = (bf16_t*)(wz + WS_R2); float* m32 = (float*)(wz + WS_R2); bf16_t* mb = (bf16_t*)(wz + WS_QKV); bf16_t* qraw = (bf16_t*)(wz + WS_R3 + R3_QRAW); bf16_t* kvraw = (bf16_t*)(wz + WS_R3 + R3_KVRAW); \
    bf16_t* ya = (bf16_t*)(wz + WS_R3 + R3_YA); bf16_t* yb = (bf16_t*)(wz + WS_R3 + R3_YB); bf16_t* yc = (bf16_t*)(wz + WS_R3 + R3_YC); \
    (void)W; (void)xb; (void)ssq; (void)h1; (void)u2; (void)u1; (void)m32; (void)mb; (void)qraw; (void)kvraw; (void)ya; (void)yb; (void)yc

    if (EN(12) && IN(0)) { LAUNDER(); phase_prologue(cx, gw, NGW, lane); phase_wconv(cx, 0, lds, gw, NGW, wave, lane); }
    if (IN(0) && IN(1)) xcd_barrier<true>(bar);
    for (int l = 0; l < DEPTH; ++l) {
        const int pb = 1 + NPL * l;
        if (EN(0) && IN(pb + 0)) { LAUNDER(); if (l > 0) phase_wconv(cx, l, lds, gw, NGW, wave, lane); }
        SEAM(pb + 0);
        if (EN(1) && IN(pb + 1)) { WSP();
            pg8::Gemm g{xb, W + W_GU1, MTOK, NGU, DM, DM}; pg8::StaticOrder S; S.init(MTOK, NGU, G, bid);
            pg8::EpiSwiGLU E{ssq, h1, FF};
            pg8::gemm_phase<pg8::EpiSwiGLU, pg8::StaticOrder, true, true>(lds, g, S, E, wv);
        }
        SEAM(pb + 1);
        if (EN(2) && IN(pb + 2)) { WSP();
            pg8::Gemm g{h1, W + W_D1, MTOK, DM, FF, FF}; pg8::StaticOrder S; S.init(MTOK, DM, G, bid);
            pg8::EpiResid E{l == 0 ? cx.in(I_X) : (const float*)xres, DUMMY_OUT(xres), DUMMY_XB(xb), DUMMY_SSQ(ssq), 0.5f};
            pg8::gemm_phase<pg8::EpiResid, pg8::StaticOrder, true, true>(lds, g, S, E, wv);
        }
        SEAM(pb + 2);
        if (EN(3) && IN(pb + 3)) { WSP();
            pg8::Gemm g{xb, W + W_IN, MTOK, NIN, DM, DM}; pg8::StaticOrder S; S.init(MTOK, NIN, G, bid);
            pg8::EpiWin E{ssq, u1, u2, U1W, U2W};
            pg8::gemm_phase<pg8::EpiWin, pg8::StaticOrder, true, true>(lds, g, S, E, wv);
        }
        SEAM(pb + 3);
        if (EN(4) && IN(pb + 4)) { WSP();
            { pg8::Gemm g{u1 + C_CQ, W + W_UQ, MTOK, 1280, 512, U1W}; pg8::StaticOrder S; S.init(MTOK, 1280, G, bid);
              pg8::EpiBf16 E{qraw, QRAW_LD};
              pg8::gemm_phase<pg8::EpiBf16, pg8::StaticOrder, true, true>(lds, g, S, E, wv); }
            { pg8::Gemm g{u1 + C_CKV, W + W_UKV, MTOK, 1536, 256, U1W}; pg8::StaticOrder S; S.init(MTOK, 1536, G, bid);
              pg8::EpiBf16 E{kvraw, KVRAW_LD};
              pg8::gemm_phase<pg8::EpiBf16, pg8::StaticOrder, true, true>(lds, g, S, E, wv); }
        }
        SEAM(pb + 4);
        if (EN(5) && IN(pb + 5)) { LAUNDER(); phase_prep(cx, l, gw, NGW, lane, args.qsel == 0); gla_local(cx, l, lds, G, bid, wv); }
        SEAM(pb + 5);
        if (EN(6) && IN(pb + 6)) { if (bid < 128 && args.qsel == 0) gla_scan(cx, bid, wv); phase_attention(cx, l, lds, lctl + 16, wv, args.qsel); }
        SEAM(pb + 6);
        if (EN(7) && IN(pb + 7)) { LAUNDER(); gla_out(cx, l, lds, G, bid, wv); dswa_combine(cx, gw, NGW, lane); }
        SEAM(pb + 7);
        if (EN(8) && IN(pb + 8)) { WSP();
            { pg8::Gemm g{ya, W + W_A, MTOK, DM, 768, 768}; pg8::StaticOrder S; S.init(MTOK, DM, G, bid);
              pg8::EpiMerge<0> E{u2, U2W, m32, mb};
              pg8::gemm_phase<pg8::EpiMerge<0>, pg8::StaticOrder, true, true>(lds, g, S, E, wv); }
            { pg8::Gemm g{yb, W + W_B, MTOK, DM, 512, 512}; pg8::StaticOrder S; S.init(MTOK, DM, G, bid);
              pg8::EpiMerge<1> E{u2 + 2048, U2W, m32, mb};
              pg8::gemm_phase<pg8::EpiMerge<1>, pg8::StaticOrder, true, true>(lds, g, S, E, wv); }
            { pg8::Gemm g{yc, W + W_C, MTOK, DM, 256, 256}; pg8::StaticOrder S; S.init(MTOK, DM, G, bid);
              pg8::EpiMerge<2> E{u2 + 4096, U2W, m32, mb};
              pg8::gemm_phase<pg8::EpiMerge<2>, pg8::StaticOrder, true, true>(lds, g, S, E, wv); }
        }
        SEAM(pb + 8);
        if (EN(9) && IN(pb + 9)) { WSP();
            pg8::Gemm g{mb, W + W_OUT, MTOK, DM, DM, DM}; pg8::StaticOrder S; S.init(MTOK, DM, G, bid);
            pg8::EpiResid E{xres, DUMMY_OUT(xres), DUMMY_XB2(xb), DUMMY_SSQ(ssq), 1.0f};
            pg8::gemm_phase<pg8::EpiResid, pg8::StaticOrder, true, true>(lds, g, S, E, wv);
        }
        SEAM(pb + 9);
        if (EN(10) && IN(pb + 10)) { WSP();
            pg8::Gemm g{xb, W + W_GU2, MTOK, NGU, DM, DM}; pg8::StaticOrder S; S.init(MTOK, NGU, G, bid);
            pg8::EpiSwiGLU E{ssq, h1, FF};
            pg8::gemm_phase<pg8::EpiSwiGLU, pg8::StaticOrder, true, true>(lds, g, S, E, wv);
        }
        SEAM(pb + 10);
        if (EN(11) && IN(pb + 11)) { WSP();
            pg8::Gemm g{h1, W + W_D2, MTOK, DM, FF, FF}; pg8::StaticOrder S; S.init(MTOK, DM, G, bid);
            pg8::EpiResid E{xres, DUMMY_OUT(xres), DUMMY_XB(xb), DUMMY_SSQ(ssq), 0.5f};
            pg8::gemm_phase<pg8::EpiResid, pg8::StaticOrder, true, true>(lds, g, S, E, wv);
        }
        SEAM(pb + 11);
    }
#undef IN
#undef SEAM
}

extern "C" void kernel_launch(void* const* d_in, const int* in_sizes, int n_in, void* d_out, int out_size, void* d_ws, size_t ws_size, hipStream_t stream) {
    static int grid = 0;
    if (grid == 0) {
        if (n_in != 27 || out_size != MTOK * DM || ws_size < WS_END) { fprintf(stderr, "kernel_launch: unexpected problem: n_in %d out %d ws %zu (need %zu)\n", n_in, out_size, ws_size, (size_t)WS_END); grid = -1; return; }
        int dev = 0, cus = 0, per_cu = 0;
        if (hipGetDevice(&dev) != hipSuccess || hipDeviceGetAttribute(&cus, hipDeviceAttributeMultiprocessorCount, dev) != hipSuccess) { grid = -1; return; }
        if (hipFuncSetAttribute((const void*)hybrid_fwd, hipFuncAttributeMaxDynamicSharedMemorySize, LDS_BYTES) != hipSuccess) { fprintf(stderr, "kernel_launch: hipFuncSetAttribute failed\n"); grid = -1; return; }
        if (hipOccupancyMaxActiveBlocksPerMultiprocessor(&per_cu, (const void*)hybrid_fwd, NTHR, LDS_BYTES) != hipSuccess || per_cu < 1)
            fprintf(stderr, "kernel_launch: occupancy query reports %d workgroups per CU\n", per_cu);
        (void)hipGetLastError();
        grid = cus;
    }
    if (grid < 0) return;
    if (hipMemsetAsync((char*)d_ws + WS_CTL, 0, CTL_BYTES, stream) != hipSuccess) return;
    Args a{};
    for (int i = 0; i < 27; ++i) a.in[i] = (const float*)d_in[i];
    a.out = (float*)d_out; a.ws = (unsigned char*)d_ws;
#if MK_SINGLE
    a.ph_lo = 0; a.ph_hi = NPH;
    hipLaunchKernelGGL(hybrid_fwd, dim3(grid), dim3(NTHR), LDS_BYTES, stream, a);
#else
    for (int p = 0; p < NPH; ++p) { a.ph_lo = p; a.ph_hi = p + 1; a.qsel = 0; hipLaunchKernelGGL(hybrid_fwd, dim3(grid), dim3(NTHR), LDS_BYTES, stream, a);
#ifdef PROBE_DUP
        if (p >= 1 && ((PROBE_DUP >> ((p - 1) % NPL)) & 1)) { a.qsel = 1; hipLaunchKernelGGL(hybrid_fwd, dim3(grid), dim3(NTHR), LDS_BYTES, stream, a); }
#endif
    }
#endif
    const hipError_t le = hipPeekAtLastError();
    if (le != hipSuccess) fprintf(stderr, "kernel_launch: launch failed: %s\n", hipGetErrorName(le));
}
```

```cpp
#include <hip/hip_runtime.h>
#include <cstdio>
#include <cstdint>

#ifndef PG8_ASM_STAGE
#define PG8_ASM_STAGE 0
#endif
#ifndef MK_SINGLE
#define MK_SINGLE 1
#endif

__device__ __forceinline__ int lane_id_v() { int x; asm volatile("v_mbcnt_lo_u32_b32 %0, -1, 0\n\tv_mbcnt_hi_u32_b32 %0, -1, %0" : "=v"(x)); return x; }
namespace pg8 {
#define PG8_LAS __attribute__((address_space(3)))
typedef unsigned short bf16_t;
typedef short bf16x8 __attribute__((ext_vector_type(8)));
typedef float f32x4 __attribute__((ext_vector_type(4)));
typedef unsigned u32x4 __attribute__((ext_vector_type(4)));
constexpr int BM = 256, BK = 64, HALF = 128, HTB = HALF * BK * 2  , STAGE_BYTES = 8 * HTB, NXCD = 8, WGM = 8;

__host__ __device__ __forceinline__ int lds_byte(int r, int c) { const int st = (r >> 4) * 2 + (c >> 5), rr = r & 15, cc = c & 31, ob = rr * 64 + cc * 2; return st * 1024 + (ob ^ (((ob >> 9) & 1) << 5)); }
__host__ __device__ __forceinline__ void stage_rc(int b, int& R, int& C) { const int st = b / 1024, sb = b % 1024, swz = sb ^ (((sb >> 9) & 1) << 5); R = (st >> 1) * 16 + swz / 64; C = (st & 1) * 32 + (swz % 64) / 2; }
__host__ __device__ __forceinline__ int perm32(int rho) { const int n = rho >> 4, i = rho & 15; return 8 * (i >> 2) + 4 * n + (i & 3); }

struct Unit { int pm, pn; };
struct Gemm { const bf16_t* A; const bf16_t* Bt; int M, N, K, lda; };

struct StaticOrder {
    int nM, nN, nwg, G, c;
    __host__ __device__ void init(int M, int N, int G_, int c_) { nM = M / BM; nN = N / BM; nwg = nM * nN; G = G_; c = c_; }
    __host__ __device__ bool next(int i, Unit& u) const {
        const long L = (long)i * G + c; if (L >= nwg) return false;
        int wgid = (int)L; { const int q = nwg / NXCD, r = nwg % NXCD, xcd = wgid % NXCD, off = wgid / NXCD; wgid = (xcd < r ? xcd * (q + 1) : r * (q + 1) + (xcd - r) * q) + off; }
        const int nig = WGM * nN, gid = wgid / nig, fm = gid * WGM, gsz = (nM - fm) < WGM ? (nM - fm) : WGM;
        u.pm = fm + ((wgid % nig) % gsz); u.pn = (wgid % nig) / gsz; return true;
    }
    __device__ __forceinline__ void a_ready(const Unit&) const {}
    __device__ __forceinline__ void done(const Unit&) const {}
};
__device__ __forceinline__ unsigned cvt_pk_bf16(float lo, float hi) { unsigned r; asm volatile("v_cvt_pk_bf16_f32 %0, %1, %2" : "=v"(r) : "v"(lo), "v"(hi)); return r; }

template <class Epi, class Sched, bool ALIGN_EPI = false, bool SP2 = false>
__device__ __forceinline__ void gemm_phase(PG8_LAS unsigned char* lds, const Gemm g, const Sched& S, const Epi& E, const int wv) {
    int tid_ = wv * 64 + lane_id_v(); asm volatile("" : "+v"(tid_));
    const int tid = tid_, wid = __builtin_amdgcn_readfirstlane(tid >> 6), lane = tid & 63, wr = wid >> 2, wc = wid & 3, fr = lane & 15, fq = lane >> 4;
    const int K = g.K, nt = K / BK;
    unsigned voffA[2], voffB[2];
#pragma unroll
    for (int i = 0; i < 2; ++i) { int R, C; stage_rc(tid * 16 + i * 8192, R, C); const int Rb = Epi::PERM ? ((R & ~31) + perm32(R & 31)) : R;
        voffA[i] = (unsigned)(R * g.lda + C) * 2u; voffB[i] = (unsigned)(Rb * K + C) * 2u; }
    const size_t kstep = (size_t)(BK * 2);
    const size_t hstep = (size_t)HALF * K * 2, hstepA = (size_t)HALF * g.lda * 2;
    const size_t tstep = 2 * hstep, tstepA = 2 * hstepA;
    const unsigned ldsw = (unsigned)wid * 1024u;
    const int aoff = lds_byte(wr * 64 + fr, fq * 8), boff = lds_byte(wc * 32 + fr, fq * 8);
#define PG8_SA(b, h) (((b) * 2 + (h)) * HTB)
#define PG8_SB(b, h) ((4 + (b) * 2 + (h)) * HTB)
#if PG8_ASM_STAGE
#define PG8_STAGE(bufoff, gbase, voff) do { const unsigned m0a_ = (unsigned)(size_t)(lds + (bufoff)) + ldsw; const char* gb_ = (const char*)(gbase); \
        asm volatile("s_mov_b32 m0, %2\n\ts_nop 0\n\tglobal_load_lds_dwordx4 %0, %1" :: "v"((voff)[0]), "s"(gb_), "s"(m0a_) : "memory", "m0"); \
        asm volatile("s_add_i32 m0, %2, 0x2000\n\ts_nop 0\n\tglobal_load_lds_dwordx4 %0, %1" :: "v"((voff)[1]), "s"(gb_), "s"(m0a_) : "memory", "m0", "scc"); } while (0)
#else
#define PG8_STAGE(bufoff, gbase, voff) do { _Pragma("unroll") for (int _i = 0; _i < 2; ++_i) \
        __builtin_amdgcn_global_load_lds((const unsigned*)((const char*)(gbase) + (voff)[_i]), (PG8_LAS unsigned*)(lds + (bufoff) + ldsw + _i * 8192), 16, 0, 0); } while (0)
#endif
#define PG8_LDA(dst, b, h) do { _Pragma("unroll") for (int m = 0; m < 4; ++m) _Pragma("unroll") for (int k = 0; k < 2; ++k) dst[m][k] = *(const PG8_LAS bf16x8*)(lds + PG8_SA(b, h) + aoff + m * 2048 + k * 1024); } while (0)
#define PG8_LDB(dst, b, h) do { _Pragma("unroll") for (int n = 0; n < 2; ++n) _Pragma("unroll") for (int k = 0; k < 2; ++k) dst[n][k] = *(const PG8_LAS bf16x8*)(lds + PG8_SB(b, h) + boff + n * 2048 + k * 1024); } while (0)
#define PG8_MMA(ai, bj, At, Bt) do { __builtin_amdgcn_s_setprio(1); _Pragma("unroll") for (int m = 0; m < 4; ++m) _Pragma("unroll") for (int n = 0; n < 2; ++n) _Pragma("unroll") for (int k = 0; k < 2; ++k) \
        acc[ai][bj][m][n] = __builtin_amdgcn_mfma_f32_16x16x32_bf16(Bt[n][k], At[m][k], acc[ai][bj][m][n], 0, 0, 0); __builtin_amdgcn_s_setprio(0); } while (0)
#define PG8_WAIT_V(n) asm volatile("s_waitcnt vmcnt(" #n ")" ::: "memory")
#define PG8_WAIT_L(n) asm volatile("s_waitcnt lgkmcnt(" #n ")" ::: "memory")
#define PG8_BAR __builtin_amdgcn_s_barrier()
#define PG8_SCHED __builtin_amdgcn_sched_barrier(0)
    Unit cur, nxt; int ui = 0;
    if (!S.next(0, cur)) return;
    f32x4 acc[2][2][4][2];
#pragma unroll
    for (int a = 0; a < 2; ++a)
#pragma unroll
        for (int b = 0; b < 2; ++b)
#pragma unroll
            for (int m = 0; m < 4; ++m)
#pragma unroll
                for (int n = 0; n < 2; ++n) acc[a][b][m][n] = (f32x4){0.f, 0.f, 0.f, 0.f};
    bf16x8 At[4][2], B0[2][2], B1[2][2];
    const char* cA = (const char*)g.A + (size_t)cur.pm * tstepA; const char* cB = (const char*)g.Bt + (size_t)cur.pn * tstep;
    S.a_ready(cur);
    if constexpr (SP2) {
        PG8_STAGE(PG8_SB(0, 0), cB, voffB); PG8_STAGE(PG8_SB(0, 1), cB + hstep, voffB); PG8_STAGE(PG8_SA(0, 0), cA, voffA); PG8_STAGE(PG8_SA(0, 1), cA + hstepA, voffA);
        if (wr == 1) PG8_BAR;
        PG8_WAIT_V(2); PG8_BAR;
        PG8_STAGE(PG8_SB(1, 0), cB + kstep, voffB); PG8_STAGE(PG8_SA(1, 0), cA + kstep, voffA); PG8_STAGE(PG8_SB(1, 1), cB + hstep + kstep, voffB);
        PG8_WAIT_V(6); PG8_BAR;
    } else {
        PG8_STAGE(PG8_SB(0, 0), cB, voffB); PG8_STAGE(PG8_SA(0, 0), cA, voffA); PG8_STAGE(PG8_SB(0, 1), cB + hstep, voffB); PG8_STAGE(PG8_SA(0, 1), cA + hstepA, voffA);
        if (wr == 1) PG8_BAR;
        PG8_WAIT_V(4); PG8_BAR;
        PG8_STAGE(PG8_SB(1, 0), cB + kstep, voffB); PG8_STAGE(PG8_SA(1, 0), cA + kstep, voffA); PG8_STAGE(PG8_SB(1, 1), cB + hstep + kstep, voffB);
        PG8_WAIT_V(6); PG8_BAR;
    }
    for (;;) {
        const bool has_next = S.next(ui + 1, nxt);
        const char* nA = has_next ? (const char*)g.A + (size_t)nxt.pm * tstepA : cA; const char* nB = has_next ? (const char*)g.Bt + (size_t)nxt.pn * tstep : cB;
        for (int t = 0; t < nt; t += 2) {
            const bool last = (t == nt - 2);
            const char* a1 = cA + (size_t)(t + 1) * kstep;
            const char* a2 = last ? nA : cA + (size_t)(t + 2) * kstep; const char* b2 = last ? nB : cB + (size_t)(t + 2) * kstep;
            const char* a3 = a2 + kstep; const char* b3 = b2 + kstep;
            if (last && has_next) S.a_ready(nxt);
            if constexpr (SP2) {
            PG8_LDB(B0, 0, 0); PG8_LDB(B1, 0, 1); PG8_SCHED; PG8_LDA(At, 0, 0); PG8_STAGE(PG8_SA(1, 1), a1 + hstepA, voffA);
            PG8_WAIT_V(8); PG8_WAIT_L(0); PG8_BAR; PG8_MMA(0, 0, At, B0); PG8_MMA(0, 1, At, B1); PG8_BAR; PG8_SCHED;
            PG8_LDA(At, 0, 1); PG8_STAGE(PG8_SB(0, 0), b2, voffB); PG8_STAGE(PG8_SB(0, 1), b2 + hstep, voffB); PG8_STAGE(PG8_SA(0, 0), a2, voffA);
            PG8_WAIT_V(8); PG8_WAIT_L(0); PG8_BAR; PG8_MMA(1, 0, At, B0); PG8_MMA(1, 1, At, B1); PG8_BAR; PG8_SCHED;
            PG8_LDB(B0, 1, 0); PG8_LDB(B1, 1, 1); PG8_SCHED; PG8_LDA(At, 1, 0); PG8_STAGE(PG8_SA(0, 1), a2 + hstepA, voffA);
            PG8_WAIT_V(8); PG8_WAIT_L(0); PG8_BAR; PG8_MMA(0, 0, At, B0); PG8_MMA(0, 1, At, B1); PG8_BAR; PG8_SCHED;
            PG8_LDA(At, 1, 1); PG8_STAGE(PG8_SB(1, 0), b3, voffB); PG8_STAGE(PG8_SB(1, 1), b3 + hstep, voffB); PG8_STAGE(PG8_SA(1, 0), a3, voffA);
            PG8_WAIT_V(8); PG8_WAIT_L(0); PG8_BAR; PG8_MMA(1, 0, At, B0); PG8_MMA(1, 1, At, B1); PG8_BAR; PG8_SCHED;
            } else {
            PG8_LDB(B0, 0, 0); PG8_SCHED; PG8_LDA(At, 0, 0); PG8_STAGE(PG8_SA(1, 1), a1 + hstepA, voffA);
            PG8_WAIT_L(8); PG8_BAR; PG8_WAIT_L(0); PG8_MMA(0, 0, At, B0); PG8_BAR; PG8_SCHED;
            PG8_LDB(B1, 0, 1); PG8_STAGE(PG8_SB(0, 0), b2, voffB);
            PG8_BAR; PG8_WAIT_L(0); PG8_MMA(0, 1, At, B1); PG8_BAR;
            PG8_LDA(At, 0, 1); PG8_STAGE(PG8_SA(0, 0), a2, voffA);
            PG8_BAR; PG8_WAIT_L(0); PG8_MMA(1, 0, At, B0); PG8_BAR; PG8_SCHED;
            PG8_STAGE(PG8_SB(0, 1), b2 + hstep, voffB);
            PG8_WAIT_V(6); PG8_BAR; PG8_MMA(1, 1, At, B1); PG8_BAR;
            PG8_LDB(B0, 1, 0); PG8_SCHED; PG8_LDA(At, 1, 0); PG8_STAGE(PG8_SA(0, 1), a2 + hstepA, voffA);
            PG8_WAIT_L(8); PG8_BAR; PG8_WAIT_L(0); PG8_MMA(0, 0, At, B0); PG8_BAR; PG8_SCHED;
            PG8_LDB(B1, 1, 1); PG8_STAGE(PG8_SB(1, 0), b3, voffB);
            PG8_BAR; PG8_WAIT_L(0); PG8_MMA(0, 1, At, B1); PG8_BAR;
            PG8_LDA(At, 1, 1); PG8_STAGE(PG8_SA(1, 0), a3, voffA);
            PG8_BAR; PG8_WAIT_L(0); PG8_MMA(1, 0, At, B0); PG8_BAR; PG8_SCHED;
            PG8_STAGE(PG8_SB(1, 1), b3 + hstep, voffB);
            PG8_WAIT_V(6); PG8_BAR; PG8_MMA(1, 1, At, B1); PG8_BAR;
            }
        }
        if constexpr (ALIGN_EPI) { if (wr == 0) PG8_BAR; }
        if constexpr (!Epi::AFTER_DRAIN) { const int ln_ = lane_id_v(); E(acc, cur, wr, wc, ln_ & 15, ln_ >> 4); S.done(cur); }
        if (!has_next) break;
#pragma unroll
        for (int a = 0; a < 2; ++a)
#pragma unroll
            for (int b = 0; b < 2; ++b)
#pragma unroll
                for (int m = 0; m < 4; ++m)
#pragma unroll
                    for (int n = 0; n < 2; ++n) acc[a][b][m][n] = (f32x4){0.f, 0.f, 0.f, 0.f};
        cur = nxt; cA = nA; cB = nB; ++ui;
        if constexpr (ALIGN_EPI) { if (wr == 1) PG8_BAR; }
    }
    PG8_WAIT_V(0);
    if constexpr (!ALIGN_EPI) { if (wr == 0) PG8_BAR; }
    PG8_BAR;
    if constexpr (Epi::AFTER_DRAIN) { E.fused(acc, cur, wr, wc, fr, fq, lds, wid, lane); S.done(cur); }
#undef PG8_SA
#undef PG8_SB
#undef PG8_STAGE
#undef PG8_LDA
#undef PG8_LDB
#undef PG8_MMA
#undef PG8_WAIT_V
#undef PG8_WAIT_L
#undef PG8_BAR
#undef PG8_SCHED
}

constexpr float NORM_EPS = 1e-6f;
__device__ __forceinline__ float row_rstd(const float* ssq, int row, int fq) {
    const f32x4 a = *(const f32x4*)(ssq + (size_t)row * 32 + fq * 8), b = *(const f32x4*)(ssq + (size_t)row * 32 + fq * 8 + 4);
    float s = ((a[0] + a[1]) + (a[2] + a[3])) + ((b[0] + b[1]) + (b[2] + b[3]));
    s += __shfl_xor(s, 16); s += __shfl_xor(s, 32);
    return rsqrtf(s * (1.0f / 2048.0f) + NORM_EPS);
}
__device__ __forceinline__ float fsigmoid(float x) { return __builtin_amdgcn_rcpf(1.0f + __expf(-x)); }
__device__ __forceinline__ u32x4 pack8(const f32x4 v0, const f32x4 v1) { u32x4 w; w.x = cvt_pk_bf16(v0[0], v0[1]); w.y = cvt_pk_bf16(v0[2], v0[3]); w.z = cvt_pk_bf16(v1[0], v1[1]); w.w = cvt_pk_bf16(v1[2], v1[3]); return w; }
__device__ __forceinline__ void unpack8(const u32x4 w, f32x4& v0, f32x4& v1) {
    v0[0] = __uint_as_float(w.x << 16); v0[1] = __uint_as_float(w.x & 0xffff0000u); v0[2] = __uint_as_float(w.y << 16); v0[3] = __uint_as_float(w.y & 0xffff0000u);
    v1[0] = __uint_as_float(w.z << 16); v1[1] = __uint_as_float(w.z & 0xffff0000u); v1[2] = __uint_as_float(w.w << 16); v1[3] = __uint_as_float(w.w & 0xffff0000u); }

struct EpiSwiGLU {
    static constexpr bool PERM = true, AFTER_DRAIN = false;
    const float* ssq; bf16_t* H; int ldh;
    __device__ __forceinline__ void operator()(const f32x4 (&acc)[2][2][4][2], const Unit& u, int wr, int wc, int fr, int fq) const {
        const int row0 = u.pm * BM + wr * 64 + fr, col0 = u.pn * HALF + wc * 32 + 8 * fq;
        float rs[2][4];
#pragma unroll
        for (int ai = 0; ai < 2; ++ai)
#pragma unroll
            for (int m = 0; m < 4; ++m) rs[ai][m] = row_rstd(ssq, row0 + ai * HALF + m * 16, fq);
#pragma unroll
        for (int ai = 0; ai < 2; ++ai)
#pragma unroll
            for (int m = 0; m < 4; ++m) { const int row = row0 + ai * HALF + m * 16; const float r = rs[ai][m];
                f32x4 h0, h1;
#pragma unroll
                for (int j = 0; j < 4; ++j) { const float g0 = acc[ai][0][m][0][j] * r, g1 = acc[ai][0][m][1][j] * r;
                    h0[j] = g0 * fsigmoid(g0) * (acc[ai][1][m][0][j] * r); h1[j] = g1 * fsigmoid(g1) * (acc[ai][1][m][1][j] * r); }
                *(u32x4*)(H + (size_t)row * ldh + col0) = pack8(h0, h1); }
    }
};
struct EpiResid {
    static constexpr bool PERM = true, AFTER_DRAIN = false;
    const float* base; float* out; bf16_t* xb; float* ssq; float alpha;
    __device__ __forceinline__ void operator()(const f32x4 (&acc)[2][2][4][2], const Unit& u, int wr, int wc, int fr, int fq) const {
        const int row0 = u.pm * BM + wr * 64 + fr, col0 = u.pn * BM + wc * 32 + 8 * fq;
#pragma unroll
        for (int ai = 0; ai < 2; ++ai) {
            f32x4 bv[4][2][2];
#pragma unroll
            for (int m = 0; m < 4; ++m)
#pragma unroll
                for (int bj = 0; bj < 2; ++bj) { const size_t off = (size_t)(row0 + ai * HALF + m * 16) * 2048 + col0 + bj * HALF;
                    bv[m][bj][0] = *(const f32x4*)(base + off); bv[m][bj][1] = *(const f32x4*)(base + off + 4); }
#pragma unroll
            for (int m = 0; m < 4; ++m) { const int row = row0 + ai * HALF + m * 16; float ss = 0.f;
#pragma unroll
                for (int bj = 0; bj < 2; ++bj) { const size_t off = (size_t)row * 2048 + col0 + bj * HALF;
                    const f32x4 v0 = bv[m][bj][0] + acc[ai][bj][m][0] * alpha, v1 = bv[m][bj][1] + acc[ai][bj][m][1] * alpha;
                    *(f32x4*)(out + off) = v0; *(f32x4*)(out + off + 4) = v1;
                    ss += ((v0[0] * v0[0] + v0[1] * v0[1]) + (v0[2] * v0[2] + v0[3] * v0[3])) + ((v1[0] * v1[0] + v1[1] * v1[1]) + (v1[2] * v1[2] + v1[3] * v1[3]));
                    *(u32x4*)(xb + off) = pack8(v0, v1); }
                ss += __shfl_xor(ss, 16); ss += __shfl_xor(ss, 32);
                if (fq == 0) ssq[(size_t)row * 32 + u.pn * 4 + wc] = ss; }
            asm volatile("" ::: "memory"); }
    }
};
struct EpiWin {
    static constexpr bool PERM = true, AFTER_DRAIN = false;
    const float* ssq; bf16_t* u1; bf16_t* u2; int ld1, ld2;
    __device__ __forceinline__ void operator()(const f32x4 (&acc)[2][2][4][2], const Unit& u, int wr, int wc, int fr, int fq) const {
        const int row0 = u.pm * BM + wr * 64 + fr; const int mode = u.pn < 17 ? 0 : (u.pn < 19 ? 1 : 2);
        bf16_t* dst = mode == 2 ? u2 : u1; const int ld = mode == 2 ? ld2 : ld1; const int col0 = (mode == 2 ? (u.pn - 19) : u.pn) * BM + wc * 32 + 8 * fq;
        float rsv[2][4];
#pragma unroll
        for (int ai = 0; ai < 2; ++ai)
#pragma unroll
            for (int m = 0; m < 4; ++m) rsv[ai][m] = row_rstd(ssq, row0 + ai * HALF + m * 16, fq);
#pragma unroll
        for (int ai = 0; ai < 2; ++ai)
#pragma unroll
            for (int m = 0; m < 4; ++m) { const int row = row0 + ai * HALF + m * 16; const float rs = rsv[ai][m];
#pragma unroll
                for (int bj = 0; bj < 2; ++bj) { f32x4 v0 = acc[ai][bj][m][0] * rs, v1 = acc[ai][bj][m][1] * rs;
                    if (mode == 1) {
#pragma unroll
                        for (int j = 0; j < 4; ++j) { v0[j] = v0[j] * fsigmoid(v0[j]); v1[j] = v1[j] * fsigmoid(v1[j]); } }
                    else if (mode == 2) {
#pragma unroll
                        for (int j = 0; j < 4; ++j) { v0[j] = fsigmoid(v0[j]); v1[j] = fsigmoid(v1[j]); } }
                    *(u32x4*)(dst + (size_t)row * ld + col0 + bj * HALF) = pack8(v0, v1); } }
    }
};
struct EpiBf16 {
    static constexpr bool PERM = true, AFTER_DRAIN = false;
    bf16_t* O; int ldc;
    __device__ __forceinline__ void operator()(const f32x4 (&acc)[2][2][4][2], const Unit& u, int wr, int wc, int fr, int fq) const {
        const int row0 = u.pm * BM + wr * 64 + fr, col0 = u.pn * BM + wc * 32 + 8 * fq;
#pragma unroll
        for (int ai = 0; ai < 2; ++ai)
#pragma unroll
            for (int m = 0; m < 4; ++m) { bf16_t* rowp = O + (size_t)(row0 + ai * HALF + m * 16) * ldc + col0;
#pragma unroll
                for (int bj = 0; bj < 2; ++bj) *(u32x4*)(rowp + bj * HALF) = pack8(acc[ai][bj][m][0], acc[ai][bj][m][1]); }
    }
};
struct EpiF32 {
    static constexpr bool PERM = false, AFTER_DRAIN = false;
    float* C; int ldc;
    __device__ __forceinline__ void operator()(const f32x4 (&acc)[2][2][4][2], const Unit& u, int wr, int wc, int fr, int fq) const {
        const int row0 = u.pm * BM + wr * 64 + fr, col0 = u.pn * BM + wc * 32 + 4 * fq;
#pragma unroll
        for (int ai = 0; ai < 2; ++ai)
#pragma unroll
            for (int m = 0; m < 4; ++m) { float* rowp = C + (size_t)(row0 + ai * HALF + m * 16) * ldc + col0;
#pragma unroll
                for (int bj = 0; bj < 2; ++bj)
#pragma unroll
                    for (int n = 0; n < 2; ++n) *(f32x4*)(rowp + bj * HALF + n * 16) = acc[ai][bj][m][n]; }
    }
};
template <int MODE> struct EpiMerge {
    static constexpr bool PERM = true, AFTER_DRAIN = false;
    const bf16_t* gate; int ldg; bf16_t* mb;
    __device__ __forceinline__ void operator()(const f32x4 (&acc)[2][2][4][2], const Unit& u, int wr, int wc, int fr, int fq) const {
        const int row0 = u.pm * BM + wr * 64 + fr, col0 = u.pn * BM + wc * 32 + 8 * fq;
#pragma unroll
        for (int ai = 0; ai < 2; ++ai) {
            u32x4 gw[4][2], mw[4][2];
#pragma unroll
            for (int m = 0; m < 4; ++m)
#pragma unroll
                for (int bj = 0; bj < 2; ++bj) { const int row = row0 + ai * HALF + m * 16, col = col0 + bj * HALF;
                    gw[m][bj] = *(const u32x4*)(gate + (size_t)row * ldg + col);
                    if (MODE >= 1) mw[m][bj] = *(const u32x4*)(mb + (size_t)row * 2048 + col); }
#pragma unroll
            for (int m = 0; m < 4; ++m)
#pragma unroll
                for (int bj = 0; bj < 2; ++bj) { const int row = row0 + ai * HALF + m * 16, col = col0 + bj * HALF;
                    f32x4 g0, g1; unpack8(gw[m][bj], g0, g1);
                    f32x4 v0 = g0 * acc[ai][bj][m][0], v1 = g1 * acc[ai][bj][m][1];
                    if (MODE >= 1) { f32x4 p0, p1; unpack8(mw[m][bj], p0, p1); v0 += p0; v1 += p1; }
                    *(u32x4*)(mb + (size_t)row * 2048 + col) = pack8(v0, v1); }
            asm volatile("" ::: "memory"); }
    }
};
}

#define GAS __attribute__((address_space(1)))
#define LAS __attribute__((address_space(3)))
typedef unsigned short bf16_t;
typedef short bf16x8 __attribute__((ext_vector_type(8)));
typedef short s16x4 __attribute__((ext_vector_type(4)));
typedef float f32x4 __attribute__((ext_vector_type(4)));
typedef float f32x16 __attribute__((ext_vector_type(16)));
typedef unsigned u32x4 __attribute__((ext_vector_type(4)));
typedef unsigned u32x2 __attribute__((ext_vector_type(2)));
#define LDS_WAIT() asm volatile("s_waitcnt lgkmcnt(0)" ::: "memory")
#define VM_WAIT() asm volatile("s_waitcnt vmcnt(0)" ::: "memory")
#define SBAR() __builtin_amdgcn_sched_barrier(0)
__device__ __forceinline__ unsigned f2bf(float f) { unsigned u = __builtin_bit_cast(unsigned, f); return (u + 0x7fffu + ((u >> 16) & 1u)) >> 16; }
__device__ __forceinline__ float bf2f(bf16_t b) { return __uint_as_float(((unsigned)b) << 16); }
__device__ __forceinline__ unsigned pk2(float lo, float hi) { return f2bf(lo) | (f2bf(hi) << 16); }
__device__ __forceinline__ float wave_sum(float v) {
#pragma unroll
    for (int o = 1; o < 64; o <<= 1) v += __shfl_xor(v, o);
    return v;
}

constexpr int NB = 2, SEQ = 16384, MTOK = NB * SEQ, DM = 2048, FF = 5504, DEPTH = 4;
constexpr int NGU = 2 * FF, NIN = 11008, U1W = 4864, U2W = 6144;
constexpr int C_CQ = 0, C_CKV = 512, C_QB = 768, C_KB = 1024, C_VB = 1280, C_QC = 1792, C_KC = 2560, C_VC = 3328, C_KROPE = 4096, C_GLR = 4160, C_RB = 4352;
constexpr int QRAW_LD = 1280, KVRAW_LD = 1536;
constexpr float EPS = 1e-6f, LOG2E = 1.4426950408889634f, LN2 = 0.6931471805599453f;
constexpr float QS_MLA = 0.07216878364870322f * LOG2E;
constexpr float QS_DSWA = 0.08838834764831845f * LOG2E;

namespace att {
constexpr int SHM_V = 64 * 128 * 2;
constexpr int K_OFF = 2 * SHM_V;
template <int DQK> struct Geo { static constexpr int KP = DQK * 2 + 16, SHM_K = 64 * KP, NCH = DQK / 8, NKST = (64 * NCH) / 512, WS_OFF = K_OFF + 2 * SHM_K, K_OFF3 = 3 * SHM_V, WS_OFF3 = K_OFF3 + 2 * SHM_K; };
__device__ __forceinline__ int v_st(int k, int c) { const int kk = (k & ~0xC) | ((k & 4) << 1) | ((k & 8) >> 1); return ((kk >> 3) * 4 + (c >> 5)) * 512 + ((kk & 7) * 32 + (c & 31)) * 2; }
__device__ __forceinline__ int v_rd_base(int lane) { return ((lane & 3) << 3) | (((lane >> 2) & 3) << 6) | (((lane >> 4) & 1) << 5) | (((lane >> 5) & 1) << 8); }
constexpr int v_rd_off(int d0, int ks, int half) { return d0 * 512 + ks * 4096 + half * 2048; }
__device__ __forceinline__ int crow(int r, int hi) { return (r & 3) + 8 * (r >> 2) + 4 * hi; }
__device__ __forceinline__ unsigned cvtpk(float lo, float hi) { unsigned r; asm volatile("v_cvt_pk_bf16_f32 %0, %1, %2" : "=v"(r) : "v"(lo), "v"(hi)); return r; }

__device__ __forceinline__ void pv_tile(f32x16* o, int vb, bf16x8 pa0, bf16x8 pa1, bf16x8 pa2, bf16x8 pa3) {
#define TRRD(dst, off) asm volatile("ds_read_b64_tr_b16 %0, %1 offset:%2" : "=&v"(dst) : "v"(vb), "i"(off) : "memory")
#define PV_RD(S, d0) do { constexpr int b_ = v_rd_off(d0, 0, 0); TRRD(S##l0, b_); TRRD(S##h0, b_ + 2048); TRRD(S##l1, b_ + 4096); TRRD(S##h1, b_ + 6144); \
        TRRD(S##l2, b_ + 8192); TRRD(S##h2, b_ + 10240); TRRD(S##l3, b_ + 12288); TRRD(S##h3, b_ + 14336); } while (0)
#define PV_MM(S, d0) do { \
        o[d0] = __builtin_amdgcn_mfma_f32_32x32x16_bf16(pa0, (bf16x8){S##l0[0], S##l0[1], S##l0[2], S##l0[3], S##h0[0], S##h0[1], S##h0[2], S##h0[3]}, o[d0], 0, 0, 0); \
        o[d0] = __builtin_amdgcn_mfma_f32_32x32x16_bf16(pa1, (bf16x8){S##l1[0], S##l1[1], S##l1[2], S##l1[3], S##h1[0], S##h1[1], S##h1[2], S##h1[3]}, o[d0], 0, 0, 0); \
        o[d0] = __builtin_amdgcn_mfma_f32_32x32x16_bf16(pa2, (bf16x8){S##l2[0], S##l2[1], S##l2[2], S##l2[3], S##h2[0], S##h2[1], S##h2[2], S##h2[3]}, o[d0], 0, 0, 0); \
        o[d0] = __builtin_amdgcn_mfma_f32_32x32x16_bf16(pa3, (bf16x8){S##l3[0], S##l3[1], S##l3[2], S##l3[3], S##h3[0], S##h3[1], S##h3[2], S##h3[3]}, o[d0], 0, 0, 0); } while (0)
    s16x4 Al0, Al1, Al2, Al3, Ah0, Ah1, Ah2, Ah3, Bl0, Bl1, Bl2, Bl3, Bh0, Bh1, Bh2, Bh3;
    PV_RD(A, 0); PV_RD(B, 1);
    asm volatile("s_waitcnt lgkmcnt(8)" ::: "memory"); SBAR(); PV_MM(A, 0); SBAR(); PV_RD(A, 2);
    asm volatile("s_waitcnt lgkmcnt(8)" ::: "memory"); SBAR(); PV_MM(B, 1); SBAR(); PV_RD(B, 3);
    asm volatile("s_waitcnt lgkmcnt(8)" ::: "memory"); SBAR(); PV_MM(A, 2); SBAR();
    asm volatile("s_waitcnt lgkmcnt(0)" ::: "memory"); SBAR(); PV_MM(B, 3);
#undef PV_MM
#undef PV_RD
#undef TRRD
}

struct AUnit { const bf16_t* Q; const bf16_t* K; const bf16_t* V; bf16_t* O; float* lse; size_t qpitch, kpitch, vpitch, opitch, lsepitch; int q0, j_lo, j_hi; float bias_c; };

template <int DQK> __device__ __forceinline__ int k_chunk_swz(int row, int c) {
    if (DQK == 192) return (c & ~7) | ((c & 7) ^ ((row >> 1) & 7));
    return c ^ (((row >> 1) & 7) | ((row & 1) << 3));
}
template <int DQK, int MODE>
__device__ __forceinline__ void attn_unit(LAS unsigned char* lds, const AUnit& u, const int wv) {
    using G = Geo<DQK>;
    constexpr int PK = DQK * 2, SHK = 64 * PK, NCH = DQK / 8, NKD = (64 * NCH) / 512;
    constexpr int KOFF = 3 * SHM_V, WOFF = KOFF + 2 * SHK;
    int tid_ = wv * 64 + lane_id_v(); asm volatile("" : "+v"(tid_));
    const int tid = tid_, wid = __builtin_amdgcn_readfirstlane(tid >> 6), lane = tid & 63, r32 = lane & 31, hi = lane >> 5;
    LAS unsigned char* V_lds = lds; LAS unsigned char* K_lds = lds + KOFF;
    LAS float* wsl = (LAS float*)(lds + WOFF) + wid * 64; LAS float* li_l = wsl; LAS float* al_l = wsl + 32;
    bf16x8 qr[DQK / 16];
    { const bf16_t* qrow = u.Q + (size_t)(wid * 32 + r32) * u.qpitch + hi * 8;
#pragma unroll
      for (int d0 = 0; d0 < DQK / 16; ++d0) qr[d0] = *(const bf16x8*)(qrow + d0 * 16); }
    float m_reg = -1e30f, l_reg = 0.f; f32x16 o[4] = {};
    const int vb0 = (int)(size_t)V_lds + v_rd_base(lane);
    const int qlo = u.q0 + wid * 32, qj = qlo + r32;
    const bool lead = wid < 4;
    const float NEG = -__builtin_inff();
    size_t ksrc[NKD], vsrc[2];
#pragma unroll
    for (int i = 0; i < NKD; ++i) { const int sl = (i * 8 + wid) * 64 + lane, row = sl / NCH, cs = sl % NCH; ksrc[i] = (size_t)row * u.kpitch + (size_t)k_chunk_swz<DQK>(row, cs) * 8; }
#pragma unroll
    for (int i = 0; i < 2; ++i) { const int off = ((i * 8 + wid) * 64 + lane) * 16, sub = off >> 9, kk = ((sub >> 2) << 3) | ((off & 511) >> 6), c = ((sub & 3) << 5) | ((off & 63) >> 1);
        const int k = (kk & ~0xC) | ((kk & 4) << 1) | ((kk & 8) >> 1); vsrc[i] = (size_t)k * u.vpitch + c; }
#define ST_DMA(t, kbf, vbf) do { const bf16_t* kt_ = u.K + (size_t)(t) * 64 * u.kpitch; const bf16_t* vt_ = u.V + (size_t)(t) * 64 * u.vpitch; \
        _Pragma("unroll") for (int i_ = 0; i_ < NKD; ++i_) __builtin_amdgcn_global_load_lds((const unsigned*)(kt_ + ksrc[i_]), (LAS unsigned*)(K_lds + (kbf) * SHK + (i_ * 8 + wid) * 1024), 16, 0, 0); \
        _Pragma("unroll") for (int i_ = 0; i_ < 2; ++i_) __builtin_amdgcn_global_load_lds((const unsigned*)(vt_ + vsrc[i_]), (LAS unsigned*)(V_lds + (vbf) * SHM_V + (i_ * 8 + wid) * 1024), 16, 0, 0); } while (0)
    int kra[4];
#pragma unroll
    for (int q = 0; q < 4; ++q) kra[q] = (int)(size_t)K_lds + r32 * PK + 16 * (((2 * q + hi) ^ ((r32 >> 1) & 7))) + (DQK == 128 ? ((r32 & 1) << 7) : 0);
#define KFRAG(KB_, d0_, half_) (*(const LAS bf16x8*)(size_t)(unsigned)((DQK == 192 ? kra[(d0_) & 3] + (KB_) * SHK + 128 * ((d0_) >> 2) : ((kra[(d0_) & 3] + (KB_) * SHK) ^ (((d0_) >> 2) << 7))) + (half_) * 32 * PK))
#define QK_TILE(T_, KB_) do { p0 = f32x16{}; p1 = f32x16{}; \
        { __builtin_amdgcn_s_setprio(1); bf16x8 kfa[3], kfb[3]; \
          kfa[0] = KFRAG(KB_, 0, 0); kfb[0] = KFRAG(KB_, 0, 1); kfa[1] = KFRAG(KB_, 1, 0); kfb[1] = KFRAG(KB_, 1, 1); \
          _Pragma("unroll") for (int d0 = 0; d0 < DQK / 16; ++d0) { \
              if (d0 + 2 < DQK / 16) { kfa[(d0 + 2) % 3] = KFRAG(KB_, d0 + 2, 0); kfb[(d0 + 2) % 3] = KFRAG(KB_, d0 + 2, 1); } \
              p0 = __builtin_amdgcn_mfma_f32_32x32x16_bf16(kfa[d0 % 3], qr[d0], p0, 0, 0, 0); \
              p1 = __builtin_amdgcn_mfma_f32_32x32x16_bf16(kfb[d0 % 3], qr[d0], p1, 0, 0, 0); SBAR(); } __builtin_amdgcn_s_setprio(0); } \
        const int kb0 = (T_) * 64; \
        if (MODE == 0) { if (kb0 + 63 > qlo) { _Pragma("unroll") for (int r = 0; r < 16; ++r) { const int key = kb0 + (r & 3) + 8 * (r >> 2) + 4 * hi; if (key > qj) p0[r] = NEG; if (key + 32 > qj) p1[r] = NEG; } } } \
        else { _Pragma("unroll") for (int r = 0; r < 16; ++r) { const int dist = qj - (kb0 + (r & 3) + 8 * (r >> 2) + 4 * hi), dist2 = dist - 32; \
                p0[r] = ((unsigned)dist <= 128u) ? p0[r] - u.bias_c * (float)dist : NEG; p1[r] = ((unsigned)dist2 <= 128u) ? p1[r] - u.bias_c * (float)dist2 : NEG; } } } while (0)
#define PK4(P, B_, OUT) do { unsigned a0 = cvtpk(P[B_ + 0], P[B_ + 1]), a1 = cvtpk(P[B_ + 2], P[B_ + 3]); unsigned b0 = cvtpk(P[B_ + 4], P[B_ + 5]), b1 = cvtpk(P[B_ + 6], P[B_ + 7]); \
        auto r0 = __builtin_amdgcn_permlane32_swap(a0, b0, false, false); auto r1 = __builtin_amdgcn_permlane32_swap(a1, b1, false, false); \
        u32x4 w = {r0[0], r1[0], r0[1], r1[1]}; OUT = *reinterpret_cast<bf16x8*>(&w); } while (0)
#define SOFTMAX_TILE() do { float pmax = p0[0]; \
        _Pragma("unroll") for (int r = 1; r < 16; ++r) pmax = fmaxf(pmax, p0[r]); \
        _Pragma("unroll") for (int r = 0; r < 16; ++r) pmax = fmaxf(pmax, p1[r]); \
        { auto rr = __builtin_amdgcn_permlane32_swap(__float_as_uint(pmax), __float_as_uint(pmax), false, false); pmax = fmaxf(__uint_as_float(rr[0]), __uint_as_float(rr[1])); } \
        const float mn = fmaxf(m_reg, pmax); const float alpha = __builtin_amdgcn_exp2f(m_reg - mn); m_reg = mn; \
        _Pragma("unroll") for (int r = 0; r < 16; ++r) { p0[r] = __builtin_amdgcn_exp2f(p0[r] - mn); p1[r] = __builtin_amdgcn_exp2f(p1[r] - mn); } \
        float ps = 0.f; \
        _Pragma("unroll") for (int r = 0; r < 16; ++r) ps += p0[r] + p1[r]; \
        { auto rr = __builtin_amdgcn_permlane32_swap(__float_as_uint(ps), __float_as_uint(ps), false, false); ps = __uint_as_float(rr[0]) + __uint_as_float(rr[1]); } \
        l_reg = l_reg * alpha + ps; \
        PK4(p0, 0, pa0); PK4(p0, 8, pa1); PK4(p1, 0, pa2); PK4(p1, 8, pa3); \
        if (__any(alpha < 1.f)) { if (hi == 0) al_l[r32] = alpha; LDS_WAIT(); \
            _Pragma("unroll") for (int r = 0; r < 16; ++r) { const float a_ = al_l[(r & 3) + 8 * (r >> 2) + 4 * hi]; \
                _Pragma("unroll") for (int d = 0; d < 4; ++d) o[d][r] *= a_; } } } while (0)
#define PV_TILE(VB_) do { __builtin_amdgcn_s_setprio(1); pv_tile(o, vb0 + (VB_) * SHM_V, pa0, pa1, pa2, pa3); __builtin_amdgcn_s_setprio(0); } while (0)
    f32x16 p0, p1; bf16x8 pa0, pa1, pa2, pa3;
    int kbuf = 0, vbuf = 0, vprev = 0;
    ST_DMA(u.j_lo, 0, 0);
#define TILE_TOP() VM_WAIT(); __syncthreads(); if (t + 1 < u.j_hi) ST_DMA(t + 1, kbuf ^ 1, (vbuf == 2 ? 0 : vbuf + 1))
#define TILE_NEXT() vprev = vbuf; kbuf ^= 1; vbuf = vbuf == 2 ? 0 : vbuf + 1
    if (lead) {
        { const int t = u.j_lo; TILE_TOP(); QK_TILE(t, kbuf); SOFTMAX_TILE(); TILE_NEXT(); }
        for (int t = u.j_lo + 1; t < u.j_hi; ++t) { TILE_TOP(); PV_TILE(vprev); QK_TILE(t, kbuf); SOFTMAX_TILE(); TILE_NEXT(); }
        PV_TILE(vprev);
    } else {
        { const int t = u.j_lo; TILE_TOP(); QK_TILE(t, kbuf); TILE_NEXT(); }
        for (int t = u.j_lo + 1; t < u.j_hi; ++t) { TILE_TOP(); { const int vp_ = vprev; SOFTMAX_TILE(); PV_TILE(vp_); } QK_TILE(t, kbuf); TILE_NEXT(); }
        SOFTMAX_TILE(); PV_TILE(vprev);
    }
#undef TILE_TOP
#undef TILE_NEXT
    if (hi == 0) li_l[r32] = l_reg; LDS_WAIT();
    float rli[16];
#pragma unroll
    for (int r = 0; r < 16; ++r) rli[r] = __builtin_amdgcn_rcpf(li_l[(r & 3) + 8 * (r >> 2) + 4 * hi]);
    bf16_t* Ow = u.O + (size_t)(wid * 32) * u.opitch;
#pragma unroll
    for (int r = 0; r < 16; ++r) { const int orow = (r & 3) + 8 * (r >> 2) + 4 * hi;
#pragma unroll
        for (int d0 = 0; d0 < 4; ++d0) { const float v = o[d0][r] * rli[r]; const float vn = __shfl_xor(v, 1);
            if ((r32 & 1) == 0) *(unsigned*)(Ow + (size_t)orow * u.opitch + d0 * 32 + r32) = cvtpk(v, vn); } }
    if (MODE == 1) { if (hi == 0) u.lse[(size_t)(wid * 32 + r32) * u.lsepitch] = (m_reg + __log2f(l_reg)) * LN2; }
    __syncthreads();
#undef ST_DMA
#undef KFRAG
#undef QK_TILE
#undef PK4
#undef SOFTMAX_TILE
#undef PV_TILE
}
}

constexpr size_t al256(size_t x) { return (x + 255) & ~(size_t)255; }
constexpr size_t WS_CTL = 0, CTL_BYTES = 1u << 20;
constexpr size_t WS_ROPE = WS_CTL + CTL_BYTES;
constexpr size_t WS_SSQ = WS_ROPE + al256((size_t)MTOK * 64 * 4);
constexpr size_t WS_XB = WS_SSQ + al256((size_t)MTOK * 32 * 4);
constexpr size_t WS_W = WS_XB + al256((size_t)MTOK * DM * 2);
constexpr size_t W_GU1 = 0, W_D1 = W_GU1 + (size_t)NGU * DM, W_IN = W_D1 + (size_t)DM * FF, W_UQ = W_IN + (size_t)NIN * DM, W_UKV = W_UQ + (size_t)1280 * 512,
                 W_A = W_UKV + (size_t)1536 * 256, W_B = W_A + (size_t)DM * 768, W_C = W_B + (size_t)DM * 512, W_OUT = W_C + (size_t)DM * 256, W_GU2 = W_OUT + (size_t)DM * DM,
                 W_D2 = W_GU2 + (size_t)NGU * DM, W_END = W_D2 + (size_t)DM * FF;
constexpr size_t WS_R1 = WS_W + al256(W_END * 2);
constexpr size_t WS_R2 = WS_R1 + al256((size_t)MTOK * U2W * 2);
constexpr size_t WS_QKV = WS_R2 + al256((size_t)MTOK * U1W * 2);
constexpr size_t QKV_Q = 0, QKV_K = (size_t)NB * 6 * SEQ * 192 * 2, QKV_V = 2 * QKV_K, QKV_END = QKV_V + (size_t)NB * 6 * SEQ * 128 * 2;
constexpr size_t WS_R3 = WS_QKV + al256(QKV_END);
constexpr size_t R3_QRAW = 0, R3_KVRAW = (size_t)MTOK * QRAW_LD * 2, R3_RAW_END = R3_KVRAW + (size_t)MTOK * KVRAW_LD * 2;
constexpr size_t R3_YA = 0, R3_YB = R3_YA + (size_t)MTOK * 768 * 2, R3_YC = R3_YB + (size_t)MTOK * 512 * 2, R3_DO = R3_YC + (size_t)MTOK * 256 * 2, R3_LSE = R3_DO + (size_t)MTOK * 768 * 2;
constexpr size_t R3_END = (R3_LSE + (size_t)MTOK * 6 * 4) > R3_RAW_END ? (R3_LSE + (size_t)MTOK * 6 * 4) : R3_RAW_END;
constexpr size_t WS_GLA = WS_R3 + al256(R3_END);
constexpr size_t GLA_DS = 0, GLA_BC = (size_t)2048 * 8192 * 4, GLA_DEC = GLA_BC + (size_t)MTOK * 256 * 4, GLA_END = GLA_DEC + (size_t)2048 * 64 * 4;
constexpr size_t WS_END = WS_GLA + al256(GLA_END);
constexpr int CW_BAR = 1024;
constexpr int CW_QUEUE = 16384;

constexpr int RING_BYTES = 131072, LDSCTL_OFF = RING_BYTES, LDS_BYTES = 147456;
constexpr int NWAVES = 8, NTHR = 512;

#define XB_TMO      128
#define XB_XCNT(j)  (256  + 64 * (j))
#define XB_XSUB(j)  (1280 + 64 * (j))
#define XB_XGEN(j)  (2304 + 64 * (j))
#define XB_TOP      3328
#define XB_TOPGEN   3392
#define XCD_BAR_WORDS 3456
#define XB_SPIN_CAP (1u << 20)
__device__ __forceinline__ unsigned xb_ld(unsigned* p)              { return __hip_atomic_load(p, __ATOMIC_RELAXED, __HIP_MEMORY_SCOPE_AGENT); }
__device__ __forceinline__ unsigned xb_add(unsigned* p, unsigned v) { return __hip_atomic_fetch_add(p, v, __ATOMIC_RELAXED, __HIP_MEMORY_SCOPE_AGENT); }
__device__ __forceinline__ unsigned xb_xcc_id() { return (unsigned)__builtin_amdgcn_s_getreg((3 << 11) | 20) & 0xFu; }
#define XB_SPIN(cond, bar) do { unsigned _sp = 0; while (cond) { __builtin_amdgcn_s_sleep(1); \
    if ((++_sp & 255u) == 0u) { if (xb_ld(&(bar)[XB_TMO])) break; if (_sp > XB_SPIN_CAP) { atomicAdd(&(bar)[XB_TMO], 1u); break; } } } } while (0)
struct XcdBarrier { unsigned* bar; unsigned x; volatile LAS unsigned* st; int wv; };
__device__ __forceinline__ bool xb_thread0(int wv) { return wv == 0 && lane_id_v() == 0; }
__device__ __forceinline__ XcdBarrier xcd_barrier_post(unsigned* bar, volatile LAS unsigned* st, int wv) {
    XcdBarrier b; b.bar = bar; b.x = xb_xcc_id(); b.st = st; b.wv = wv;
    if (xb_thread0(wv)) (void)xb_add(&bar[XB_XCNT(b.x)], 1u);
    return b;
}
__device__ __forceinline__ void xcd_barrier_complete(unsigned* bar, unsigned x, unsigned& nloc, unsigned& nx) {
    const unsigned G = gridDim.x * gridDim.y * gridDim.z;
    unsigned sum, cnt, mine, sp = 0u;
    for (;;) {
        sum = 0u; cnt = 0u; mine = 0u;
#pragma unroll
        for (unsigned j = 0; j < 16; ++j) { const unsigned c = xb_ld(&bar[XB_XCNT(j)]); sum += c; cnt += (c > 0u) ? 1u : 0u; mine = (j == x) ? c : mine; }
        if (sum == G) break;
        __builtin_amdgcn_s_sleep(1);
        if ((++sp & 255u) == 0u) { if (xb_ld(&bar[XB_TMO])) break; if (sp > XB_SPIN_CAP) { atomicAdd(&bar[XB_TMO], 1u); break; } }
    }
    nloc = mine > 0u ? mine : 1u; nx = cnt > 0u ? cnt : 1u;
}
template <bool FIRST> __device__ __forceinline__ void xcd_barrier(const XcdBarrier& b) {
    asm volatile("s_waitcnt vmcnt(0)" ::: "memory");
    __syncthreads();
    if (xb_thread0(b.wv)) {
        unsigned* bar = b.bar;
        __builtin_amdgcn_s_waitcnt(0);
        unsigned nloc = b.st[0], nx = b.st[1];
        if (FIRST) { xcd_barrier_complete(bar, b.x, nloc, nx); b.st[0] = nloc; b.st[1] = nx; }
        const unsigned old = xb_add(&bar[XB_XSUB(b.x)], 1u);
        const unsigned gen = old / nloc;
        if (old + 1u == (gen + 1u) * nloc) {
            __builtin_amdgcn_fence(__ATOMIC_RELEASE, "agent");
            asm volatile("s_waitcnt vmcnt(0)" ::: "memory");
            const unsigned og = xb_add(&bar[XB_TOP], 1u);
            const unsigned tg = og / nx;
            if (og + 1u == (tg + 1u) * nx) xb_add(&bar[XB_TOPGEN], 1u);
            else XB_SPIN(xb_ld(&bar[XB_TOPGEN]) == tg, bar);
            __builtin_amdgcn_fence(__ATOMIC_ACQUIRE, "agent");
            xb_add(&bar[XB_XGEN(b.x)], 1u);
            asm volatile("s_waitcnt vmcnt(0)" ::: "memory");
        } else {
            XB_SPIN(xb_ld(&bar[XB_XGEN(b.x)]) == gen, bar);
            __builtin_amdgcn_fence(__ATOMIC_ACQUIRE, "agent");
            asm volatile("s_waitcnt vmcnt(0)" ::: "memory");
        }
    }
    __syncthreads();
}

struct Args { const float* in[27]; float* out; unsigned char* ws; int ph_lo, ph_hi, qsel, pad; };
struct Ctx { unsigned char* ws; volatile LAS unsigned long long* ptab;
    __device__ __forceinline__ const float* in(int i) const { const unsigned long long v = ptab[i];
        const unsigned lo = __builtin_amdgcn_readfirstlane((unsigned)v), hi = __builtin_amdgcn_readfirstlane((unsigned)(v >> 32)); return (const float*)(((unsigned long long)hi << 32) | lo); } };
enum { I_X = 0, I_POS, I_F1N, I_F1G, I_F1U, I_F1D, I_MIXN, I_WIN, I_CQN, I_CKVN, I_WUQ, I_WUKV, I_QN, I_KN, I_WG2, I_BG2, I_ON, I_DQN, I_DKN, I_WA, I_WB, I_WC, I_WOUT, I_F2N, I_F2G, I_F2U, I_F2D };

__device__ __forceinline__ int win_map(int n) {
    if (n < 768) return n;
    if (n < 1024) return 832 + (n - 768);
    if (n < 1280) return 1088 + (n - 1024);
    if (n < 1792) return 1344 + (n - 1280);
    if (n < 2560) return 2384 + (n - 1792);
    if (n < 3328) return 3152 + (n - 2560);
    if (n < 4096) return 3920 + (n - 3328);
    if (n < 4160) return 768 + (n - 4096);
    if (n < 4176) return 1856 + (n - 4160);
    if (n < 4352) return -1;
    if (n < 4864) return 1872 + (n - 4352);
    return 4688 + (n - 4864);
}
struct WMat { const float* src; const float* src2; const float* gain; bf16_t* dst; int K, Nsrc, Ndst, kind; };
__device__ __forceinline__ void wconv_item(const WMat& w, int item, LAS float* scr, int lane) {
    const int nblk = w.Ndst / 32, kb = item / nblk, nb = item % nblk, k0 = 64 * kb, n0 = 32 * nb;
    const int cq = lane & 7, kr = lane >> 3, nn = n0 + 4 * cq;
    const float* sp = w.src; int scol = nn; bool valid = true;
    if (w.kind == 1) { const int tile = nn >> 8; int wi = nn & 255; if (wi >= 128) { sp = w.src2; wi -= 128; } scol = tile * 128 + wi; }
    else if (w.kind == 2) { scol = win_map(nn); valid = scol >= 0; }
    else valid = nn < w.Nsrc;
    if (!valid) scol = 0;
    f32x4 v[8]; float g[8];
#pragma unroll
    for (int i = 0; i < 8; ++i) { const int kk = 8 * i + kr; v[i] = *(const f32x4*)(sp + (size_t)(k0 + kk) * w.Nsrc + scol); g[i] = w.gain ? w.gain[k0 + kk] : 1.f; }
#pragma unroll
    for (int i = 0; i < 8; ++i) { const int kk = 8 * i + kr; LAS float* d = scr + kk * 33 + 4 * cq; const float gg = valid ? g[i] : 0.f;
        d[0] = v[i][0] * gg; d[1] = v[i][1] * gg; d[2] = v[i][2] * gg; d[3] = v[i][3] * gg; }
    LDS_WAIT(); asm volatile("" ::: "memory");
    const int c = lane & 7;
#pragma unroll
    for (int j = 0; j < 4; ++j) { const int n = (lane >> 3) + 8 * j; const LAS float* s = scr + (8 * c) * 33 + n;
        u32x4 o; o.x = pk2(s[0 * 33], s[1 * 33]); o.y = pk2(s[2 * 33], s[3 * 33]); o.z = pk2(s[4 * 33], s[5 * 33]); o.w = pk2(s[6 * 33], s[7 * 33]);
        *(u32x4*)(w.dst + (size_t)(n0 + n) * w.K + k0 + 8 * c) = o; }
    LDS_WAIT(); asm volatile("" ::: "memory");
}
constexpr int wc_items(int K, int Ndst) { return (K / 64) * (Ndst / 32); }
constexpr int WI_GU = wc_items(DM, NGU), WI_D = wc_items(FF, DM), WI_IN = wc_items(DM, NIN), WI_UQ = wc_items(512, 1280), WI_UKV = wc_items(256, 1536),
              WI_A = wc_items(768, DM), WI_B = wc_items(512, DM), WI_C = wc_items(256, DM), WI_OUT = wc_items(DM, DM);
constexpr int WI_TOTAL = 2 * WI_GU + 2 * WI_D + WI_IN + WI_UQ + WI_UKV + WI_A + WI_B + WI_C + WI_OUT;

__device__ __forceinline__ void phase_wconv(const Ctx& a, int l, LAS unsigned char* lds, int gw, int NGW, int wave, int lane) {
    LAS float* scr = (LAS float*)(lds + wave * 16384);
    bf16_t* W = (bf16_t*)(a.ws + WS_W);
    const size_t oFF = (size_t)l * DM * FF;
    for (int it = gw; it < WI_TOTAL; it += NGW) {
        int r = it; WMat w;
        if (r < WI_GU) { w = WMat{a.in(I_F1G) + oFF, a.in(I_F1U) + oFF, a.in(I_F1N) + (size_t)l * DM, W + W_GU1, DM, FF, NGU, 1}; }
        else if ((r -= WI_GU) < WI_GU) { w = WMat{a.in(I_F2G) + oFF, a.in(I_F2U) + oFF, a.in(I_F2N) + (size_t)l * DM, W + W_GU2, DM, FF, NGU, 1}; }
        else if ((r -= WI_GU) < WI_IN) { w = WMat{a.in(I_WIN) + (size_t)l * DM * 10832, nullptr, a.in(I_MIXN) + (size_t)l * DM, W + W_IN, DM, 10832, NIN, 2}; }
        else if ((r -= WI_IN) < WI_D) { w = WMat{a.in(I_F1D) + oFF, nullptr, nullptr, W + W_D1, FF, DM, DM, 0}; }
        else if ((r -= WI_D) < WI_D) { w = WMat{a.in(I_F2D) + oFF, nullptr, nullptr, W + W_D2, FF, DM, DM, 0}; }
        else if ((r -= WI_D) < WI_OUT) { w = WMat{a.in(I_WOUT) + (size_t)l * DM * DM, nullptr, nullptr, W + W_OUT, DM, DM, DM, 0}; }
        else if ((r -= WI_OUT) < WI_A) { w = WMat{a.in(I_WA) + (size_t)l * 768 * DM, nullptr, nullptr, W + W_A, 768, DM, DM, 0}; }
        else if ((r -= WI_A) < WI_B) { w = WMat{a.in(I_WB) + (size_t)l * 512 * DM, nullptr, nullptr, W + W_B, 512, DM, DM, 0}; }
        else if ((r -= WI_B) < WI_C) { w = WMat{a.in(I_WC) + (size_t)l * 256 * DM, nullptr, nullptr, W + W_C, 256, DM, DM, 0}; }
        else if ((r -= WI_C) < WI_UQ) { w = WMat{a.in(I_WUQ) + (size_t)l * 512 * 1152, nullptr, a.in(I_CQN) + (size_t)l * 512, W + W_UQ, 512, 1152, 1280, 0}; }
        else { r -= WI_UQ; w = WMat{a.in(I_WUKV) + (size_t)l * 256 * 1536, nullptr, a.in(I_CKVN) + (size_t)l * 256, W + W_UKV, 256, 1536, 1536, 0}; }
        wconv_item(w, r, scr, lane);
    }
}

__device__ __forceinline__ void phase_prologue(const Ctx& a, int gw, int NGW, int lane) {
    const int* pos = (const int*)a.in(I_POS);
    float* ropec = (float*)(a.ws + WS_ROPE); float* ropes = ropec + (size_t)MTOK * 32;
    const int i = lane & 31; const float invf = exp2f(-(float)i * 0.41524101186092029f);
    for (int p = gw; p < MTOK / 2; p += NGW) { const int tok = 2 * p + (lane >> 5); const float ang = (float)pos[tok] * invf; float sn, cs; sincosf(ang, &sn, &cs);
        ropec[(size_t)tok * 32 + i] = cs; ropes[(size_t)tok * 32 + i] = sn; }
    const float* x = a.in(I_X); bf16_t* xb = (bf16_t*)(a.ws + WS_XB); float* ssq = (float*)(a.ws + WS_SSQ);
    for (int m = gw; m < MTOK; m += NGW) { const f32x4* xr = (const f32x4*)(x + (size_t)m * DM) + lane; u32x2* o8 = (u32x2*)(xb + (size_t)m * DM) + lane; float s = 0.f;
#pragma unroll
        for (int j = 0; j < 8; ++j) { const f32x4 v = xr[64 * j]; s += (v[0] * v[0] + v[1] * v[1]) + (v[2] * v[2] + v[3] * v[3]); u32x2 w; w.x = pk2(v[0], v[1]); w.y = pk2(v[2], v[3]); o8[64 * j] = w; }
        s += __shfl_xor(s, 1); if ((lane & 1) == 0) ssq[(size_t)m * 32 + (lane >> 1)] = s; }
}

template <int CTRL> __device__ __forceinline__ float dppf(float x) { return __builtin_bit_cast(float, __builtin_amdgcn_mov_dpp(__builtin_bit_cast(int, x), CTRL, 0xf, 0xf, true)); }
__device__ __forceinline__ float row16_sum(float x) { x += dppf<0xB1>(x); x += dppf<0x4E>(x); x += dppf<0x141>(x); x += dppf<0x128>(x); return x; }
__device__ __forceinline__ void unpk4(const u32x2 w, float (&f)[4]) { f[0] = __uint_as_float(w.x << 16); f[1] = __uint_as_float(w.x & 0xffff0000u); f[2] = __uint_as_float(w.y << 16); f[3] = __uint_as_float(w.y & 0xffff0000u); }
__device__ __forceinline__ void unpk8(const u32x4 w, float (&f)[8]) { f[0] = __uint_as_float(w.x << 16); f[1] = __uint_as_float(w.x & 0xffff0000u); f[2] = __uint_as_float(w.y << 16); f[3] = __uint_as_float(w.y & 0xffff0000u);
    f[4] = __uint_as_float(w.z << 16); f[5] = __uint_as_float(w.z & 0xffff0000u); f[6] = __uint_as_float(w.w << 16); f[7] = __uint_as_float(w.w & 0xffff0000u); }
__device__ __forceinline__ float ssq8(const u32x4 w) { float f[8]; unpk8(w, f); return ((f[0] * f[0] + f[1] * f[1]) + (f[2] * f[2] + f[3] * f[3])) + ((f[4] * f[4] + f[5] * f[5]) + (f[6] * f[6] + f[7] * f[7])); }
__device__ __forceinline__ void rope4(float (&x)[4], const f32x4 cs, const f32x4 sn, bool first) {
#pragma unroll
    for (int e = 0; e < 4; ++e) { const float xp = dppf<0x128>(x[e]); x[e] = first ? x[e] * cs[e] - xp * sn[e] : xp * sn[e] + x[e] * cs[e]; }
}
__device__ __forceinline__ void phase_prep(const Ctx& a, int l, int gw, int NGW, int lane, bool do_dswa) {
    bf16_t* u1 = (bf16_t*)(a.ws + WS_R2);
    const bf16_t* qraw = (const bf16_t*)(a.ws + WS_R3 + R3_QRAW); const bf16_t* kvraw = (const bf16_t*)(a.ws + WS_R3 + R3_KVRAW);
    const float* ropec = (const float*)(a.ws + WS_ROPE); const float* ropes = ropec + (size_t)MTOK * 32;
    bf16_t* Qo = (bf16_t*)(a.ws + WS_QKV + QKV_Q); bf16_t* Ko = (bf16_t*)(a.ws + WS_QKV + QKV_K); bf16_t* Vo = (bf16_t*)(a.ws + WS_QKV + QKV_V);
    const int t = lane & 15, g4 = lane >> 4; const bool first = t < 8;
    const float* gq = a.in(I_QN) + (size_t)l * 192; const float* gk = a.in(I_KN) + (size_t)l * 192;
    const f32x4 gq0 = *(const f32x4*)(gq + 4 * t), gq1 = *(const f32x4*)(gq + 64 + 4 * t), gq2 = *(const f32x4*)(gq + 128 + 4 * t);
    const f32x4 gka = *(const f32x4*)(gk + 8 * t), gkb = *(const f32x4*)(gk + 8 * t + 4), gkr = *(const f32x4*)(gk + 128 + 4 * t);
    const float* dq = a.in(I_DQN) + (size_t)l * 128; const float* dk = a.in(I_DKN) + (size_t)l * 128;
    const f32x4 dqa = *(const f32x4*)(dq + 8 * t), dqb = *(const f32x4*)(dq + 8 * t + 4), dka = *(const f32x4*)(dk + 8 * t), dkb = *(const f32x4*)(dk + 8 * t + 4);
    for (int qd = gw; qd < MTOK / 4; qd += NGW) {
        const int row = 4 * qd + g4; bf16_t* ur = u1 + (size_t)row * U1W; const int b = row / SEQ, s = row % SEQ;
        float q = 0.f;
#pragma unroll
        for (int j = 0; j < 4; ++j) q += ssq8(*(const u32x4*)(ur + C_CQ + 8 * t + 128 * j));
        const float rstd_cq = rsqrtf(row16_sum(q) * (1.f / 512.f) + EPS);
        q = ssq8(*(const u32x4*)(ur + C_CKV + 8 * t)) + ssq8(*(const u32x4*)(ur + C_CKV + 128 + 8 * t));
        const float rstd_ckv = rsqrtf(row16_sum(q) * (1.f / 256.f) + EPS);
        float kr[4]; unpk4(*(const u32x2*)(ur + C_KROPE + 4 * t), kr);
        const float ssq_kr = row16_sum((kr[0] * kr[0] + kr[1] * kr[1]) + (kr[2] * kr[2] + kr[3] * kr[3]));
        const f32x4 cs = *(const f32x4*)(ropec + (size_t)row * 32 + 4 * (t & 7)), sn = *(const f32x4*)(ropes + (size_t)row * 32 + 4 * (t & 7));
#pragma unroll 2
        for (int h = 0; h < 6; ++h) {
            const bf16_t* qp = qraw + (size_t)row * QRAW_LD + h * 192 + 4 * t;
            float x0[4], x1[4], x2[4]; unpk4(*(const u32x2*)qp, x0); unpk4(*(const u32x2*)(qp + 64), x1); unpk4(*(const u32x2*)(qp + 128), x2);
            float ss = 0.f;
#pragma unroll
            for (int e = 0; e < 4; ++e) { x0[e] *= rstd_cq; x1[e] *= rstd_cq; x2[e] *= rstd_cq; ss += x0[e] * x0[e] + x1[e] * x1[e] + x2[e] * x2[e]; }
            const float rq = rsqrtf(row16_sum(ss) * (1.f / 192.f) + EPS);
#pragma unroll
            for (int e = 0; e < 4; ++e) { x0[e] *= rq * gq0[e]; x1[e] *= rq * gq1[e]; x2[e] *= rq * gq2[e]; }
            rope4(x2, cs, sn, first);
            bf16_t* qo = Qo + ((size_t)((b * 6 + h) * SEQ + s)) * 192 + 4 * t;
            { u32x2 w; w.x = pk2(x0[0] * QS_MLA, x0[1] * QS_MLA); w.y = pk2(x0[2] * QS_MLA, x0[3] * QS_MLA); *(u32x2*)qo = w;
              w.x = pk2(x1[0] * QS_MLA, x1[1] * QS_MLA); w.y = pk2(x1[2] * QS_MLA, x1[3] * QS_MLA); *(u32x2*)(qo + 64) = w;
              w.x = pk2(x2[0] * QS_MLA, x2[1] * QS_MLA); w.y = pk2(x2[2] * QS_MLA, x2[3] * QS_MLA); *(u32x2*)(qo + 128) = w; }
            const bf16_t* kp = kvraw + (size_t)row * KVRAW_LD + h * 256 + 8 * t;
            float kn[8], vv[8]; unpk8(*(const u32x4*)kp, kn); unpk8(*(const u32x4*)(kp + 128), vv);
            ss = 0.f;
#pragma unroll
            for (int e = 0; e < 8; ++e) { kn[e] *= rstd_ckv; vv[e] *= rstd_ckv; ss += kn[e] * kn[e]; }
            const float rk = rsqrtf((row16_sum(ss) + ssq_kr) * (1.f / 192.f) + EPS);
            float kx[4];
#pragma unroll
            for (int e = 0; e < 4; ++e) { kn[e] *= rk * gka[e]; kn[4 + e] *= rk * gkb[e]; kx[e] = kr[e] * rk * gkr[e]; }
            rope4(kx, cs, sn, first);
            bf16_t* ko = Ko + ((size_t)((b * 6 + h) * SEQ + s)) * 192;
            { u32x4 w; w.x = pk2(kn[0], kn[1]); w.y = pk2(kn[2], kn[3]); w.z = pk2(kn[4], kn[5]); w.w = pk2(kn[6], kn[7]); *(u32x4*)(ko + 8 * t) = w;
              u32x2 w2; w2.x = pk2(kx[0], kx[1]); w2.y = pk2(kx[2], kx[3]); *(u32x2*)(ko + 128 + 4 * t) = w2;
              w.x = pk2(vv[0], vv[1]); w.y = pk2(vv[2], vv[3]); w.z = pk2(vv[4], vv[5]); w.w = pk2(vv[6], vv[7]);
              *(u32x4*)(Vo + ((size_t)((b * 6 + h) * SEQ + s)) * 128 + 8 * t) = w; }
        }
        if (do_dswa)
#pragma unroll 2
        for (int h = 0; h < 6; ++h) {
            u32x4* qp = (u32x4*)(ur + C_QC + h * 128 + 8 * t); u32x4* kp = (u32x4*)(ur + C_KC + h * 128 + 8 * t);
            float qv[8], kv[8]; unpk8(*qp, qv); unpk8(*kp, kv);
            float sq = 0.f, sk = 0.f;
#pragma unroll
            for (int e = 0; e < 8; ++e) { sq += qv[e] * qv[e]; sk += kv[e] * kv[e]; }
            const float rq = rsqrtf(row16_sum(sq) * (1.f / 128.f) + EPS) * QS_DSWA, rk = rsqrtf(row16_sum(sk) * (1.f / 128.f) + EPS);
            u32x4 w; w.x = pk2(qv[0] * rq * dqa[0], qv[1] * rq * dqa[1]); w.y = pk2(qv[2] * rq * dqa[2], qv[3] * rq * dqa[3]); w.z = pk2(qv[4] * rq * dqb[0], qv[5] * rq * dqb[1]); w.w = pk2(qv[6] * rq * dqb[2], qv[7] * rq * dqb[3]); *qp = w;
            w.x = pk2(kv[0] * rk * dka[0], kv[1] * rk * dka[1]); w.y = pk2(kv[2] * rk * dka[2], kv[3] * rk * dka[3]); w.z = pk2(kv[4] * rk * dkb[0], kv[5] * rk * dkb[1]); w.w = pk2(kv[6] * rk * dkb[2], kv[7] * rk * dkb[3]); *kp = w;
        }
    }
}

__device__ __forceinline__ float logsigmoidf_(float z) { return fminf(z, 0.f) - log1pf(expf(-fabsf(z))); }
__device__ __forceinline__ int crow32(int r, int hi) { return (r & 3) + 8 * (r >> 2) + 4 * hi; }
__device__ __forceinline__ void gla_local(const Ctx& a, int l, LAS unsigned char* lds, int G, int bid, const int wv) {
    int tid_ = wv * 64 + lane_id_v(); asm volatile("" : "+v"(tid_));
    const int tid = tid_, wid = __builtin_amdgcn_readfirstlane(tid >> 6), lane = tid & 63, l32 = lane & 31, hi = lane >> 5;
    LAS float* kd = (LAS float*)lds; LAS float* vv = (LAS float*)(lds + 16640); LAS float* tot = (LAS float*)(lds + 16640 + 32768);
    const bf16_t* u1 = (const bf16_t*)(a.ws + WS_R2);
    float* dS = (float*)(a.ws + WS_GLA + GLA_DS); float* bcum = (float*)(a.ws + WS_GLA + GLA_BC); float* dec = (float*)(a.ws + WS_GLA + GLA_DEC);
    const float* w2 = a.in(I_WG2) + (size_t)l * 16 * 256; const float* b2 = a.in(I_BG2) + (size_t)l * 256;
    const int d = lane, tg = wid;
    for (int ci = bid; ci < 2048; ci += G) {
        const int bh = ci >> 8, c = ci & 255, b = bh >> 2, h = bh & 3, row0 = b * SEQ + 64 * c;
        float w2c[16];
#pragma unroll
        for (int j = 0; j < 16; ++j) w2c[j] = w2[j * 256 + h * 64 + d];
        const float bias = b2[h * 64 + d];
        float bcv[8]; float run = 0.f;
#pragma unroll
        for (int i = 0; i < 8; ++i) { const int t = tg * 8 + i; const bf16_t* gl = u1 + (size_t)(row0 + t) * U1W + C_GLR;
            const bf16x8 g0 = *(const bf16x8*)gl, g1 = *(const bf16x8*)(gl + 8); float z = bias;
#pragma unroll
            for (int j = 0; j < 8; ++j) { z += bf2f((bf16_t)g0[j]) * w2c[j]; z += bf2f((bf16_t)g1[j]) * w2c[8 + j]; }
            run += logsigmoidf_(z) * (1.f / 16.f); bcv[i] = run; }
        tot[tg * 64 + d] = run;
        { const int t = tid >> 3, c0 = (tid & 7) * 16; const bf16_t* vp = u1 + (size_t)(row0 + t) * U1W + C_VB + h * 128 + c0;
          const bf16x8 v0 = *(const bf16x8*)vp, v1 = *(const bf16x8*)(vp + 8);
#pragma unroll
          for (int j = 0; j < 8; ++j) { vv[t * 128 + c0 + j] = bf2f((bf16_t)v0[j]); vv[t * 128 + c0 + 8 + j] = bf2f((bf16_t)v1[j]); } }
        __syncthreads();
        float off = 0.f, bend = 0.f;
#pragma unroll
        for (int g = 0; g < 8; ++g) { const float x = tot[g * 64 + d]; bend += x; if (g < tg) off += x; }
#pragma unroll
        for (int i = 0; i < 8; ++i) { const int t = tg * 8 + i; const float bc = bcv[i] + off;
            bcum[(size_t)(row0 + t) * 256 + h * 64 + d] = bc;
            const float kk = bf2f(u1[(size_t)(row0 + t) * U1W + C_KB + h * 64 + d]);
            kd[t * 65 + d] = kk * expf(bend - bc); }
        if (tg == 0) dec[(size_t)ci * 64 + d] = expf(bend);
        __syncthreads();
        { const int di = wid >> 2, ei = wid & 3; f32x16 acc = {};
#pragma unroll 8
          for (int s0 = 0; s0 < 64; s0 += 2) { const float av = kd[(s0 + hi) * 65 + 32 * di + l32], bv = vv[(s0 + hi) * 128 + 32 * ei + l32];
              acc = __builtin_amdgcn_mfma_f32_32x32x2f32(av, bv, acc, 0, 0, 0); }
          float* dst = dS + (size_t)ci * 8192;
#pragma unroll
          for (int r = 0; r < 16; ++r) dst[(32 * di + crow32(r, hi)) * 128 + 32 * ei + l32] = acc[r]; }
        __syncthreads();
    }
}
__device__ __forceinline__ void gla_scan(const Ctx& a, int bid, const int wv) {
    float* dS = (float*)(a.ws + WS_GLA + GLA_DS); const float* dec = (const float*)(a.ws + WS_GLA + GLA_DEC);
    int tid_ = wv * 64 + lane_id_v(); asm volatile("" : "+v"(tid_));
    const int gid = bid * NTHR + tid_, bh = gid >> 13, de = gid & 8191, d = de >> 7;
    float st = 0.f; float* p = dS + (size_t)bh * 256 * 8192 + de; const float* dc = dec + (size_t)bh * 256 * 64 + d;
    for (int c = 0; c < 256; c += 8) { float x[8], g[8];
#pragma unroll
        for (int i = 0; i < 8; ++i) { x[i] = p[(size_t)(c + i) * 8192]; g[i] = dc[(c + i) * 64]; }
#pragma unroll
        for (int i = 0; i < 8; ++i) { p[(size_t)(c + i) * 8192] = st; st = g[i] * st + x[i]; } }
}
__device__ __forceinline__ void gla_out(const Ctx& a, int l, LAS unsigned char* lds, int G, int bid, const int wv) {
    int tid_ = wv * 64 + lane_id_v(); asm volatile("" : "+v"(tid_));
    const int tid = tid_, wid = __builtin_amdgcn_readfirstlane(tid >> 6), lane = tid & 63, l32 = lane & 31, hi = lane >> 5;
    LAS float* qe = (LAS float*)lds; LAS float* ke = (LAS float*)(lds + 16640); LAS float* At = (LAS float*)(lds + 33280);
    LAS float* vv = (LAS float*)(lds + 49920); LAS float* Sp = (LAS float*)(lds + 82688);
    const bf16_t* u1 = (const bf16_t*)(a.ws + WS_R2);
    const float* dS = (const float*)(a.ws + WS_GLA + GLA_DS); const float* bcum = (const float*)(a.ws + WS_GLA + GLA_BC);
    bf16_t* yb = (bf16_t*)(a.ws + WS_R3 + R3_YB); const float* go = a.in(I_ON) + (size_t)l * 128;
    for (int ci = bid; ci < 2048; ci += G) {
        const int bh = ci >> 8, c = ci & 255, b = bh >> 2, h = bh & 3, row0 = b * SEQ + 64 * c;
        { const int d = lane, tg = wid;
#pragma unroll
          for (int i = 0; i < 8; ++i) { const int t = tg * 8 + i; const float bc = bcum[(size_t)(row0 + t) * 256 + h * 64 + d];
              const float q = bf2f(u1[(size_t)(row0 + t) * U1W + C_QB + h * 64 + d]), k = bf2f(u1[(size_t)(row0 + t) * U1W + C_KB + h * 64 + d]);
              qe[t * 65 + d] = q * 0.125f * expf(bc); ke[t * 65 + d] = k * expf(-bc); } }
        { const int t = tid >> 3, c0 = (tid & 7) * 16; const bf16_t* vp = u1 + (size_t)(row0 + t) * U1W + C_VB + h * 128 + c0;
          const bf16x8 v0 = *(const bf16x8*)vp, v1 = *(const bf16x8*)(vp + 8);
#pragma unroll
          for (int j = 0; j < 8; ++j) { vv[t * 128 + c0 + j] = bf2f((bf16_t)v0[j]); vv[t * 128 + c0 + 8 + j] = bf2f((bf16_t)v1[j]); }
          const f32x4* sp = (const f32x4*)(dS + (size_t)ci * 8192) + tid * 4;
#pragma unroll
          for (int j = 0; j < 4; ++j) *(LAS f32x4*)(Sp + tid * 16 + j * 4) = sp[j]; }
        __syncthreads();
        if (wid < 4) {
            if (wid < 3) { const int ti = wid == 0 ? 0 : 1, si = wid == 2 ? 1 : 0; f32x16 acc = {};
#pragma unroll 8
                for (int d0 = 0; d0 < 64; d0 += 2) { const float av = qe[(32 * ti + l32) * 65 + d0 + hi], bv = ke[(32 * si + l32) * 65 + d0 + hi];
                    acc = __builtin_amdgcn_mfma_f32_32x32x2f32(av, bv, acc, 0, 0, 0); }
#pragma unroll
                for (int r = 0; r < 16; ++r) { const int t = 32 * ti + crow32(r, hi), s = 32 * si + l32; At[t * 65 + s] = (s <= t) ? acc[r] : 0.f; } }
            else {
#pragma unroll
                for (int r = 0; r < 16; ++r) At[crow32(r, hi) * 65 + 32 + l32] = 0.f; }
        }
        __syncthreads();
        f32x16 acc = {}; const int ti = wid >> 2, ei = wid & 3;
#pragma unroll 8
        for (int s0 = 0; s0 < 64; s0 += 2) { const float av = At[(32 * ti + l32) * 65 + s0 + hi], bv = vv[(s0 + hi) * 128 + 32 * ei + l32];
            acc = __builtin_amdgcn_mfma_f32_32x32x2f32(av, bv, acc, 0, 0, 0); }
#pragma unroll 8
        for (int d0 = 0; d0 < 64; d0 += 2) { const float av = qe[(32 * ti + l32) * 65 + d0 + hi], bv = Sp[(d0 + hi) * 128 + 32 * ei + l32];
            acc = __builtin_amdgcn_mfma_f32_32x32x2f32(av, bv, acc, 0, 0, 0); }
        __syncthreads();
#pragma unroll
        for (int r = 0; r < 16; ++r) Sp[(32 * ti + crow32(r, hi)) * 128 + 32 * ei + l32] = acc[r];
        __syncthreads();
        { const int t = tid >> 3, e0 = (tid & 7) * 16; float ov[16]; float ss = 0.f;
#pragma unroll
          for (int j = 0; j < 4; ++j) { const f32x4 x = *(const LAS f32x4*)(Sp + t * 128 + e0 + 4 * j); ov[4 * j] = x[0]; ov[4 * j + 1] = x[1]; ov[4 * j + 2] = x[2]; ov[4 * j + 3] = x[3];
              ss += (x[0] * x[0] + x[1] * x[1]) + (x[2] * x[2] + x[3] * x[3]); }
          ss += __shfl_xor(ss, 1); ss += __shfl_xor(ss, 2); ss += __shfl_xor(ss, 4);
          const float rs = rsqrtf(ss * (1.f / 128.f) + EPS);
          const bf16_t* rp = u1 + (size_t)(row0 + t) * U1W + C_RB + h * 128 + e0; const bf16x8 r0 = *(const bf16x8*)rp, r1 = *(const bf16x8*)(rp + 8);
          unsigned w[8];
#pragma unroll
          for (int j = 0; j < 4; ++j) { w[j] = pk2(ov[2 * j] * rs * go[e0 + 2 * j] * bf2f((bf16_t)r0[2 * j]), ov[2 * j + 1] * rs * go[e0 + 2 * j + 1] * bf2f((bf16_t)r0[2 * j + 1]));
              w[4 + j] = pk2(ov[8 + 2 * j] * rs * go[e0 + 8 + 2 * j] * bf2f((bf16_t)r1[2 * j]), ov[8 + 2 * j + 1] * rs * go[e0 + 8 + 2 * j + 1] * bf2f((bf16_t)r1[2 * j + 1])); }
          u32x4* yo = (u32x4*)(yb + (size_t)(row0 + t) * 512 + h * 128 + e0);
          yo[0] = (u32x4){w[0], w[1], w[2], w[3]}; yo[1] = (u32x4){w[4], w[5], w[6], w[7]}; }
        __syncthreads();
    }
}
__device__ __forceinline__ void dswa_combine(const Ctx& a, int gw, int NGW, int lane) {
    const bf16_t* dout = (const bf16_t*)(a.ws + WS_R3 + R3_DO); const float* lse = (const float*)(a.ws + WS_R3 + R3_LSE); bf16_t* yc = (bf16_t*)(a.ws + WS_R3 + R3_YC);
    const int hp = lane >> 5, e = 4 * (lane & 31);
    for (int row = gw; row < MTOK; row += NGW) {
        const float l0 = lse[(size_t)row * 6 + hp], l1 = lse[(size_t)row * 6 + 2 + hp], l2 = lse[(size_t)row * 6 + 4 + hp];
        const float mx = fmaxf(l0, fmaxf(l1, l2)); float w0 = expf(l0 - mx), w1 = expf(l1 - mx), w2 = expf(l2 - mx); const float inv = 1.f / (w0 + w1 + w2); w0 *= inv; w1 *= inv; w2 *= inv;
        const u32x2 a0 = *(const u32x2*)(dout + (size_t)row * 768 + hp * 128 + e), a1 = *(const u32x2*)(dout + (size_t)row * 768 + (2 + hp) * 128 + e), a2 = *(const u32x2*)(dout + (size_t)row * 768 + (4 + hp) * 128 + e);
        float o[4];
        o[0] = w0 * __uint_as_float(a0.x << 16) + w1 * __uint_as_float(a1.x << 16) + w2 * __uint_as_float(a2.x << 16);
        o[1] = w0 * __uint_as_float(a0.x & 0xffff0000u) + w1 * __uint_as_float(a1.x & 0xffff0000u) + w2 * __uint_as_float(a2.x & 0xffff0000u);
        o[2] = w0 * __uint_as_float(a0.y << 16) + w1 * __uint_as_float(a1.y << 16) + w2 * __uint_as_float(a2.y << 16);
        o[3] = w0 * __uint_as_float(a0.y & 0xffff0000u) + w1 * __uint_as_float(a1.y & 0xffff0000u) + w2 * __uint_as_float(a2.y & 0xffff0000u);
        u32x2 w; w.x = pk2(o[0], o[1]); w.y = pk2(o[2], o[3]); *(u32x2*)(yc + (size_t)row * 256 + hp * 128 + e) = w;
    }
}

constexpr int N_Q_MLA = 96, N_Q_UNITS = 192;
__device__ __forceinline__ void phase_attention(const Ctx& a, int l, LAS unsigned char* lds, volatile LAS unsigned* qword, const int wv, const int qsel) {
    const int tid0 = wv * 64 + lane_id_v();
    const bf16_t* u1 = (const bf16_t*)(a.ws + WS_R2);
    const int xcc = (int)(xb_xcc_id() & 7u);
    for (int qi = 0; qi < 8; ++qi) {
        const int x = (xcc + qi) & 7, j = x >> 1, odd = x & 1;
        unsigned* head = (unsigned*)(a.ws + WS_CTL) + CW_QUEUE + 64 * (8 * l + x) + 4096 * qsel;
        for (;;) {
            if (tid0 == 0) *qword = __hip_atomic_fetch_add(head, 1u, __ATOMIC_RELAXED, __HIP_MEMORY_SCOPE_AGENT);
            __syncthreads();
            const int p = (int)__builtin_amdgcn_readfirstlane(*qword);
            __syncthreads();
            if (p >= N_Q_UNITS) break;
            att::AUnit u;
            if (p < N_Q_MLA) {
                const int k = p / 3, r = p % 3;
                const int bh = r == 1 ? 3 * j + 1 : 3 * j + 2 * odd, qb = r == 0 ? 63 - 2 * k : (r == 1 ? 62 - 2 * k + odd : 62 - 2 * k), b = bh / 6, h = bh % 6;
                u.Q = (const bf16_t*)(a.ws + WS_QKV + QKV_Q) + ((size_t)bh * SEQ + 256 * qb) * 192; u.qpitch = 192;
                u.K = (const bf16_t*)(a.ws + WS_QKV + QKV_K) + (size_t)bh * SEQ * 192; u.kpitch = 192;
                u.V = (const bf16_t*)(a.ws + WS_QKV + QKV_V) + (size_t)bh * SEQ * 128; u.vpitch = 128;
                u.O = (bf16_t*)(a.ws + WS_R3 + R3_YA) + ((size_t)(b * SEQ + 256 * qb)) * 768 + h * 128; u.opitch = 768;
                u.lse = nullptr; u.lsepitch = 0; u.q0 = 256 * qb; u.j_lo = 0; u.j_hi = 4 * qb + 4; u.bias_c = 0.f;
                att::attn_unit<192, 0>(lds, u, wv);
            } else {
                const int v = x * 96 + (p - N_Q_MLA), b = v / 384, hh = (v / 64) % 6, idx = v % 64, g = hh >> 1, dil = g == 0 ? 1 : (g == 1 ? 4 : 16), nb = 64 / dil, r = idx / nb, qb = idx % nb;
                const size_t tok0 = (size_t)b * SEQ + r;
                u.Q = u1 + (tok0 + (size_t)256 * qb * dil) * U1W + C_QC + hh * 128; u.qpitch = (size_t)dil * U1W;
                u.K = u1 + tok0 * U1W + C_KC + hh * 128; u.kpitch = (size_t)dil * U1W;
                u.V = u1 + tok0 * U1W + C_VC + hh * 128; u.vpitch = (size_t)dil * U1W;
                u.O = (bf16_t*)(a.ws + WS_R3 + R3_DO) + (tok0 + (size_t)256 * qb * dil) * 768 + hh * 128; u.opitch = (size_t)dil * 768;
                u.lse = (float*)(a.ws + WS_R3 + R3_LSE) + (tok0 + (size_t)256 * qb * dil) * 6 + hh; u.lsepitch = (size_t)dil * 6;
                u.q0 = 256 * qb; u.j_lo = 4 * qb - 2 > 0 ? 4 * qb - 2 : 0; u.j_hi = 4 * qb + 4;
                u.bias_c = exp2f(-8.f * (float)(hh + 1) / 6.f) * (float)dil * LOG2E;
                att::attn_unit<128, 1>(lds, u, wv);
            }
        }
    }
    __syncthreads();
}

constexpr int NPL = 12, NPH = 1 + NPL * DEPTH;
__global__ void __launch_bounds__(NTHR, 2) hybrid_fwd(Args args) {
    extern __shared__ __attribute__((aligned(16))) unsigned char lds_raw[];
    LAS unsigned char* lds = (LAS unsigned char*)lds_raw;
    const int tid = threadIdx.x;
    const int wv = __builtin_amdgcn_readfirstlane(tid >> 6);
    const int G = gridDim.x, bid = blockIdx.x, NGW = G * NWAVES;
#define LAUNDER() int tz_ = lane_id_v(); asm volatile("" : "+v"(tz_)); const int lane = tz_, wave = wv, gw = bid * NWAVES + wave
    volatile LAS unsigned* lctl = (volatile LAS unsigned*)(lds + LDSCTL_OFF);
    for (int u = tid; u < (LDS_BYTES - LDSCTL_OFF) / 4; u += NTHR) lctl[u] = 0u;
    __syncthreads();
    const int lo = args.ph_lo, hi = args.ph_hi;
    unsigned* ctl = (unsigned*)(args.ws + WS_CTL);
    XcdBarrier bar; bar.bar = ctl + CW_BAR; bar.x = 0; bar.st = lctl + 8; bar.wv = wv;
    if (hi - lo > 1) bar = xcd_barrier_post(ctl + CW_BAR, lctl + 8, wv);
#ifndef PH_MASK
#define PH_MASK 0xFFFF
#endif
#define IN(k) (lo <= (k) && (k) < hi)
#define EN(j) ((PH_MASK >> (j)) & 1)
#define DUMMY_OUT(p) (args.qsel ? (float*)(wz + WS_R3) : (p))
#define DUMMY_XB(p) (args.qsel ? (bf16_t*)(wz + WS_QKV) : (p))
#define DUMMY_XB2(p) (args.qsel ? (bf16_t*)(wz + WS_R2) : (p))
#define DUMMY_SSQ(p) (args.qsel ? (float*)(wz + WS_GLA) : (p))
#define SEAM(k) do { if (IN(k) && IN((k) + 1)) xcd_barrier<false>(bar); } while (0)
    unsigned char* ws = args.ws;
    volatile LAS unsigned long long* ptab = (volatile LAS unsigned long long*)(lds + LDSCTL_OFF + 256);
    if (tid < 27) ptab[tid] = (unsigned long long)args.in[tid];
    __syncthreads();
    Ctx cx; cx.ws = ws; cx.ptab = ptab;
    float* xres = args.out;
#define WSP() unsigned char* wz = ws; asm volatile("" : "+s"(wz)); \
    bf16_t* W = (bf16_t*)(wz + WS_W); bf16_t* xb = (bf16_t*)(wz + WS_XB); float* ssq = (float*)(wz + WS_SSQ); bf16_t* h1 = (bf16_t*)(wz + WS_R1); bf16_t* u2 = (bf16_t*)(wz + WS_R1); \
    bf16_t* u1 = (bf16_t*)(wz + WS_R2); float* m32 = (float*)(wz + WS_R2); bf16_t* mb = (bf16_t*)(wz + WS_QKV); bf16_t* qraw = (bf16_t*)(wz + WS_R3 + R3_QRAW); bf16_t* kvraw = (bf16_t*)(wz + WS_R3 + R3_KVRAW); \
    bf16_t* ya = (bf16_t*)(wz + WS_R3 + R3_YA); bf16_t* yb = (bf16_t*)(wz + WS_R3 + R3_YB); bf16_t* yc = (bf16_t*)(wz + WS_R3 + R3_YC); \
    (void)W; (void)xb; (void)ssq; (void)h1; (void)u2; (void)u1; (void)m32; (void)mb; (void)qraw; (void)kvraw; (void)ya; (void)yb; (void)yc

    if (EN(12) && IN(0)) { LAUNDER(); phase_prologue(cx, gw, NGW, lane); phase_wconv(cx, 0, lds, gw, NGW, wave, lane); }
    if (IN(0) && IN(1)) xcd_barrier<true>(bar);
    for (int l = 0; l < DEPTH; ++l) {
        const int pb = 1 + NPL * l;
        if (EN(0) && IN(pb + 0)) { LAUNDER(); if (l > 0) phase_wconv(cx, l, lds, gw, NGW, wave, lane); }
        SEAM(pb + 0);
        if (EN(1) && IN(pb + 1)) { WSP();
            pg8::Gemm g{xb, W + W_GU1, MTOK, NGU, DM, DM}; pg8::StaticOrder S; S.init(MTOK, NGU, G, bid);
            pg8::EpiSwiGLU E{ssq, h1, FF};
            pg8::gemm_phase<pg8::EpiSwiGLU, pg8::StaticOrder, true, true>(lds, g, S, E, wv);
        }
        SEAM(pb + 1);
        if (EN(2) && IN(pb + 2)) { WSP();
            pg8::Gemm g{h1, W + W_D1, MTOK, DM, FF, FF}; pg8::StaticOrder S; S.init(MTOK, DM, G, bid);
            pg8::EpiResid E{l == 0 ? cx.in(I_X) : (const float*)xres, DUMMY_OUT(xres), DUMMY_XB(xb), DUMMY_SSQ(ssq), 0.5f};
            pg8::gemm_phase<pg8::EpiResid, pg8::StaticOrder, true, true>(lds, g, S, E, wv);
        }
        SEAM(pb + 2);
        if (EN(3) && IN(pb + 3)) { WSP();
            pg8::Gemm g{xb, W + W_IN, MTOK, NIN, DM, DM}; pg8::StaticOrder S; S.init(MTOK, NIN, G, bid);
            pg8::EpiWin E{ssq, u1, u2, U1W, U2W};
            pg8::gemm_phase<pg8::EpiWin, pg8::StaticOrder, true, true>(lds, g, S, E, wv);
        }
        SEAM(pb + 3);
        if (EN(4) && IN(pb + 4)) { WSP();
            { pg8::Gemm g{u1 + C_CQ, W + W_UQ, MTOK, 1280, 512, U1W}; pg8::StaticOrder S; S.init(MTOK, 1280, G, bid);
              pg8::EpiBf16 E{qraw, QRAW_LD};
              pg8::gemm_phase<pg8::EpiBf16, pg8::StaticOrder, true, true>(lds, g, S, E, wv); }
            { pg8::Gemm g{u1 + C_CKV, W + W_UKV, MTOK, 1536, 256, U1W}; pg8::StaticOrder S; S.init(MTOK, 1536, G, bid);
              pg8::EpiBf16 E{kvraw, KVRAW_LD};
              pg8::gemm_phase<pg8::EpiBf16, pg8::StaticOrder, true, true>(lds, g, S, E, wv); }
        }
        SEAM(pb + 4);
        if (EN(5) && IN(pb + 5)) { LAUNDER(); phase_prep(cx, l, gw, NGW, lane, args.qsel == 0); gla_local(cx, l, lds, G, bid, wv); }
        SEAM(pb + 5);
        if (EN(6) && IN(pb + 6)) { if (bid < 128 && args.qsel == 0) gla_scan(cx, bid, wv); phase_attention(cx, l, lds, lctl + 16, wv, args.qsel); }
        SEAM(pb + 6);
        if (EN(7) && IN(pb + 7)) { LAUNDER(); gla_out(cx, l, lds, G, bid, wv); dswa_combine(cx, gw, NGW, lane); }
        SEAM(pb + 7);
        if (EN(8) && IN(pb + 8)) { WSP();
            { pg8::Gemm g{ya, W + W_A, MTOK, DM, 768, 768}; pg8::StaticOrder S; S.init(MTOK, DM, G, bid);
              pg8::EpiMerge<0> E{u2, U2W, mb};
              pg8::gemm_phase<pg8::EpiMerge<0>, pg8::StaticOrder, true, true>(lds, g, S, E, wv); }
            { pg8::Gemm g{yb, W + W_B, MTOK, DM, 512, 512}; pg8::StaticOrder S; S.init(MTOK, DM, G, bid);
              pg8::EpiMerge<1> E{u2 + 2048, U2W, mb};
              pg8::gemm_phase<pg8::EpiMerge<1>, pg8::StaticOrder, true, true>(lds, g, S, E, wv); }
            { pg8::Gemm g{yc, W + W_C, MTOK, DM, 256, 256}; pg8::StaticOrder S; S.init(MTOK, DM, G, bid);
              pg8::EpiMerge<2> E{u2 + 4096, U2W, mb};
              pg8::gemm_phase<pg8::EpiMerge<2>, pg8::StaticOrder, true, true>(lds, g, S, E, wv); }
        }
        SEAM(pb + 8);
        if (EN(9) && IN(pb + 9)) { WSP();
            pg8::Gemm g{mb, W + W_OUT, MTOK, DM, DM, DM}; pg8::StaticOrder S; S.init(MTOK, DM, G, bid);
            pg8::EpiResid E{xres, DUMMY_OUT(xres), DUMMY_XB2(xb), DUMMY_SSQ(ssq), 1.0f};
            pg8::gemm_phase<pg8::EpiResid, pg8::StaticOrder, true, true>(lds, g, S, E, wv);
        }
        SEAM(pb + 9);
        if (EN(10) && IN(pb + 10)) { WSP();
            pg8::Gemm g{xb, W + W_GU2, MTOK, NGU, DM, DM}; pg8::StaticOrder S; S.init(MTOK, NGU, G, bid);
            pg8::EpiSwiGLU E{ssq, h1, FF};
            pg8::gemm_phase<pg8::EpiSwiGLU, pg8::StaticOrder, true, true>(lds, g, S, E, wv);
        }
        SEAM(pb + 10);
        if (EN(11) && IN(pb + 11)) { WSP();
            pg8::Gemm g{h1, W + W_D2, MTOK, DM, FF, FF}; pg8::StaticOrder S; S.init(MTOK, DM, G, bid);
            pg8::EpiResid E{xres, DUMMY_OUT(xres), DUMMY_XB(xb), DUMMY_SSQ(ssq), 0.5f};
            pg8::gemm_phase<pg8::EpiResid, pg8::StaticOrder, true, true>(lds, g, S, E, wv);
        }
        SEAM(pb + 11);
    }
#undef IN
#undef SEAM
}

extern "C" void kernel_launch(void* const* d_in, const int* in_sizes, int n_in, void* d_out, int out_size, void* d_ws, size_t ws_size, hipStream_t stream) {
    static int grid = 0;
    if (grid == 0) {
        if (n_in != 27 || out_size != MTOK * DM || ws_size < WS_END) { fprintf(stderr, "kernel_launch: unexpected problem: n_in %d out %d ws %zu (need %zu)\n", n_in, out_size, ws_size, (size_t)WS_END); grid = -1; return; }
        int dev = 0, cus = 0, per_cu = 0;
        if (hipGetDevice(&dev) != hipSuccess || hipDeviceGetAttribute(&cus, hipDeviceAttributeMultiprocessorCount, dev) != hipSuccess) { grid = -1; return; }
        if (hipFuncSetAttribute((const void*)hybrid_fwd, hipFuncAttributeMaxDynamicSharedMemorySize, LDS_BYTES) != hipSuccess) { fprintf(stderr, "kernel_launch: hipFuncSetAttribute failed\n"); grid = -1; return; }
        if (hipOccupancyMaxActiveBlocksPerMultiprocessor(&per_cu, (const void*)hybrid_fwd, NTHR, LDS_BYTES) != hipSuccess || per_cu < 1)
            fprintf(stderr, "kernel_launch: occupancy query reports %d workgroups per CU\n", per_cu);
        (void)hipGetLastError();
        grid = cus;
    }
    if (grid < 0) return;
    if (hipMemsetAsync((char*)d_ws + WS_CTL, 0, CTL_BYTES, stream) != hipSuccess) return;
    Args a{};
    for (int i = 0; i < 27; ++i) a.in[i] = (const float*)d_in[i];
    a.out = (float*)d_out; a.ws = (unsigned char*)d_ws;
#if MK_SINGLE
    a.ph_lo = 0; a.ph_hi = NPH;
    hipLaunchKernelGGL(hybrid_fwd, dim3(grid), dim3(NTHR), LDS_BYTES, stream, a);
#else
    for (int p = 0; p < NPH; ++p) { a.ph_lo = p; a.ph_hi = p + 1; a.qsel = 0; hipLaunchKernelGGL(hybrid_fwd, dim3(grid), dim3(NTHR), LDS_BYTES, stream, a);
#ifdef PROBE_DUP
        if (p >= 1 && ((PROBE_DUP >> ((p - 1) % NPL)) & 1)) { a.qsel = 1; hipLaunchKernelGGL(hybrid_fwd, dim3(grid), dim3(NTHR), LDS_BYTES, stream, a); }
#endif
    }
#endif
    const hipError_t le = hipPeekAtLastError();
    if (le != hipSuccess) fprintf(stderr, "kernel_launch: launch failed: %s\n", hipGetErrorName(le));
}
```

```cpp
#include <hip/hip_runtime.h>
#include <cstdio>
#include <cstdint>

#ifndef PG8_ASM_STAGE
#define PG8_ASM_STAGE 0
#endif
#ifndef RESID_LO
#define RESID_LO 0
#endif
#ifndef MK_SINGLE
#define MK_SINGLE 1
#endif

__device__ __forceinline__ int lane_id_v() { int x; asm volatile("v_mbcnt_lo_u32_b32 %0, -1, 0\n\tv_mbcnt_hi_u32_b32 %0, -1, %0" : "=v"(x)); return x; }
template <int CTRL> __device__ __forceinline__ float dppx(float x) { return __builtin_bit_cast(float, __builtin_amdgcn_mov_dpp(__builtin_bit_cast(int, x), CTRL, 0xf, 0xf, true)); }
__device__ __forceinline__ float lane_xor1(float x) { return dppx<0xB1>(x); }
__device__ __forceinline__ float sum_xor16(float x) { auto s = __builtin_amdgcn_permlane16_swap(__float_as_uint(x), __float_as_uint(x), false, false); return __uint_as_float(s[0]) + __uint_as_float(s[1]); }
__device__ __forceinline__ float sum_xor32(float x) { auto s = __builtin_amdgcn_permlane32_swap(__float_as_uint(x), __float_as_uint(x), false, false); return __uint_as_float(s[0]) + __uint_as_float(s[1]); }
__device__ __forceinline__ float max_xor16(float x) { auto s = __builtin_amdgcn_permlane16_swap(__float_as_uint(x), __float_as_uint(x), false, false); return fmaxf(__uint_as_float(s[0]), __uint_as_float(s[1])); }
__device__ __forceinline__ float max_xor32(float x) { auto s = __builtin_amdgcn_permlane32_swap(__float_as_uint(x), __float_as_uint(x), false, false); return fmaxf(__uint_as_float(s[0]), __uint_as_float(s[1])); }
__device__ __forceinline__ float sum_row16(float x) { x += dppx<0xB1>(x); x += dppx<0x4E>(x); x += dppx<0x141>(x); x += dppx<0x128>(x); return x; }
__device__ __forceinline__ float max_row16(float x) { x = fmaxf(x, dppx<0xB1>(x)); x = fmaxf(x, dppx<0x4E>(x)); x = fmaxf(x, dppx<0x141>(x)); x = fmaxf(x, dppx<0x128>(x)); return x; }
namespace pg8 {
#define PG8_LAS __attribute__((address_space(3)))
typedef unsigned short bf16_t;
typedef short bf16x8 __attribute__((ext_vector_type(8)));
typedef float f32x4 __attribute__((ext_vector_type(4)));
typedef unsigned u32x4 __attribute__((ext_vector_type(4)));
typedef unsigned u32x2 __attribute__((ext_vector_type(2)));
constexpr int BM = 256, BK = 64, HALF = 128, HTB = HALF * BK * 2  , STAGE_BYTES = 8 * HTB, NXCD = 8, WGM = 8;

__host__ __device__ __forceinline__ int lds_byte(int r, int c) { const int st = (r >> 4) * 2 + (c >> 5), rr = r & 15, cc = c & 31, ob = rr * 64 + cc * 2; return st * 1024 + (ob ^ (((ob >> 9) & 1) << 5)); }
__host__ __device__ __forceinline__ void stage_rc(int b, int& R, int& C) { const int st = b / 1024, sb = b % 1024, swz = sb ^ (((sb >> 9) & 1) << 5); R = (st >> 1) * 16 + swz / 64; C = (st & 1) * 32 + (swz % 64) / 2; }
__host__ __device__ __forceinline__ int perm32(int rho) { const int n = rho >> 4, i = rho & 15; return 8 * (i >> 2) + 4 * n + (i & 3); }

struct Unit { int pm, pn; };
struct Gemm { const bf16_t* A; const bf16_t* Bt; int M, N, K, lda; };

struct StaticOrder {
    int nM, nN, nwg, G, c, wgm;
    __host__ __device__ void init(int M, int N, int G_, int c_, int wgm_ = WGM) { nM = M / BM; nN = N / BM; nwg = nM * nN; G = G_; c = c_; wgm = wgm_; }
    __host__ __device__ bool next(int i, Unit& u) const {
        const long L = (long)i * G + c; if (L >= nwg) return false;
        int wgid = (int)L; { const int q = nwg / NXCD, r = nwg % NXCD, xcd = wgid % NXCD, off = wgid / NXCD; wgid = (xcd < r ? xcd * (q + 1) : r * (q + 1) + (xcd - r) * q) + off; }
        const int nig = wgm * nN, gid = wgid / nig, fm = gid * wgm, gsz = (nM - fm) < wgm ? (nM - fm) : wgm;
        u.pm = fm + ((wgid % nig) % gsz); u.pn = (wgid % nig) / gsz; return true;
    }
    __device__ __forceinline__ void a_ready(const Unit&) const {}
    __device__ __forceinline__ void done(const Unit&) const {}
};
__device__ __forceinline__ unsigned cvt_pk_bf16(float lo, float hi) { unsigned r; asm volatile("v_cvt_pk_bf16_f32 %0, %1, %2" : "=v"(r) : "v"(lo), "v"(hi)); return r; }

template <class Epi, class Sched, bool ALIGN_EPI = false, bool SP2 = false, bool ABLK = false>
__device__ __forceinline__ void gemm_phase(PG8_LAS unsigned char* lds, const Gemm g, const Sched& S, const Epi& E, const int wv) {
    int tid_ = wv * 64 + lane_id_v(); asm volatile("" : "+v"(tid_));
    const int tid = tid_, wid = __builtin_amdgcn_readfirstlane(tid >> 6), lane = tid & 63, wr = wid >> 2, wc = wid & 3, fr = lane & 15, fq = lane >> 4;
    const int K = g.K, nt = K / BK;
    unsigned voffA[2], voffB[2];
#pragma unroll
    for (int i = 0; i < 2; ++i) { int R, C; stage_rc(tid * 16 + i * 8192, R, C); const int Rb = Epi::PERM ? ((R & ~31) + perm32(R & 31)) : R;
        voffA[i] = (unsigned)(R * (ABLK ? BK : g.lda) + C) * 2u; voffB[i] = (unsigned)(Rb * K + C) * 2u; }
    const size_t kstep = (size_t)(BK * 2);
    const size_t kstepA = ABLK ? (size_t)BM * BK * 2 : kstep;
    const size_t hstep = (size_t)HALF * K * 2, hstepA = (size_t)HALF * (ABLK ? BK : g.lda) * 2;
    const size_t tstep = 2 * hstep, tstepA = ABLK ? (size_t)nt * BM * BK * 2 : 2 * hstepA;
    const unsigned ldsw = (unsigned)wid * 1024u;
    const int aoff = lds_byte(wr * 64 + fr, fq * 8), boff = lds_byte(wc * 32 + fr, fq * 8);
#define PG8_SA(b, h) (((b) * 2 + (h)) * HTB)
#define PG8_SB(b, h) ((4 + (b) * 2 + (h)) * HTB)
#if PG8_ASM_STAGE
#define PG8_STAGE(bufoff, gbase, voff) do { const unsigned m0a_ = (unsigned)(size_t)(lds + (bufoff)) + ldsw; const char* gb_ = (const char*)(gbase); \
        asm volatile("s_mov_b32 m0, %2\n\ts_nop 0\n\tglobal_load_lds_dwordx4 %0, %1" :: "v"((voff)[0]), "s"(gb_), "s"(m0a_) : "memory", "m0"); \
        asm volatile("s_add_i32 m0, %2, 0x2000\n\ts_nop 0\n\tglobal_load_lds_dwordx4 %0, %1" :: "v"((voff)[1]), "s"(gb_), "s"(m0a_) : "memory", "m0", "scc"); } while (0)
#else
#define PG8_STAGE(bufoff, gbase, voff) do { _Pragma("unroll") for (int _i = 0; _i < 2; ++_i) \
        __builtin_amdgcn_global_load_lds((const unsigned*)((const char*)(gbase) + (voff)[_i]), (PG8_LAS unsigned*)(lds + (bufoff) + ldsw + _i * 8192), 16, 0, 0); } while (0)
#endif
#define PG8_LDA(dst, b, h) do { _Pragma("unroll") for (int m = 0; m < 4; ++m) _Pragma("unroll") for (int k = 0; k < 2; ++k) dst[m][k] = *(const PG8_LAS bf16x8*)(lds + PG8_SA(b, h) + aoff + m * 2048 + k * 1024); } while (0)
#define PG8_LDB(dst, b, h) do { _Pragma("unroll") for (int n = 0; n < 2; ++n) _Pragma("unroll") for (int k = 0; k < 2; ++k) dst[n][k] = *(const PG8_LAS bf16x8*)(lds + PG8_SB(b, h) + boff + n * 2048 + k * 1024); } while (0)
#define PG8_MMA(ai, bj, At, Bt) do { __builtin_amdgcn_s_setprio(1); _Pragma("unroll") for (int m = 0; m < 4; ++m) _Pragma("unroll") for (int n = 0; n < 2; ++n) _Pragma("unroll") for (int k = 0; k < 2; ++k) \
        acc[ai][bj][m][n] = __builtin_amdgcn_mfma_f32_16x16x32_bf16(Bt[n][k], At[m][k], acc[ai][bj][m][n], 0, 0, 0); __builtin_amdgcn_s_setprio(0); } while (0)
#define PG8_WAIT_V(n) asm volatile("s_waitcnt vmcnt(" #n ")" ::: "memory")
#define PG8_WAIT_L(n) asm volatile("s_waitcnt lgkmcnt(" #n ")" ::: "memory")
#define PG8_BAR __builtin_amdgcn_s_barrier()
#define PG8_SCHED __builtin_amdgcn_sched_barrier(0)
    Unit cur, nxt; int ui = 0;
    if (!S.next(0, cur)) return;
    f32x4 acc[2][2][4][2];
#pragma unroll
    for (int a = 0; a < 2; ++a)
#pragma unroll
        for (int b = 0; b < 2; ++b)
#pragma unroll
            for (int m = 0; m < 4; ++m)
#pragma unroll
                for (int n = 0; n < 2; ++n) acc[a][b][m][n] = (f32x4){0.f, 0.f, 0.f, 0.f};
    bf16x8 At[4][2], B0[2][2], B1[2][2];
    const char* cA = (const char*)g.A + (size_t)cur.pm * tstepA; const char* cB = (const char*)g.Bt + (size_t)cur.pn * tstep;
    S.a_ready(cur);
    if constexpr (SP2) {
        PG8_STAGE(PG8_SB(0, 0), cB, voffB); PG8_STAGE(PG8_SB(0, 1), cB + hstep, voffB); PG8_STAGE(PG8_SA(0, 0), cA, voffA); PG8_STAGE(PG8_SA(0, 1), cA + hstepA, voffA);
        if (wr == 1) PG8_BAR;
        PG8_WAIT_V(2); PG8_BAR;
        PG8_STAGE(PG8_SB(1, 0), cB + kstep, voffB); PG8_STAGE(PG8_SA(1, 0), cA + kstepA, voffA); PG8_STAGE(PG8_SB(1, 1), cB + hstep + kstep, voffB);
        PG8_WAIT_V(6); PG8_BAR;
    } else {
        PG8_STAGE(PG8_SB(0, 0), cB, voffB); PG8_STAGE(PG8_SA(0, 0), cA, voffA); PG8_STAGE(PG8_SB(0, 1), cB + hstep, voffB); PG8_STAGE(PG8_SA(0, 1), cA + hstepA, voffA);
        if (wr == 1) PG8_BAR;
        PG8_WAIT_V(4); PG8_BAR;
        PG8_STAGE(PG8_SB(1, 0), cB + kstep, voffB); PG8_STAGE(PG8_SA(1, 0), cA + kstepA, voffA); PG8_STAGE(PG8_SB(1, 1), cB + hstep + kstep, voffB);
        PG8_WAIT_V(6); PG8_BAR;
    }
    for (;;) {
        const bool has_next = S.next(ui + 1, nxt);
        const char* nA = has_next ? (const char*)g.A + (size_t)nxt.pm * tstepA : cA; const char* nB = has_next ? (const char*)g.Bt + (size_t)nxt.pn * tstep : cB;
        for (int t = 0; t < nt; t += 2) {
            const bool last = (t == nt - 2);
            const char* a1 = cA + (size_t)(t + 1) * kstepA;
            const char* a2 = last ? nA : cA + (size_t)(t + 2) * kstepA; const char* b2 = last ? nB : cB + (size_t)(t + 2) * kstep;
            const char* a3 = a2 + kstepA; const char* b3 = b2 + kstep;
            if (last && has_next) S.a_ready(nxt);
            if constexpr (Epi::HAS_MID) { if (t == Epi::T1 || t == Epi::T2) { const int ln_ = lane_id_v(); E.mid(acc, cur, wr, wc, ln_ & 15, ln_ >> 4, t); } }
            if constexpr (SP2) {
            PG8_LDB(B0, 0, 0); PG8_LDB(B1, 0, 1); PG8_SCHED; PG8_LDA(At, 0, 0); PG8_STAGE(PG8_SA(1, 1), a1 + hstepA, voffA);
            PG8_WAIT_V(8); PG8_WAIT_L(0); PG8_BAR; PG8_MMA(0, 0, At, B0); PG8_MMA(0, 1, At, B1); PG8_BAR; PG8_SCHED;
            PG8_LDA(At, 0, 1); PG8_STAGE(PG8_SB(0, 0), b2, voffB); PG8_STAGE(PG8_SB(0, 1), b2 + hstep, voffB); PG8_STAGE(PG8_SA(0, 0), a2, voffA);
            PG8_WAIT_V(8); PG8_WAIT_L(0); PG8_BAR; PG8_MMA(1, 0, At, B0); PG8_MMA(1, 1, At, B1); PG8_BAR; PG8_SCHED;
            PG8_LDB(B0, 1, 0); PG8_LDB(B1, 1, 1); PG8_SCHED; PG8_LDA(At, 1, 0); PG8_STAGE(PG8_SA(0, 1), a2 + hstepA, voffA);
            PG8_WAIT_V(8); PG8_WAIT_L(0); PG8_BAR; PG8_MMA(0, 0, At, B0); PG8_MMA(0, 1, At, B1); PG8_BAR; PG8_SCHED;
            PG8_LDA(At, 1, 1); PG8_STAGE(PG8_SB(1, 0), b3, voffB); PG8_STAGE(PG8_SB(1, 1), b3 + hstep, voffB); PG8_STAGE(PG8_SA(1, 0), a3, voffA);
            PG8_WAIT_V(8); PG8_WAIT_L(0); PG8_BAR; PG8_MMA(1, 0, At, B0); PG8_MMA(1, 1, At, B1); PG8_BAR; PG8_SCHED;
            } else {
            PG8_LDB(B0, 0, 0); PG8_SCHED; PG8_LDA(At, 0, 0); PG8_STAGE(PG8_SA(1, 1), a1 + hstepA, voffA);
            PG8_WAIT_L(8); PG8_BAR; PG8_WAIT_L(0); PG8_MMA(0, 0, At, B0); PG8_BAR; PG8_SCHED;
            PG8_LDB(B1, 0, 1); PG8_STAGE(PG8_SB(0, 0), b2, voffB);
            PG8_BAR; PG8_WAIT_L(0); PG8_MMA(0, 1, At, B1); PG8_BAR;
            PG8_LDA(At, 0, 1); PG8_STAGE(PG8_SA(0, 0), a2, voffA);
            PG8_BAR; PG8_WAIT_L(0); PG8_MMA(1, 0, At, B0); PG8_BAR; PG8_SCHED;
            PG8_STAGE(PG8_SB(0, 1), b2 + hstep, voffB);
            PG8_WAIT_V(6); PG8_BAR; PG8_MMA(1, 1, At, B1); PG8_BAR;
            PG8_LDB(B0, 1, 0); PG8_SCHED; PG8_LDA(At, 1, 0); PG8_STAGE(PG8_SA(0, 1), a2 + hstepA, voffA);
            PG8_WAIT_L(8); PG8_BAR; PG8_WAIT_L(0); PG8_MMA(0, 0, At, B0); PG8_BAR; PG8_SCHED;
            PG8_LDB(B1, 1, 1); PG8_STAGE(PG8_SB(1, 0), b3, voffB);
            PG8_BAR; PG8_WAIT_L(0); PG8_MMA(0, 1, At, B1); PG8_BAR;
            PG8_LDA(At, 1, 1); PG8_STAGE(PG8_SA(1, 0), a3, voffA);
            PG8_BAR; PG8_WAIT_L(0); PG8_MMA(1, 0, At, B0); PG8_BAR; PG8_SCHED;
            PG8_STAGE(PG8_SB(1, 1), b3 + hstep, voffB);
            PG8_WAIT_V(6); PG8_BAR; PG8_MMA(1, 1, At, B1); PG8_BAR;
            }
        }
        if constexpr (ALIGN_EPI) { if (wr == 0) PG8_BAR; }
        if constexpr (!Epi::AFTER_DRAIN) { const int ln_ = lane_id_v(); E(acc, cur, wr, wc, ln_ & 15, ln_ >> 4); S.done(cur); }
        if (!has_next) break;
#pragma unroll
        for (int a = 0; a < 2; ++a)
#pragma unroll
            for (int b = 0; b < 2; ++b)
#pragma unroll
                for (int m = 0; m < 4; ++m)
#pragma unroll
                    for (int n = 0; n < 2; ++n) acc[a][b][m][n] = (f32x4){0.f, 0.f, 0.f, 0.f};
        cur = nxt; cA = nA; cB = nB; ++ui;
        if constexpr (ALIGN_EPI) { if (wr == 1) PG8_BAR; }
    }
    PG8_WAIT_V(0);
    if constexpr (!ALIGN_EPI) { if (wr == 0) PG8_BAR; }
    PG8_BAR;
    if constexpr (Epi::AFTER_DRAIN) { E.fused(acc, cur, wr, wc, fr, fq, lds, wid, lane); S.done(cur); }
#undef PG8_SA
#undef PG8_SB
#undef PG8_STAGE
#undef PG8_LDA
#undef PG8_LDB
#undef PG8_MMA
#undef PG8_WAIT_V
#undef PG8_WAIT_L
#undef PG8_BAR
#undef PG8_SCHED
}

constexpr float NORM_EPS = 1e-6f;
__device__ __forceinline__ float row_rstd(const float* ssq, int row, int fq) {
    const f32x4 a = *(const f32x4*)(ssq + (size_t)row * 32 + fq * 8), b = *(const f32x4*)(ssq + (size_t)row * 32 + fq * 8 + 4);
    float s = ((a[0] + a[1]) + (a[2] + a[3])) + ((b[0] + b[1]) + (b[2] + b[3]));
    s = sum_xor32(sum_xor16(s));
    return rsqrtf(s * (1.0f / 2048.0f) + NORM_EPS);
}
__device__ __forceinline__ float fsigmoid(float x) { return __builtin_amdgcn_rcpf(1.0f + __expf(-x)); }
__device__ __forceinline__ u32x4 pack8(const f32x4 v0, const f32x4 v1) { u32x4 w; w.x = cvt_pk_bf16(v0[0], v0[1]); w.y = cvt_pk_bf16(v0[2], v0[3]); w.z = cvt_pk_bf16(v1[0], v1[1]); w.w = cvt_pk_bf16(v1[2], v1[3]); return w; }
__device__ __forceinline__ void unpack8(const u32x4 w, f32x4& v0, f32x4& v1) {
    v0[0] = __uint_as_float(w.x << 16); v0[1] = __uint_as_float(w.x & 0xffff0000u); v0[2] = __uint_as_float(w.y << 16); v0[3] = __uint_as_float(w.y & 0xffff0000u);
    v1[0] = __uint_as_float(w.z << 16); v1[1] = __uint_as_float(w.z & 0xffff0000u); v1[2] = __uint_as_float(w.w << 16); v1[3] = __uint_as_float(w.w & 0xffff0000u); }

struct EpiSwiGLU {
    static constexpr bool PERM = true, AFTER_DRAIN = false, HAS_MID = false;
    const float* ssq; bf16_t* H; int ldh;
    __device__ __forceinline__ void operator()(const f32x4 (&acc)[2][2][4][2], const Unit& u, int wr, int wc, int fr, int fq) const {
        const int row0 = u.pm * BM + wr * 64 + fr;
        bf16_t* Hb = H + ((size_t)(u.pm * (ldh / BK) + 2 * u.pn + (wc >> 1)) * BM + wr * 64 + fr) * BK + (wc & 1) * 32 + 8 * fq;
        float rs[2][4];
#pragma unroll
        for (int ai = 0; ai < 2; ++ai)
#pragma unroll
            for (int m = 0; m < 4; ++m) rs[ai][m] = row_rstd(ssq, row0 + ai * HALF + m * 16, fq);
#pragma unroll
        for (int ai = 0; ai < 2; ++ai)
#pragma unroll
            for (int m = 0; m < 4; ++m) { const float r = rs[ai][m];
                f32x4 h0, h1;
#pragma unroll
                for (int j = 0; j < 4; ++j) { const float g0 = acc[ai][0][m][0][j] * r, g1 = acc[ai][0][m][1][j] * r;
                    h0[j] = g0 * fsigmoid(g0) * (acc[ai][1][m][0][j] * r); h1[j] = g1 * fsigmoid(g1) * (acc[ai][1][m][1][j] * r); }
                *(u32x4*)(Hb + (size_t)(ai * HALF + m * 16) * BK) = pack8(h0, h1); }
    }
};
template <bool FINAL> struct EpiResid {
    static constexpr bool PERM = true, AFTER_DRAIN = false, HAS_MID = false;
    float* out; bf16_t* xb; const bf16_t* xl_in; bf16_t* xl_out; float* ssq; float alpha;
    __device__ __forceinline__ void operator()(const f32x4 (&acc)[2][2][4][2], const Unit& u, int wr, int wc, int fr, int fq) const {
        const int row0 = u.pm * BM + wr * 64 + fr, col0 = u.pn * BM + wc * 32 + 8 * fq;
        const size_t xb0 = ((size_t)(u.pm * (2048 / BK) + 4 * u.pn + (wc >> 1)) * BM + wr * 64 + fr) * BK + (wc & 1) * 32 + 8 * fq;
#pragma unroll
        for (int ai = 0; ai < 2; ++ai) {
            u32x4 bw[4][2], lw[4][2];
#pragma unroll
            for (int m = 0; m < 4; ++m)
#pragma unroll
                for (int bj = 0; bj < 2; ++bj) { const size_t offb = xb0 + (size_t)(2 * bj) * BM * BK + (size_t)(ai * HALF + m * 16) * BK; bw[m][bj] = *(const u32x4*)(xb + offb); if (RESID_LO) lw[m][bj] = *(const u32x4*)(xl_in + offb); }
#pragma unroll
            for (int m = 0; m < 4; ++m) { const int row = row0 + ai * HALF + m * 16; float ss = 0.f;
#pragma unroll
                for (int bj = 0; bj < 2; ++bj) { const size_t off = (size_t)row * 2048 + col0 + bj * HALF, offb = xb0 + (size_t)(2 * bj) * BM * BK + (size_t)(ai * HALF + m * 16) * BK;
                    f32x4 b0, b1; unpack8(bw[m][bj], b0, b1); if (RESID_LO) { f32x4 l0, l1; unpack8(lw[m][bj], l0, l1); b0 += l0; b1 += l1; }
                    const f32x4 v0 = b0 + acc[ai][bj][m][0] * alpha, v1 = b1 + acc[ai][bj][m][1] * alpha;
                    if (FINAL) { *(f32x4*)(out + off) = v0; *(f32x4*)(out + off + 4) = v1; }
                    else { ss += ((v0[0] * v0[0] + v0[1] * v0[1]) + (v0[2] * v0[2] + v0[3] * v0[3])) + ((v1[0] * v1[0] + v1[1] * v1[1]) + (v1[2] * v1[2] + v1[3] * v1[3]));
                        const u32x4 hw = pack8(v0, v1); f32x4 h0, h1; unpack8(hw, h0, h1);
                        *(u32x4*)(xb + offb) = hw; if (RESID_LO) *(u32x4*)(xl_out + offb) = pack8(v0 - h0, v1 - h1); } }
                if (!FINAL) { ss = sum_xor32(sum_xor16(ss)); if (fq == 0) ssq[(size_t)row * 32 + u.pn * 4 + wc] = ss; } }
            asm volatile("" ::: "memory"); }
    }
};
struct EpiWin {
    static constexpr bool PERM = true, AFTER_DRAIN = false, HAS_MID = false;
    const float* ssq; bf16_t* u1; bf16_t* u2; int ld1, ld2;
    __device__ __forceinline__ void operator()(const f32x4 (&acc)[2][2][4][2], const Unit& u, int wr, int wc, int fr, int fq) const {
        const int row0 = u.pm * BM + wr * 64 + fr; const int mode = u.pn < 17 ? 0 : (u.pn < 19 ? 1 : 2);
        bf16_t* dst = mode == 2 ? u2 : u1; const int ld = mode == 2 ? ld2 : ld1; const int col0 = (mode == 2 ? (u.pn - 19) : u.pn) * BM + wc * 32 + 8 * fq;
        float rsv[2][4];
#pragma unroll
        for (int ai = 0; ai < 2; ++ai)
#pragma unroll
            for (int m = 0; m < 4; ++m) rsv[ai][m] = row_rstd(ssq, row0 + ai * HALF + m * 16, fq);
#pragma unroll
        for (int ai = 0; ai < 2; ++ai)
#pragma unroll
            for (int m = 0; m < 4; ++m) { const int row = row0 + ai * HALF + m * 16; const float rs = rsv[ai][m];
#pragma unroll
                for (int bj = 0; bj < 2; ++bj) { f32x4 v0 = acc[ai][bj][m][0] * rs, v1 = acc[ai][bj][m][1] * rs;
                    if (mode == 1) {
#pragma unroll
                        for (int j = 0; j < 4; ++j) { v0[j] = v0[j] * fsigmoid(v0[j]); v1[j] = v1[j] * fsigmoid(v1[j]); } }
                    else if (mode == 2) {
#pragma unroll
                        for (int j = 0; j < 4; ++j) { v0[j] = fmaxf(fsigmoid(v0[j]), 9.094947e-13f); v1[j] = fmaxf(fsigmoid(v1[j]), 9.094947e-13f); } }
                    *(u32x4*)(dst + (size_t)row * ld + col0 + bj * HALF) = pack8(v0, v1); } }
    }
};
struct EpiBf16 {
    static constexpr bool PERM = true, AFTER_DRAIN = false, HAS_MID = false;
    bf16_t* O; int ldc;
    __device__ __forceinline__ void operator()(const f32x4 (&acc)[2][2][4][2], const Unit& u, int wr, int wc, int fr, int fq) const {
        const int row0 = u.pm * BM + wr * 64 + fr, col0 = u.pn * BM + wc * 32 + 8 * fq;
#pragma unroll
        for (int ai = 0; ai < 2; ++ai)
#pragma unroll
            for (int m = 0; m < 4; ++m) { bf16_t* rowp = O + (size_t)(row0 + ai * HALF + m * 16) * ldc + col0;
#pragma unroll
                for (int bj = 0; bj < 2; ++bj) *(u32x4*)(rowp + bj * HALF) = pack8(acc[ai][bj][m][0], acc[ai][bj][m][1]); }
    }
};
struct EpiF32 {
    static constexpr bool PERM = false, AFTER_DRAIN = false, HAS_MID = false;
    float* C; int ldc;
    __device__ __forceinline__ void operator()(const f32x4 (&acc)[2][2][4][2], const Unit& u, int wr, int wc, int fr, int fq) const {
        const int row0 = u.pm * BM + wr * 64 + fr, col0 = u.pn * BM + wc * 32 + 4 * fq;
#pragma unroll
        for (int ai = 0; ai < 2; ++ai)
#pragma unroll
            for (int m = 0; m < 4; ++m) { float* rowp = C + (size_t)(row0 + ai * HALF + m * 16) * ldc + col0;
#pragma unroll
                for (int bj = 0; bj < 2; ++bj)
#pragma unroll
                    for (int n = 0; n < 2; ++n) *(f32x4*)(rowp + bj * HALF + n * 16) = acc[ai][bj][m][n]; }
    }
};
struct EpiMergeFused {
    static constexpr bool PERM = true, AFTER_DRAIN = false, HAS_MID = true;
    static constexpr int T1 = 12, T2 = 20;
    const bf16_t* gate; int ldg; bf16_t* mb;
    __device__ __forceinline__ void mid(f32x4 (&acc)[2][2][4][2], const Unit& u, int wr, int wc, int fr, int fq, int t) const {
        const int row0 = u.pm * BM + wr * 64 + fr, col0 = u.pn * BM + wc * 32 + 8 * fq; const bf16_t* gx = gate + (t == T1 ? 0 : 2048); const bf16_t* gy = gx + 2048;
#pragma unroll
        for (int ai = 0; ai < 2; ++ai) { u32x4 wx[4][2], wy[4][2];
#pragma unroll
            for (int m = 0; m < 4; ++m)
#pragma unroll
                for (int bj = 0; bj < 2; ++bj) { const size_t o = (size_t)(row0 + ai * HALF + m * 16) * ldg + col0 + bj * HALF; wx[m][bj] = *(const u32x4*)(gx + o); wy[m][bj] = *(const u32x4*)(gy + o); }
#pragma unroll
            for (int m = 0; m < 4; ++m)
#pragma unroll
                for (int bj = 0; bj < 2; ++bj) { f32x4 x0, x1, y0, y1; unpack8(wx[m][bj], x0, x1); unpack8(wy[m][bj], y0, y1);
#pragma unroll
                    for (int j = 0; j < 4; ++j) { acc[ai][bj][m][0][j] *= x0[j] * __builtin_amdgcn_rcpf(y0[j]); acc[ai][bj][m][1][j] *= x1[j] * __builtin_amdgcn_rcpf(y1[j]); } }
            asm volatile("" ::: "memory"); }
    }
    __device__ __forceinline__ void operator()(const f32x4 (&acc)[2][2][4][2], const Unit& u, int wr, int wc, int fr, int fq) const {
        const int row0 = u.pm * BM + wr * 64 + fr, col0 = u.pn * BM + wc * 32 + 8 * fq; const bf16_t* gc = gate + 4096;
#pragma unroll
        for (int ai = 0; ai < 2; ++ai) { u32x4 gw[4][2];
#pragma unroll
            for (int m = 0; m < 4; ++m)
#pragma unroll
                for (int bj = 0; bj < 2; ++bj) gw[m][bj] = *(const u32x4*)(gc + (size_t)(row0 + ai * HALF + m * 16) * ldg + col0 + bj * HALF);
#pragma unroll
            for (int m = 0; m < 4; ++m)
#pragma unroll
                for (int bj = 0; bj < 2; ++bj) { f32x4 g0, g1; unpack8(gw[m][bj], g0, g1);
                    *(u32x4*)(mb + (size_t)(row0 + ai * HALF + m * 16) * 2048 + col0 + bj * HALF) = pack8(g0 * acc[ai][bj][m][0], g1 * acc[ai][bj][m][1]); }
            asm volatile("" ::: "memory"); }
    }
};
}

#define GAS __attribute__((address_space(1)))
#define LAS __attribute__((address_space(3)))
typedef unsigned short bf16_t;
typedef short bf16x8 __attribute__((ext_vector_type(8)));
typedef short s16x4 __attribute__((ext_vector_type(4)));
typedef float f32x4 __attribute__((ext_vector_type(4)));
typedef float f32x16 __attribute__((ext_vector_type(16)));
typedef unsigned u32x4 __attribute__((ext_vector_type(4)));
typedef unsigned u32x2 __attribute__((ext_vector_type(2)));
#define LDS_WAIT() asm volatile("s_waitcnt lgkmcnt(0)" ::: "memory")
#define VM_WAIT() asm volatile("s_waitcnt vmcnt(0)" ::: "memory")
#define SBAR() __builtin_amdgcn_sched_barrier(0)
__device__ __forceinline__ unsigned f2bf(float f) { unsigned u = __builtin_bit_cast(unsigned, f); return (u + 0x7fffu + ((u >> 16) & 1u)) >> 16; }
__device__ __forceinline__ float bf2f(bf16_t b) { return __uint_as_float(((unsigned)b) << 16); }
__device__ __forceinline__ unsigned pk2(float lo, float hi) { return f2bf(lo) | (f2bf(hi) << 16); }
__device__ __forceinline__ float wave_sum(float v) { return sum_xor32(sum_xor16(sum_row16(v))); }

constexpr int NB = 2, SEQ = 16384, MTOK = NB * SEQ, DM = 2048, FF = 5504, DEPTH = 4;
constexpr int NGU = 2 * FF, NIN = 11008, U1W = 4864, U2W = 6144;
constexpr int C_CQ = 0, C_CKV = 512, C_QB = 768, C_KB = 1024, C_VB = 1280, C_QC = 1792, C_KC = 2560, C_VC = 3328, C_KROPE = 4096, C_GLR = 4160, C_RB = 4352;
constexpr int QRAW_LD = 1280, KVRAW_LD = 1536, YW = 1536;
constexpr float EPS = 1e-6f, LOG2E = 1.4426950408889634f, LN2 = 0.6931471805599453f;
constexpr float QS_MLA = 0.07216878364870322f * LOG2E;
constexpr float QS_DSWA = 0.08838834764831845f * LOG2E;

namespace att {
constexpr int SHM_V = 64 * 128 * 2;
__device__ __forceinline__ int v_rd_base(int lane) { const int g = lane >> 4, c = lane & 15; return (g & 1) * 2048 + (g >> 1) * 256 + (c >> 2) * 64 + (c & 3) * 8; }
__device__ __forceinline__ unsigned cvtpk(float lo, float hi) { unsigned r; asm volatile("v_cvt_pk_bf16_f32 %0, %1, %2" : "=v"(r) : "v"(lo), "v"(hi)); return r; }
#define MFMA16(A_, B_, C_) __builtin_amdgcn_mfma_f32_16x16x32_bf16(A_, B_, C_, 0, 0, 0)

template <class F> __device__ __forceinline__ void pv_tile(f32x4 (&o)[8][2], int vbe, int vbo, bf16x8 p00, bf16x8 p01, bf16x8 p10, bf16x8 p11, F&& between) {
#define TRRD(dst, base, off) asm volatile("ds_read_b64_tr_b16 %0, %1 offset:%2" : "=&v"(dst) : "v"(base), "i"(off) : "memory")
    s16x4 va[8], vb[8];
#define PV_SLOT_RD(i) do { constexpr int i_ = (i); if ((i_ & 1) == 0) { TRRD(va[i_ & 7], vbe, (i_ >> 2) * 512 + ((i_ >> 1) & 1) * 8192); TRRD(vb[i_ & 7], vbe, (i_ >> 2) * 512 + ((i_ >> 1) & 1) * 8192 + 4096); } \
        else { TRRD(va[i_ & 7], vbo, (i_ >> 2) * 512 + ((i_ >> 1) & 1) * 8192); TRRD(vb[i_ & 7], vbo, (i_ >> 2) * 512 + ((i_ >> 1) & 1) * 8192 + 4096); } } while (0)
#define VF_(x, y) (bf16x8){x[0], x[1], x[2], x[3], y[0], y[1], y[2], y[3]}
#define PV_SLOT_MM(i) do { constexpr int i_ = (i), db_ = 2 * (i_ >> 2) + (i_ & 1); const bf16x8 f_ = VF_(va[i_ & 7], vb[i_ & 7]); \
        if (((i_ >> 1) & 1) == 0) { o[db_][0] = MFMA16(f_, p00, o[db_][0]); o[db_][1] = MFMA16(f_, p10, o[db_][1]); } else { o[db_][0] = MFMA16(f_, p01, o[db_][0]); o[db_][1] = MFMA16(f_, p11, o[db_][1]); } } while (0)
#define PV_STEP(i, W) do { if ((i) + 7 < 16) PV_SLOT_RD(((i) + 7) & 15); asm volatile("s_waitcnt lgkmcnt(" #W ")" ::: "memory"); SBAR(); PV_SLOT_MM(i); SBAR(); } while (0)
    PV_SLOT_RD(0); PV_SLOT_RD(1); PV_SLOT_RD(2); PV_SLOT_RD(3); PV_SLOT_RD(4); PV_SLOT_RD(5); PV_SLOT_RD(6);
    PV_STEP(0, 14); PV_STEP(1, 14); PV_STEP(2, 14); PV_STEP(3, 14); between(0); SBAR();
    PV_STEP(4, 14); PV_STEP(5, 14); PV_STEP(6, 14); PV_STEP(7, 14); between(1); SBAR();
    PV_STEP(8, 14); PV_STEP(9, 12); PV_STEP(10, 10); PV_STEP(11, 8); between(2); SBAR();
    PV_STEP(12, 6); PV_STEP(13, 4); PV_STEP(14, 2); PV_STEP(15, 0); between(3);
#undef PV_STEP
#undef PV_SLOT_MM
#undef VF_
#undef PV_SLOT_RD
#undef TRRD
}

struct AUnit { const bf16_t* Q; const bf16_t* K; const bf16_t* V; bf16_t* O; float* lse; size_t qpitch, kpitch, vpitch, opitch, lsepitch; int q0, j_lo, j_hi; float bias_c, mbound; };

template <int DQK> __device__ __forceinline__ int k_chunk_swz(int row, int c) {
    if (DQK == 192) return (c & ~7) | ((c & 7) ^ ((row >> 1) & 7));
    return c ^ (((row >> 1) & 7) | ((row & 1) << 3));
}
template <int DQK, int MODE, int VAR = 0>
__device__ __forceinline__ void attn_unit(LAS unsigned char* lds, const AUnit& u, const int wv) {
    constexpr int PK = DQK * 2, SHK = 64 * PK, NCH = DQK / 8, NKD = (64 * NCH) / 512, NKS = DQK / 32;
    constexpr int KOFF = 4 * SHM_V;
    int tid_ = wv * 64 + lane_id_v(); asm volatile("" : "+v"(tid_));
    const int tid = tid_, wid = __builtin_amdgcn_readfirstlane(tid >> 6), lane = tid & 63, c16 = lane & 15, g4 = lane >> 4;
    LAS unsigned char* V_lds = lds; LAS unsigned char* K_lds = lds + KOFF;
    bf16x8 qr[2][NKS];
#pragma unroll
    for (int qb = 0; qb < 2; ++qb) { const bf16_t* qrow = u.Q + (size_t)(wid * 32 + 16 * qb + c16) * u.qpitch + g4 * 8;
#pragma unroll
      for (int ks = 0; ks < NKS; ++ks) qr[qb][ks] = *(const bf16x8*)(qrow + ks * 32); }
    float l0 = 0.f, l1 = 0.f; f32x4 o[8][2]; const float mb_ = u.mbound;
#pragma unroll
    for (int db = 0; db < 8; ++db) { o[db][0] = (f32x4){0.f, 0.f, 0.f, 0.f}; o[db][1] = (f32x4){0.f, 0.f, 0.f, 0.f}; }
    const int vb0 = (int)(size_t)V_lds + v_rd_base(lane), vsw = (g4 & 1) * 32;
    const int qlo = u.q0 + wid * 32, qj = qlo + c16;
    const bool lead = wid < 4;
    const float NEG = -__builtin_inff();
#define KSRC(P_, LN_) ([&]() -> unsigned { const int sl = ((P_) * 8 + wid) * 64 + (LN_), row = sl / NCH, cs = sl % NCH; return (unsigned)row * kp32 + (unsigned)k_chunk_swz<DQK>(row, cs) * 8u; }())
#define VSRC(P_, LN_) ([&]() -> unsigned { const int off = (((P_) * 8 + wid) * 64 + (LN_)) * 16, sub = off >> 9, kk = ((sub >> 2) << 3) | ((off & 511) >> 6), c = ((sub & 3) << 5) | (((off ^ (((sub >> 2) & 1) << 5)) & 63) >> 1); \
        const int k = (kk & ~0xC) | ((kk & 4) << 1) | ((kk & 8) >> 1); return (unsigned)k * vp32 + (unsigned)c; }())
    const unsigned kp32 = (unsigned)u.kpitch, vp32 = (unsigned)u.vpitch;
    unsigned dsrc[NKD + 2];
#pragma unroll
    for (int p_ = 0; p_ < NKD + 2; ++p_) dsrc[p_] = p_ < NKD ? KSRC(p_ < NKD ? p_ : 0, lane) : VSRC(p_ >= NKD ? p_ - NKD : 0, lane);
#define ST_PIECE(T_, KBF_, VBF_, P_, LN_) do { if ((P_) < NKD) __builtin_amdgcn_global_load_lds((const unsigned*)(u.K + (size_t)(T_) * 64 * u.kpitch + dsrc[P_]), (LAS unsigned*)(K_lds + (KBF_) * SHK + ((P_) * 8 + wid) * 1024), 16, 0, 0); \
        else __builtin_amdgcn_global_load_lds((const unsigned*)(u.V + (size_t)(T_) * 64 * u.vpitch + dsrc[P_]), (LAS unsigned*)(V_lds + (VBF_) * SHM_V + (((P_) - NKD) * 8 + wid) * 1024), 16, 0, 0); } while (0)
#define ST_DMA(t, kbf, vbf) do { int ln_ = lane; asm volatile("" : "+v"(ln_)); _Pragma("unroll") for (int p_ = 0; p_ < NKD + 2; ++p_) ST_PIECE(t, kbf, vbf, p_, ln_); } while (0)
    int kra[DQK == 192 ? 2 : 4];
#pragma unroll
    for (int i = 0; i < (DQK == 192 ? 2 : 4); ++i) kra[i] = (int)(size_t)K_lds + c16 * PK + 16 * k_chunk_swz<DQK>(c16, 4 * i + g4);
#define KFRD(dst_, ka_, ks_, kb_) asm volatile("ds_read_b128 %0, %1 offset:%2" : "=v"(dst_) : "v"(ka_), "i"((kb_) * 16 * PK + (DQK == 192 ? 128 * ((ks_) >> 1) : 0)) : "memory")
#define KADDR(kbs_, ks_) ((DQK == 192 ? kra[(ks_) & 1] : kra[(ks_) & 3]) + (kbs_))
#define QK_TILE(T_, KB_) do { \
        _Pragma("unroll") for (int kb = 0; kb < 4; ++kb) { sc[kb][0] = (f32x4){0.f, 0.f, 0.f, 0.f}; sc[kb][1] = (f32x4){0.f, 0.f, 0.f, 0.f}; } \
        { __builtin_amdgcn_s_setprio(1); bf16x8 kf[2][4]; const int kbs_ = (KB_) * SHK;        \
          _Pragma("unroll") for (int i = 0; i < 7; ++i) { const int ka_ = KADDR(kbs_, i >> 2); KFRD(kf[(i >> 2) & 1][i & 3], ka_, i >> 2, i & 3); } \
          _Pragma("unroll") for (int i = 0; i < 4 * NKS; ++i) { \
              if (i + 7 < 4 * NKS) { const int ka_ = KADDR(kbs_, (i + 7) >> 2); KFRD(kf[((i + 7) >> 2) & 1][(i + 7) & 3], ka_, (i + 7) >> 2, (i + 7) & 3); } \
              { const int rem_ = 4 * NKS - 1 - i; \
                if (rem_ >= 7) asm volatile("s_waitcnt lgkmcnt(7)" ::: "memory"); else if (rem_ == 6) asm volatile("s_waitcnt lgkmcnt(6)" ::: "memory"); else if (rem_ == 5) asm volatile("s_waitcnt lgkmcnt(5)" ::: "memory"); \
                else if (rem_ == 4) asm volatile("s_waitcnt lgkmcnt(4)" ::: "memory"); else if (rem_ == 3) asm volatile("s_waitcnt lgkmcnt(3)" ::: "memory"); else if (rem_ == 2) asm volatile("s_waitcnt lgkmcnt(2)" ::: "memory"); \
                else if (rem_ == 1) asm volatile("s_waitcnt lgkmcnt(1)" ::: "memory"); else asm volatile("s_waitcnt lgkmcnt(0)" ::: "memory"); } \
              SBAR(); \
              sc[i & 3][0] = MFMA16(kf[(i >> 2) & 1][i & 3], qr[0][i >> 2], sc[i & 3][0]); sc[i & 3][1] = MFMA16(kf[(i >> 2) & 1][i & 3], qr[1][i >> 2], sc[i & 3][1]); \
              SBAR(); } __builtin_amdgcn_s_setprio(0); } \
        const int kb0 = (T_) * 64; \
        if (MODE == 0) { if (kb0 + 63 > qlo) { _Pragma("unroll") for (int kb = 0; kb < 4; ++kb) { _Pragma("unroll") for (int r = 0; r < 4; ++r) { const int key = kb0 + 16 * kb + 4 * g4 + r; \
                if (key > qj) sc[kb][0][r] = NEG; if (key > qj + 16) sc[kb][1][r] = NEG; } } } } \
        else { _Pragma("unroll") for (int kb = 0; kb < 4; ++kb) { _Pragma("unroll") for (int r = 0; r < 4; ++r) { const int dist = qj - (kb0 + 16 * kb + 4 * g4 + r), dist2 = dist + 16; \
                sc[kb][0][r] = ((unsigned)dist <= 128u) ? sc[kb][0][r] - u.bias_c * (float)dist : NEG; sc[kb][1][r] = ((unsigned)dist2 <= 128u) ? sc[kb][1][r] - u.bias_c * (float)dist2 : NEG; } } } } while (0)
#define PKB(qb_, s_) ([&]() -> bf16x8 { u32x4 w_ = {cvtpk(sc[2 * (s_)][qb_][0], sc[2 * (s_)][qb_][1]), cvtpk(sc[2 * (s_)][qb_][2], sc[2 * (s_)][qb_][3]), cvtpk(sc[2 * (s_) + 1][qb_][0], sc[2 * (s_) + 1][qb_][1]), cvtpk(sc[2 * (s_) + 1][qb_][2], sc[2 * (s_) + 1][qb_][3])}; \
        return *reinterpret_cast<bf16x8*>(&w_); }())
#define SOFTMAX_TILE() do { \
        _Pragma("unroll") for (int kb = 0; kb < 4; ++kb) { _Pragma("unroll") for (int r = 0; r < 4; ++r) { sc[kb][0][r] = __builtin_amdgcn_exp2f(sc[kb][0][r] - mb_); sc[kb][1][r] = __builtin_amdgcn_exp2f(sc[kb][1][r] - mb_); } } \
        float ps0 = 0.f, ps1 = 0.f; \
        _Pragma("unroll") for (int kb = 0; kb < 4; ++kb) { _Pragma("unroll") for (int r = 0; r < 4; ++r) { ps0 += sc[kb][0][r]; ps1 += sc[kb][1][r]; } } \
        l0 += ps0; l1 += ps1; \
        p00 = PKB(0, 0); p01 = PKB(0, 1); p10 = PKB(1, 0); p11 = PKB(1, 1); } while (0)
#define PV_TILE(VB_, DT_, DKB_, DVB_) do { __builtin_amdgcn_s_setprio(1); const int dt_ = (DT_), dkb_ = (DKB_), dvb_ = (DVB_); \
        pv_tile(o, vb0 + (VB_) * SHM_V + vsw, vb0 + (VB_) * SHM_V + (vsw ^ 32), p00, p01, p10, p11, [&](int st_) { if (dt_ >= 0) { int lp_ = lane; asm volatile("" : "+v"(lp_)); \
            if (st_ == 0) { ST_PIECE(dt_, dkb_, dvb_, 0, lp_); ST_PIECE(dt_, dkb_, dvb_, 1, lp_); } else if (st_ == 1) { ST_PIECE(dt_, dkb_, dvb_, 2, lp_); } else if (st_ == 2) { ST_PIECE(dt_, dkb_, dvb_, 3, lp_); } \
            else if (NKD + 2 > 4) { ST_PIECE(dt_, dkb_, dvb_, NKD + 1, lp_); } } }); __builtin_amdgcn_s_setprio(0); } while (0)
    f32x4 sc[4][2]; bf16x8 p00, p01, p10, p11;
    int kb_ = 0, vb_ = 0, vprev = 0;
    ST_DMA(u.j_lo, 0, 0);
    if (u.j_lo + 1 < u.j_hi) ST_DMA(u.j_lo + 1, 1, 1);
#define TILE_TOP() do { if (t + 1 < u.j_hi) asm volatile("s_waitcnt vmcnt(%0)" :: "i"(NKD + 2) : "memory"); else VM_WAIT(); \
        asm volatile("s_waitcnt lgkmcnt(0)" ::: "memory"); __builtin_amdgcn_s_barrier(); asm volatile("" ::: "memory"); } while (0)
#define DT() ((t + 2 < u.j_hi) ? t + 2 : -1)
#define KB2() (kb_ == 0 ? 2 : kb_ - 1)
#define VB2() ((vb_ + 2) & 3)
#define TILE_NEXT() do { vprev = vb_; kb_ = kb_ == 2 ? 0 : kb_ + 1; vb_ = (vb_ + 1) & 3; } while (0)
    if (lead) {
        { const int t = u.j_lo; TILE_TOP(); QK_TILE(t, kb_); if (DT() >= 0) ST_DMA(DT(), KB2(), VB2()); SOFTMAX_TILE(); TILE_NEXT(); }
        for (int t = u.j_lo + 1; t < u.j_hi; ++t) { TILE_TOP(); PV_TILE(vprev, DT(), KB2(), VB2()); QK_TILE(t, kb_); SOFTMAX_TILE(); TILE_NEXT(); }
        PV_TILE(vprev, -1, 0, 0);
    } else {
        { const int t = u.j_lo; TILE_TOP(); QK_TILE(t, kb_); if (DT() >= 0) ST_DMA(DT(), KB2(), VB2()); TILE_NEXT(); }
        for (int t = u.j_lo + 1; t < u.j_hi; ++t) { TILE_TOP(); { const int vp_ = vprev; SOFTMAX_TILE(); PV_TILE(vp_, DT(), KB2(), VB2()); } QK_TILE(t, kb_); TILE_NEXT(); }
        SOFTMAX_TILE(); PV_TILE(vprev, -1, 0, 0);
    }
#undef TILE_TOP
#undef DT
#undef KB2
#undef VB2
#undef TILE_NEXT
    { const int le = lane_id_v(), ce = le & 15, ge = le >> 4;
    const float lt0 = sum_xor32(sum_xor16(l0)), lt1 = sum_xor32(sum_xor16(l1));
    const float i0 = __builtin_amdgcn_rcpf(lt0), i1 = __builtin_amdgcn_rcpf(lt1);
    bf16_t* Ow = u.O + (size_t)(wid * 32 + ce) * u.opitch + 4 * ge;
#pragma unroll
    for (int db = 0; db < 8; ++db) {
        u32x2 w0 = {cvtpk(o[db][0][0] * i0, o[db][0][1] * i0), cvtpk(o[db][0][2] * i0, o[db][0][3] * i0)}; *(u32x2*)(Ow + 16 * db) = w0;
        u32x2 w1 = {cvtpk(o[db][1][0] * i1, o[db][1][1] * i1), cvtpk(o[db][1][2] * i1, o[db][1][3] * i1)}; *(u32x2*)(Ow + 16 * u.opitch + 16 * db) = w1; }
    if (MODE == 1) { if (ge == 0) { u.lse[(size_t)(wid * 32 + ce) * u.lsepitch] = (mb_ + __log2f(lt0)) * LN2; u.lse[(size_t)(wid * 32 + 16 + ce) * u.lsepitch] = (mb_ + __log2f(lt1)) * LN2; } } }
    __syncthreads();
#undef ST_DMA
#undef ST_PIECE
#undef KSRC
#undef VSRC
#undef KFRD
#undef KADDR
#undef QK_TILE
#undef PKB
#undef SOFTMAX_TILE
#undef PV_TILE
}
}

constexpr size_t al256(size_t x) { return (x + 255) & ~(size_t)255; }
constexpr size_t WS_CTL = 0, CTL_BYTES = 1u << 20;
constexpr size_t WS_ROPE = WS_CTL + CTL_BYTES;
constexpr size_t WS_SSQ = WS_ROPE + al256((size_t)MTOK * 64 * 4);
constexpr size_t WS_XB = WS_SSQ + al256((size_t)MTOK * 32 * 4);
constexpr size_t WS_W = WS_XB + al256((size_t)MTOK * DM * 2);
constexpr size_t W_GU1 = 0, W_D1 = W_GU1 + (size_t)NGU * DM, W_IN = W_D1 + (size_t)DM * FF, W_UQ = W_IN + (size_t)NIN * DM, W_UKV = W_UQ + (size_t)1280 * 512,
                 W_M = W_UKV + (size_t)1536 * 256, W_OUT = W_M + (size_t)DM * YW, W_GU2 = W_OUT + (size_t)DM * DM,
                 W_D2 = W_GU2 + (size_t)NGU * DM, W_END = W_D2 + (size_t)DM * FF;
constexpr size_t WS_WSTRIDE = al256(W_END * 2);
constexpr size_t WS_R1 = WS_W + 2 * WS_WSTRIDE;
constexpr size_t WS_R2 = WS_R1 + al256((size_t)MTOK * U2W * 2);
constexpr size_t WS_QKV = WS_R2 + al256((size_t)MTOK * U1W * 2);
constexpr size_t QKV_Q = 0, QKV_K = (size_t)NB * 6 * SEQ * 192 * 2, QKV_V = 2 * QKV_K, QKV_END = QKV_V + (size_t)NB * 6 * SEQ * 128 * 2;
constexpr size_t WS_R3 = WS_QKV + al256(QKV_END);
constexpr size_t R3_QRAW = 0, R3_KVRAW = (size_t)MTOK * QRAW_LD * 2, R3_RAW_END = R3_KVRAW + (size_t)MTOK * KVRAW_LD * 2;
constexpr size_t R3_Y = 0, R3_DO = R3_Y + (size_t)MTOK * YW * 2, R3_LSE = R3_DO + (size_t)MTOK * 768 * 2;
constexpr size_t R3_END = (R3_LSE + (size_t)MTOK * 6 * 4) > R3_RAW_END ? (R3_LSE + (size_t)MTOK * 6 * 4) : R3_RAW_END;
constexpr size_t WS_GLA = WS_R3 + al256(R3_END);
constexpr size_t GLA_DS = 0, GLA_BC = (size_t)2048 * 8192 * 4, GLA_DEC = GLA_BC + (size_t)MTOK * 256 * 4, GLA_END = GLA_DEC + (size_t)2048 * 64 * 4;
constexpr size_t WS_END = WS_GLA + al256(GLA_END);
constexpr int CW_BAR = 1024;
constexpr int CW_QUEUE = 16384;

constexpr int RING_BYTES = 155648, LDSCTL_OFF = RING_BYTES, LDS_BYTES = 163840;
constexpr int NWAVES = 8, NTHR = 512;

#define XB_TMO      128
#define XB_XCNT(j)  (256  + 64 * (j))
#define XB_XSUB(j)  (1280 + 64 * (j))
#define XB_XGEN(j)  (2304 + 64 * (j))
#define XB_TOP      3328
#define XB_TOPGEN   3392
#define XCD_BAR_WORDS 3456
#define XB_SPIN_CAP (1u << 20)
__device__ __forceinline__ unsigned xb_ld(unsigned* p)              { return __hip_atomic_load(p, __ATOMIC_RELAXED, __HIP_MEMORY_SCOPE_AGENT); }
__device__ __forceinline__ unsigned xb_add(unsigned* p, unsigned v) { return __hip_atomic_fetch_add(p, v, __ATOMIC_RELAXED, __HIP_MEMORY_SCOPE_AGENT); }
__device__ __forceinline__ unsigned xb_xcc_id() { return (unsigned)__builtin_amdgcn_s_getreg((3 << 11) | 20) & 0xFu; }
#define XB_SPIN(cond, bar) do { unsigned _sp = 0; while (cond) { __builtin_amdgcn_s_sleep(1); \
    if ((++_sp & 255u) == 0u) { if (xb_ld(&(bar)[XB_TMO])) break; if (_sp > XB_SPIN_CAP) { atomicAdd(&(bar)[XB_TMO], 1u); break; } } } } while (0)
struct XcdBarrier { unsigned* bar; unsigned x; volatile LAS unsigned* st; int wv; };
__device__ __forceinline__ bool xb_thread0(int wv) { return wv == 0 && lane_id_v() == 0; }
__device__ __forceinline__ XcdBarrier xcd_barrier_post(unsigned* bar, volatile LAS unsigned* st, int wv) {
    XcdBarrier b; b.bar = bar; b.x = xb_xcc_id(); b.st = st; b.wv = wv;
    if (xb_thread0(wv)) (void)xb_add(&bar[XB_XCNT(b.x)], 1u);
    return b;
}
__device__ __forceinline__ void xcd_barrier_complete(unsigned* bar, unsigned x, unsigned& nloc, unsigned& nx) {
    const unsigned G = gridDim.x * gridDim.y * gridDim.z;
    unsigned sum, cnt, mine, sp = 0u;
    for (;;) {
        sum = 0u; cnt = 0u; mine = 0u;
#pragma unroll
        for (unsigned j = 0; j < 16; ++j) { const unsigned c = xb_ld(&bar[XB_XCNT(j)]); sum += c; cnt += (c > 0u) ? 1u : 0u; mine = (j == x) ? c : mine; }
        if (sum == G) break;
        __builtin_amdgcn_s_sleep(1);
        if ((++sp & 255u) == 0u) { if (xb_ld(&bar[XB_TMO])) break; if (sp > XB_SPIN_CAP) { atomicAdd(&bar[XB_TMO], 1u); break; } }
    }
    nloc = mine > 0u ? mine : 1u; nx = cnt > 0u ? cnt : 1u;
}
template <bool FIRST> __device__ __forceinline__ void xcd_barrier(const XcdBarrier& b) {
    asm volatile("s_waitcnt vmcnt(0)" ::: "memory");
    __syncthreads();
    if (xb_thread0(b.wv)) {
        unsigned* bar = b.bar;
        __builtin_amdgcn_s_waitcnt(0);
        unsigned nloc = b.st[0], nx = b.st[1];
        if (FIRST) { xcd_barrier_complete(bar, b.x, nloc, nx); b.st[0] = nloc; b.st[1] = nx; }
        const unsigned old = xb_add(&bar[XB_XSUB(b.x)], 1u);
        const unsigned gen = old / nloc;
        if (old + 1u == (gen + 1u) * nloc) {
            __builtin_amdgcn_fence(__ATOMIC_RELEASE, "agent");
            asm volatile("s_waitcnt vmcnt(0)" ::: "memory");
            const unsigned og = xb_add(&bar[XB_TOP], 1u);
            const unsigned tg = og / nx;
            if (og + 1u == (tg + 1u) * nx) xb_add(&bar[XB_TOPGEN], 1u);
            else XB_SPIN(xb_ld(&bar[XB_TOPGEN]) == tg, bar);
            __builtin_amdgcn_fence(__ATOMIC_ACQUIRE, "agent");
            xb_add(&bar[XB_XGEN(b.x)], 1u);
            asm volatile("s_waitcnt vmcnt(0)" ::: "memory");
        } else {
            XB_SPIN(xb_ld(&bar[XB_XGEN(b.x)]) == gen, bar);
            __builtin_amdgcn_fence(__ATOMIC_ACQUIRE, "agent");
            asm volatile("s_waitcnt vmcnt(0)" ::: "memory");
        }
    }
    __syncthreads();
}

struct Args { const float* in[27]; float* out; unsigned char* ws; int ph_lo, ph_hi, qsel, pad; };
struct Ctx { unsigned char* ws; volatile LAS unsigned long long* ptab;
#ifdef PROBE_ATT_VAR
    unsigned char* outp;
#endif
    __device__ __forceinline__ const float* in(int i) const { const unsigned long long v = ptab[i];
        const unsigned lo = __builtin_amdgcn_readfirstlane((unsigned)v), hi = __builtin_amdgcn_readfirstlane((unsigned)(v >> 32)); return (const float*)(((unsigned long long)hi << 32) | lo); } };
enum { I_X = 0, I_POS, I_F1N, I_F1G, I_F1U, I_F1D, I_MIXN, I_WIN, I_CQN, I_CKVN, I_WUQ, I_WUKV, I_QN, I_KN, I_WG2, I_BG2, I_ON, I_DQN, I_DKN, I_WA, I_WB, I_WC, I_WOUT, I_F2N, I_F2G, I_F2U, I_F2D };

__device__ __forceinline__ int win_map(int n) {
    if (n < 768) return n;
    if (n < 1024) return 832 + (n - 768);
    if (n < 1280) return 1088 + (n - 1024);
    if (n < 1792) return 1344 + (n - 1280);
    if (n < 2560) return 2384 + (n - 1792);
    if (n < 3328) return 3152 + (n - 2560);
    if (n < 4096) return 3920 + (n - 3328);
    if (n < 4160) return 768 + (n - 4096);
    if (n < 4176) return 1856 + (n - 4160);
    if (n < 4352) return -1;
    if (n < 4864) return 1872 + (n - 4352);
    return 4688 + (n - 4864);
}
struct WMat { const float* src; const float* src2; const float* gain; bf16_t* dst; int K, Nsrc, Ndst, kind, ldd; };
__device__ __forceinline__ void wconv_item(const WMat& w, int item, LAS float* scr, int lane) {
    const int nblk = w.Ndst / 32, kb = item / nblk, nb = item % nblk, k0 = 64 * kb, n0 = 32 * nb;
    const int cq = lane & 7, kr = lane >> 3, nn = n0 + 4 * cq;
    const float* sp = w.src; int scol = nn; bool valid = true;
    if (w.kind == 1) { const int tile = nn >> 8; int wi = nn & 255; if (wi >= 128) { sp = w.src2; wi -= 128; } scol = tile * 128 + wi; }
    else if (w.kind == 2) { scol = win_map(nn); valid = scol >= 0; }
    else valid = nn < w.Nsrc;
    if (!valid) scol = 0;
    f32x4 v[8]; float g[8];
#pragma unroll
    for (int i = 0; i < 8; ++i) { const int kk = 8 * i + kr; v[i] = *(const f32x4*)(sp + (size_t)(k0 + kk) * w.Nsrc + scol); g[i] = w.gain ? w.gain[k0 + kk] : 1.f; }
#pragma unroll
    for (int i = 0; i < 8; ++i) { const int kk = 8 * i + kr; LAS float* d = scr + kk * 33 + 4 * cq; const float gg = valid ? g[i] : 0.f;
        d[0] = v[i][0] * gg; d[1] = v[i][1] * gg; d[2] = v[i][2] * gg; d[3] = v[i][3] * gg; }
    LDS_WAIT(); asm volatile("" ::: "memory");
    const int c = lane & 7;
#pragma unroll
    for (int j = 0; j < 4; ++j) { const int n = (lane >> 3) + 8 * j; const LAS float* s = scr + (8 * c) * 33 + n;
        u32x4 o; o.x = pk2(s[0 * 33], s[1 * 33]); o.y = pk2(s[2 * 33], s[3 * 33]); o.z = pk2(s[4 * 33], s[5 * 33]); o.w = pk2(s[6 * 33], s[7 * 33]);
        *(u32x4*)(w.dst + (size_t)(n0 + n) * (w.ldd ? w.ldd : w.K) + k0 + 8 * c) = o; }
    LDS_WAIT(); asm volatile("" ::: "memory");
}
constexpr int wc_items(int K, int Ndst) { return (K / 64) * (Ndst / 32); }
constexpr int WI_GU = wc_items(DM, NGU), WI_D = wc_items(FF, DM), WI_IN = wc_items(DM, NIN), WI_UQ = wc_items(512, 1280), WI_UKV = wc_items(256, 1536),
              WI_A = wc_items(768, DM), WI_B = wc_items(512, DM), WI_C = wc_items(256, DM), WI_OUT = wc_items(DM, DM);
constexpr int WI_TOTAL = 2 * WI_GU + 2 * WI_D + WI_IN + WI_UQ + WI_UKV + WI_A + WI_B + WI_C + WI_OUT;
constexpr int WG_0 = 0, WG_1 = WI_GU, WG_2 = WI_GU + WI_D + WI_IN, WG_3 = WI_TOTAL - WI_D, WG_4 = WI_TOTAL;

__device__ __forceinline__ void phase_wconv(const Ctx& a, int l, LAS unsigned char* lds, int gw, int NGW, int wave, int lane, int it0 = 0, int it1 = WI_TOTAL) {
    LAS float* scr = (LAS float*)(lds + wave * 16384);
    bf16_t* W = (bf16_t*)(a.ws + WS_W + (size_t)(l & 1) * WS_WSTRIDE);
    const size_t oFF = (size_t)l * DM * FF;
    for (int it = it0 + gw; it < it1; it += NGW) {
        int r = it; WMat w;
        if (r < WI_GU) { w = WMat{a.in(I_F1G) + oFF, a.in(I_F1U) + oFF, a.in(I_F1N) + (size_t)l * DM, W + W_GU1, DM, FF, NGU, 1, 0}; }
        else if ((r -= WI_GU) < WI_D) { w = WMat{a.in(I_F1D) + oFF, nullptr, nullptr, W + W_D1, FF, DM, DM, 0, 0}; }
        else if ((r -= WI_D) < WI_IN) { w = WMat{a.in(I_WIN) + (size_t)l * DM * 10832, nullptr, a.in(I_MIXN) + (size_t)l * DM, W + W_IN, DM, 10832, NIN, 2, 0}; }
        else if ((r -= WI_IN) < WI_GU) { w = WMat{a.in(I_F2G) + oFF, a.in(I_F2U) + oFF, a.in(I_F2N) + (size_t)l * DM, W + W_GU2, DM, FF, NGU, 1, 0}; }
        else if ((r -= WI_GU) < WI_OUT) { w = WMat{a.in(I_WOUT) + (size_t)l * DM * DM, nullptr, nullptr, W + W_OUT, DM, DM, DM, 0, 0}; }
        else if ((r -= WI_OUT) < WI_A) { w = WMat{a.in(I_WA) + (size_t)l * 768 * DM, nullptr, nullptr, W + W_M, 768, DM, DM, 0, YW}; }
        else if ((r -= WI_A) < WI_B) { w = WMat{a.in(I_WB) + (size_t)l * 512 * DM, nullptr, nullptr, W + W_M + 768, 512, DM, DM, 0, YW}; }
        else if ((r -= WI_B) < WI_C) { w = WMat{a.in(I_WC) + (size_t)l * 256 * DM, nullptr, nullptr, W + W_M + 1280, 256, DM, DM, 0, YW}; }
        else if ((r -= WI_C) < WI_UQ) { w = WMat{a.in(I_WUQ) + (size_t)l * 512 * 1152, nullptr, a.in(I_CQN) + (size_t)l * 512, W + W_UQ, 512, 1152, 1280, 0, 0}; }
        else if ((r -= WI_UQ) < WI_UKV) { w = WMat{a.in(I_WUKV) + (size_t)l * 256 * 1536, nullptr, a.in(I_CKVN) + (size_t)l * 256, W + W_UKV, 256, 1536, 1536, 0, 0}; }
        else { r -= WI_UKV; w = WMat{a.in(I_F2D) + oFF, nullptr, nullptr, W + W_D2, FF, DM, DM, 0, 0}; }
        wconv_item(w, r, scr, lane);
    }
}

__device__ __forceinline__ void phase_prologue(const Ctx& a, int gw, int NGW, int lane, bf16_t* xl) {
    const int* pos = (const int*)a.in(I_POS);
    float* ropec = (float*)(a.ws + WS_ROPE); float* ropes = ropec + (size_t)MTOK * 32;
    const int i = lane & 31; const float invf = exp2f(-(float)i * 0.41524101186092029f);
    for (int p = gw; p < MTOK / 2; p += NGW) { const int tok = 2 * p + (lane >> 5); const float ang = (float)pos[tok] * invf; float sn, cs; sincosf(ang, &sn, &cs);
        ropec[(size_t)tok * 32 + i] = cs; ropes[(size_t)tok * 32 + i] = sn; }
    const float* x = a.in(I_X); bf16_t* xb = (bf16_t*)(a.ws + WS_XB); float* ssq = (float*)(a.ws + WS_SSQ);
    for (int m = gw; m < MTOK; m += NGW) { const f32x4* xr = (const f32x4*)(x + (size_t)m * DM) + lane; u32x2* o8 = (u32x2*)(xb + ((size_t)((m >> 8) * 32 + (lane >> 4)) * 256 + (m & 255)) * 64) + (lane & 15);        u32x2* l8 = (u32x2*)(xl + (size_t)m * DM) + lane; float s = 0.f;
#pragma unroll
        for (int j = 0; j < 8; ++j) { const f32x4 v = xr[64 * j]; s += (v[0] * v[0] + v[1] * v[1]) + (v[2] * v[2] + v[3] * v[3]); u32x2 w; w.x = pk2(v[0], v[1]); w.y = pk2(v[2], v[3]); o8[(size_t)j * 4 * 256 * 16] = w;
            if (RESID_LO) { u32x2 wl; wl.x = pk2(v[0] - __uint_as_float(w.x << 16), v[1] - __uint_as_float(w.x & 0xffff0000u)); wl.y = pk2(v[2] - __uint_as_float(w.y << 16), v[3] - __uint_as_float(w.y & 0xffff0000u)); l8[64 * j] = wl; } }
        s += lane_xor1(s); if ((lane & 1) == 0) ssq[(size_t)m * 32 + (lane >> 1)] = s; }
}

__device__ __forceinline__ float row16_sum(float x) { return sum_row16(x); }
__device__ __forceinline__ void unpk4(const u32x2 w, float (&f)[4]) { f[0] = __uint_as_float(w.x << 16); f[1] = __uint_as_float(w.x & 0xffff0000u); f[2] = __uint_as_float(w.y << 16); f[3] = __uint_as_float(w.y & 0xffff0000u); }
__device__ __forceinline__ void unpk8(const u32x4 w, float (&f)[8]) { f[0] = __uint_as_float(w.x << 16); f[1] = __uint_as_float(w.x & 0xffff0000u); f[2] = __uint_as_float(w.y << 16); f[3] = __uint_as_float(w.y & 0xffff0000u);
    f[4] = __uint_as_float(w.z << 16); f[5] = __uint_as_float(w.z & 0xffff0000u); f[6] = __uint_as_float(w.w << 16); f[7] = __uint_as_float(w.w & 0xffff0000u); }
__device__ __forceinline__ float ssq8(const u32x4 w) { float f[8]; unpk8(w, f); return ((f[0] * f[0] + f[1] * f[1]) + (f[2] * f[2] + f[3] * f[3])) + ((f[4] * f[4] + f[5] * f[5]) + (f[6] * f[6] + f[7] * f[7])); }
__device__ __forceinline__ void rope4(float (&x)[4], const f32x4 cs, const f32x4 sn, bool first) {
#pragma unroll
    for (int e = 0; e < 4; ++e) { const float xp = dppx<0x128>(x[e]); x[e] = first ? x[e] * cs[e] - xp * sn[e] : xp * sn[e] + x[e] * cs[e]; }
}
__device__ __forceinline__ void phase_prep(const Ctx& a, int l, int gw, int NGW, int lane, bool do_dswa) {
    bf16_t* u1 = (bf16_t*)(a.ws + WS_R2);
    const bf16_t* qraw = (const bf16_t*)(a.ws + WS_R3 + R3_QRAW); const bf16_t* kvraw = (const bf16_t*)(a.ws + WS_R3 + R3_KVRAW);
    const float* ropec = (const float*)(a.ws + WS_ROPE); const float* ropes = ropec + (size_t)MTOK * 32;
    bf16_t* Qo = (bf16_t*)(a.ws + WS_QKV + QKV_Q); bf16_t* Ko = (bf16_t*)(a.ws + WS_QKV + QKV_K); bf16_t* Vo = (bf16_t*)(a.ws + WS_QKV + QKV_V);
    const int t = lane & 15, g4 = lane >> 4; const bool first = t < 8;
    const float* gq = a.in(I_QN) + (size_t)l * 192; const float* gk = a.in(I_KN) + (size_t)l * 192;
    const f32x4 gq0 = *(const f32x4*)(gq + 4 * t), gq1 = *(const f32x4*)(gq + 64 + 4 * t), gq2 = *(const f32x4*)(gq + 128 + 4 * t);
    const f32x4 gka = *(const f32x4*)(gk + 8 * t), gkb = *(const f32x4*)(gk + 8 * t + 4), gkr = *(const f32x4*)(gk + 128 + 4 * t);
    const float* dq = a.in(I_DQN) + (size_t)l * 128; const float* dk = a.in(I_DKN) + (size_t)l * 128;
    const f32x4 dqa = *(const f32x4*)(dq + 8 * t), dqb = *(const f32x4*)(dq + 8 * t + 4), dka = *(const f32x4*)(dk + 8 * t), dkb = *(const f32x4*)(dk + 8 * t + 4);
    for (int qd = gw; qd < MTOK / 4; qd += NGW) {
        const int row = 4 * qd + g4; bf16_t* ur = u1 + (size_t)row * U1W; const int b = row / SEQ, s = row % SEQ;
        float q = 0.f;
#pragma unroll
        for (int j = 0; j < 4; ++j) q += ssq8(*(const u32x4*)(ur + C_CQ + 8 * t + 128 * j));
        const float rstd_cq = rsqrtf(row16_sum(q) * (1.f / 512.f) + EPS);
        q = ssq8(*(const u32x4*)(ur + C_CKV + 8 * t)) + ssq8(*(const u32x4*)(ur + C_CKV + 128 + 8 * t));
        const float rstd_ckv = rsqrtf(row16_sum(q) * (1.f / 256.f) + EPS);
        float kr[4]; unpk4(*(const u32x2*)(ur + C_KROPE + 4 * t), kr);
        const float ssq_kr = row16_sum((kr[0] * kr[0] + kr[1] * kr[1]) + (kr[2] * kr[2] + kr[3] * kr[3]));
        const f32x4 cs = *(const f32x4*)(ropec + (size_t)row * 32 + 4 * (t & 7)), sn = *(const f32x4*)(ropes + (size_t)row * 32 + 4 * (t & 7));
#pragma unroll 2
        for (int h = 0; h < 6; ++h) {
            const bf16_t* qp = qraw + (size_t)row * QRAW_LD + h * 192 + 4 * t;
            float x0[4], x1[4], x2[4]; unpk4(*(const u32x2*)qp, x0); unpk4(*(const u32x2*)(qp + 64), x1); unpk4(*(const u32x2*)(qp + 128), x2);
            float ss = 0.f;
#pragma unroll
            for (int e = 0; e < 4; ++e) { x0[e] *= rstd_cq; x1[e] *= rstd_cq; x2[e] *= rstd_cq; ss += x0[e] * x0[e] + x1[e] * x1[e] + x2[e] * x2[e]; }
            const float rq = rsqrtf(row16_sum(ss) * (1.f / 192.f) + EPS);
#pragma unroll
            for (int e = 0; e < 4; ++e) { x0[e] *= rq * gq0[e]; x1[e] *= rq * gq1[e]; x2[e] *= rq * gq2[e]; }
            rope4(x2, cs, sn, first);
            bf16_t* qo = Qo + ((size_t)((b * 6 + h) * SEQ + s)) * 192 + 4 * t;
            { u32x2 w; w.x = pk2(x0[0] * QS_MLA, x0[1] * QS_MLA); w.y = pk2(x0[2] * QS_MLA, x0[3] * QS_MLA); *(u32x2*)qo = w;
              w.x = pk2(x1[0] * QS_MLA, x1[1] * QS_MLA); w.y = pk2(x1[2] * QS_MLA, x1[3] * QS_MLA); *(u32x2*)(qo + 64) = w;
              w.x = pk2(x2[0] * QS_MLA, x2[1] * QS_MLA); w.y = pk2(x2[2] * QS_MLA, x2[3] * QS_MLA); *(u32x2*)(qo + 128) = w; }
            const bf16_t* kp = kvraw + (size_t)row * KVRAW_LD + h * 256 + 8 * t;
            float kn[8], vv[8]; unpk8(*(const u32x4*)kp, kn); unpk8(*(const u32x4*)(kp + 128), vv);
            ss = 0.f;
#pragma unroll
            for (int e = 0; e < 8; ++e) { kn[e] *= rstd_ckv; vv[e] *= rstd_ckv; ss += kn[e] * kn[e]; }
            const float rk = rsqrtf((row16_sum(ss) + ssq_kr) * (1.f / 192.f) + EPS);
            float kx[4];
#pragma unroll
            for (int e = 0; e < 4; ++e) { kn[e] *= rk * gka[e]; kn[4 + e] *= rk * gkb[e]; kx[e] = kr[e] * rk * gkr[e]; }
            rope4(kx, cs, sn, first);
            bf16_t* ko = Ko + ((size_t)((b * 6 + h) * SEQ + s)) * 192;
            { u32x4 w; w.x = pk2(kn[0], kn[1]); w.y = pk2(kn[2], kn[3]); w.z = pk2(kn[4], kn[5]); w.w = pk2(kn[6], kn[7]); *(u32x4*)(ko + 8 * t) = w;
              u32x2 w2; w2.x = pk2(kx[0], kx[1]); w2.y = pk2(kx[2], kx[3]); *(u32x2*)(ko + 128 + 4 * t) = w2;
              w.x = pk2(vv[0], vv[1]); w.y = pk2(vv[2], vv[3]); w.z = pk2(vv[4], vv[5]); w.w = pk2(vv[6], vv[7]);
              *(u32x4*)(Vo + ((size_t)((b * 6 + h) * SEQ + s)) * 128 + 8 * t) = w; }
        }
        if (do_dswa)
#pragma unroll 2
        for (int h = 0; h < 6; ++h) {
            u32x4* qp = (u32x4*)(ur + C_QC + h * 128 + 8 * t); u32x4* kp = (u32x4*)(ur + C_KC + h * 128 + 8 * t);
            float qv[8], kv[8]; unpk8(*qp, qv); unpk8(*kp, kv);
            float sq = 0.f, sk = 0.f;
#pragma unroll
            for (int e = 0; e < 8; ++e) { sq += qv[e] * qv[e]; sk += kv[e] * kv[e]; }
            const float rq = rsqrtf(row16_sum(sq) * (1.f / 128.f) + EPS) * QS_DSWA, rk = rsqrtf(row16_sum(sk) * (1.f / 128.f) + EPS);
            u32x4 w; w.x = pk2(qv[0] * rq * dqa[0], qv[1] * rq * dqa[1]); w.y = pk2(qv[2] * rq * dqa[2], qv[3] * rq * dqa[3]); w.z = pk2(qv[4] * rq * dqb[0], qv[5] * rq * dqb[1]); w.w = pk2(qv[6] * rq * dqb[2], qv[7] * rq * dqb[3]); *qp = w;
            w.x = pk2(kv[0] * rk * dka[0], kv[1] * rk * dka[1]); w.y = pk2(kv[2] * rk * dka[2], kv[3] * rk * dka[3]); w.z = pk2(kv[4] * rk * dkb[0], kv[5] * rk * dkb[1]); w.w = pk2(kv[6] * rk * dkb[2], kv[7] * rk * dkb[3]); *kp = w;
        }
    }
}

__device__ __forceinline__ float logsigmoidf_(float z) { return fminf(z, 0.f) - log1pf(expf(-fabsf(z))); }
__device__ __forceinline__ int crow32(int r, int hi) { return (r & 3) + 8 * (r >> 2) + 4 * hi; }
template <int SA, int SB> __device__ __forceinline__ f32x16 mfma16_f32src(const LAS float* pa, const LAS float* pb, f32x16 acc) {
    float a[8], b[8];
#pragma unroll
    for (int j = 0; j < 8; ++j) { a[j] = pa[j * SA]; b[j] = pb[j * SB]; }
    u32x4 wa = {att::cvtpk(a[0], a[1]), att::cvtpk(a[2], a[3]), att::cvtpk(a[4], a[5]), att::cvtpk(a[6], a[7])}, wb = {att::cvtpk(b[0], b[1]), att::cvtpk(b[2], b[3]), att::cvtpk(b[4], b[5]), att::cvtpk(b[6], b[7])};
    return __builtin_amdgcn_mfma_f32_32x32x16_bf16(*reinterpret_cast<bf16x8*>(&wa), *reinterpret_cast<bf16x8*>(&wb), acc, 0, 0, 0);
}
__device__ __forceinline__ void gla_local(const Ctx& a, int l, LAS unsigned char* lds, int G, int bid, const int wv) {
    int tid_ = wv * 64 + lane_id_v(); asm volatile("" : "+v"(tid_));
    const int tid = tid_, wid = __builtin_amdgcn_readfirstlane(tid >> 6), lane = tid & 63, l32 = lane & 31, hi = lane >> 5;
    LAS float* kd = (LAS float*)lds; LAS float* vv = (LAS float*)(lds + 16640); LAS float* tot = (LAS float*)(lds + 16640 + 32768);
    const bf16_t* u1 = (const bf16_t*)(a.ws + WS_R2);
    float* dS = (float*)(a.ws + WS_GLA + GLA_DS); float* bcum = (float*)(a.ws + WS_GLA + GLA_BC); float* dec = (float*)(a.ws + WS_GLA + GLA_DEC);
    const float* w2 = a.in(I_WG2) + (size_t)l * 16 * 256; const float* b2 = a.in(I_BG2) + (size_t)l * 256;
    const int d = lane, tg = wid;
    struct GLLoad { float w2c[16]; float bias; bf16x8 g0[8], g1[8]; bf16_t kraw[8]; bf16x8 v0, v1; };
    auto gl_load = [&](int ci, GLLoad& L) {
        const int bh = ci >> 8, c = ci & 255, b = bh >> 2, h = bh & 3, row0 = b * SEQ + 64 * c;
#pragma unroll
        for (int j = 0; j < 16; ++j) L.w2c[j] = w2[j * 256 + h * 64 + d];
        L.bias = b2[h * 64 + d];
#pragma unroll
        for (int i = 0; i < 8; ++i) { const int t = tg * 8 + i; const bf16_t* gl = u1 + (size_t)(row0 + t) * U1W + C_GLR; L.g0[i] = *(const bf16x8*)gl; L.g1[i] = *(const bf16x8*)(gl + 8);
            L.kraw[i] = u1[(size_t)(row0 + t) * U1W + C_KB + h * 64 + d]; }
        const int t = tid >> 3, c0 = (tid & 7) * 16; const bf16_t* vp = u1 + (size_t)(row0 + t) * U1W + C_VB + h * 128 + c0;
        L.v0 = *(const bf16x8*)vp; L.v1 = *(const bf16x8*)(vp + 8); };
    GLLoad L;
    if (bid < 2048) gl_load(bid, L);
    for (int ci = bid; ci < 2048; ci += G) {
        const int bh = ci >> 8, c = ci & 255, b = bh >> 2, h = bh & 3, row0 = b * SEQ + 64 * c;
        float bcv[8]; float run = 0.f;
#pragma unroll
        for (int i = 0; i < 8; ++i) { float z = L.bias;
#pragma unroll
            for (int j = 0; j < 8; ++j) { z += bf2f((bf16_t)L.g0[i][j]) * L.w2c[j]; z += bf2f((bf16_t)L.g1[i][j]) * L.w2c[8 + j]; }
            run += logsigmoidf_(z) * (1.f / 16.f); bcv[i] = run; }
        tot[tg * 64 + d] = run;
        bf16_t kraw[8];
#pragma unroll
        for (int i = 0; i < 8; ++i) kraw[i] = L.kraw[i];
        { const int t = tid >> 3, c0 = (tid & 7) * 16;
#pragma unroll
          for (int j = 0; j < 8; ++j) { vv[t * 128 + c0 + j] = bf2f((bf16_t)L.v0[j]); vv[t * 128 + c0 + 8 + j] = bf2f((bf16_t)L.v1[j]); } }
        if (ci + G < 2048) gl_load(ci + G, L);
        __syncthreads();
        float off = 0.f, bend = 0.f;
#pragma unroll
        for (int g = 0; g < 8; ++g) { const float x = tot[g * 64 + d]; bend += x; if (g < tg) off += x; }
#pragma unroll
        for (int i = 0; i < 8; ++i) { const int t = tg * 8 + i; const float bc = bcv[i] + off;
            bcum[(size_t)(row0 + t) * 256 + h * 64 + d] = bc;
            const float kk = bf2f(kraw[i]);
            kd[t * 65 + d] = kk * expf(bend - bc); }
        if (tg == 0) dec[(size_t)ci * 64 + d] = expf(bend);
        __syncthreads();
        { const int di = wid >> 2, ei = wid & 3; f32x16 acc = {};
#pragma unroll
          for (int k0 = 0; k0 < 64; k0 += 16) acc = mfma16_f32src<65, 128>(kd + (k0 + 8 * hi) * 65 + 32 * di + l32, vv + (k0 + 8 * hi) * 128 + 32 * ei + l32, acc);
          float* dst = dS + (size_t)ci * 8192;
#pragma unroll
          for (int r = 0; r < 16; ++r) dst[(32 * di + crow32(r, hi)) * 128 + 32 * ei + l32] = acc[r]; }
        __syncthreads();
    }
}
__device__ __forceinline__ void gla_scan(const Ctx& a, int bid, const int wv) {
    float* dS = (float*)(a.ws + WS_GLA + GLA_DS); const float* dec = (const float*)(a.ws + WS_GLA + GLA_DEC);
    int tid_ = wv * 64 + lane_id_v(); asm volatile("" : "+v"(tid_));
    const int gid = bid * NTHR + tid_, bh = gid >> 11, de = (gid & 2047) * 4, d = de >> 7;
    f32x4 st = {0.f, 0.f, 0.f, 0.f}; float* p = dS + (size_t)bh * 256 * 8192 + de; const float* dc = dec + (size_t)bh * 256 * 64 + d;
    for (int c = 0; c < 256; c += 8) { f32x4 x[8]; float g[8];
#pragma unroll
        for (int i = 0; i < 8; ++i) { x[i] = *(const f32x4*)(p + (size_t)(c + i) * 8192); g[i] = dc[(c + i) * 64]; }
#pragma unroll
        for (int i = 0; i < 8; ++i) { *(f32x4*)(p + (size_t)(c + i) * 8192) = st; st = st * g[i] + x[i]; } }
}
__device__ __forceinline__ void gla_out(const Ctx& a, int l, LAS unsigned char* lds, int G, int bid, const int wv) {
    int tid_ = wv * 64 + lane_id_v(); asm volatile("" : "+v"(tid_));
    const int tid = tid_, wid = __builtin_amdgcn_readfirstlane(tid >> 6), lane = tid & 63, l32 = lane & 31, hi = lane >> 5;
    LAS float* qe = (LAS float*)lds; LAS float* ke = (LAS float*)(lds + 16640); LAS float* At = (LAS float*)(lds + 33280);
    LAS float* vv = (LAS float*)(lds + 49920); LAS float* Sp = (LAS float*)(lds + 82688);
    const bf16_t* u1 = (const bf16_t*)(a.ws + WS_R2);
    const float* dS = (const float*)(a.ws + WS_GLA + GLA_DS); const float* bcum = (const float*)(a.ws + WS_GLA + GLA_BC);
    bf16_t* yb = (bf16_t*)(a.ws + WS_R3 + R3_Y) + 768; const float* go = a.in(I_ON) + (size_t)l * 128;
    struct GOLoad { float bc[8]; bf16_t q[8], k[8]; bf16x8 v0, v1, r0, r1; f32x4 sp[4]; };
    auto go_load = [&](int ci, GOLoad& L) {
        const int bh = ci >> 8, c = ci & 255, b = bh >> 2, h = bh & 3, row0 = b * SEQ + 64 * c;
#pragma unroll
        for (int i = 0; i < 8; ++i) { const int t = wid * 8 + i; L.bc[i] = bcum[(size_t)(row0 + t) * 256 + h * 64 + lane];
            L.q[i] = u1[(size_t)(row0 + t) * U1W + C_QB + h * 64 + lane]; L.k[i] = u1[(size_t)(row0 + t) * U1W + C_KB + h * 64 + lane]; }
        const int t = tid >> 3, c0 = (tid & 7) * 16; const bf16_t* vp = u1 + (size_t)(row0 + t) * U1W + C_VB + h * 128 + c0; const bf16_t* rp = u1 + (size_t)(row0 + t) * U1W + C_RB + h * 128 + c0;
        L.v0 = *(const bf16x8*)vp; L.v1 = *(const bf16x8*)(vp + 8); L.r0 = *(const bf16x8*)rp; L.r1 = *(const bf16x8*)(rp + 8);
        const f32x4* sp = (const f32x4*)(dS + (size_t)ci * 8192) + tid * 4;
#pragma unroll
        for (int j = 0; j < 4; ++j) L.sp[j] = sp[j]; };
    GOLoad L;
    if (bid < 2048) go_load(bid, L);
    for (int ci = bid; ci < 2048; ci += G) {
        const int bh = ci >> 8, c = ci & 255, b = bh >> 2, h = bh & 3, row0 = b * SEQ + 64 * c;
        { const int d = lane, tg = wid;
#pragma unroll
          for (int i = 0; i < 8; ++i) { const int t = tg * 8 + i; const float bc = L.bc[i];
              const float q = bf2f(L.q[i]), k = bf2f(L.k[i]);
              qe[t * 65 + d] = q * 0.125f * expf(bc); ke[t * 65 + d] = k * expf(-bc); } }
        bf16x8 rr0, rr1;
        { const int t = tid >> 3, c0 = (tid & 7) * 16;
#pragma unroll
          for (int j = 0; j < 8; ++j) { vv[t * 128 + c0 + j] = bf2f((bf16_t)L.v0[j]); vv[t * 128 + c0 + 8 + j] = bf2f((bf16_t)L.v1[j]); }
          rr0 = L.r0; rr1 = L.r1;
#pragma unroll
          for (int j = 0; j < 4; ++j) *(LAS f32x4*)(Sp + tid * 16 + j * 4) = L.sp[j]; }
        if (ci + G < 2048) go_load(ci + G, L);
        __syncthreads();
        if (wid < 4) {
            if (wid < 3) { const int ti = wid == 0 ? 0 : 1, si = wid == 2 ? 1 : 0; f32x16 acc = {};
#pragma unroll
                for (int k0 = 0; k0 < 64; k0 += 16) acc = mfma16_f32src<1, 1>(qe + (32 * ti + l32) * 65 + k0 + 8 * hi, ke + (32 * si + l32) * 65 + k0 + 8 * hi, acc);
#pragma unroll
                for (int r = 0; r < 16; ++r) { const int t = 32 * ti + crow32(r, hi), s = 32 * si + l32; At[t * 65 + s] = (s <= t) ? acc[r] : 0.f; } }
            else {
#pragma unroll
                for (int r = 0; r < 16; ++r) At[crow32(r, hi) * 65 + 32 + l32] = 0.f; }
        }
        __syncthreads();
        f32x16 acc = {}; const int ti = wid >> 2, ei = wid & 3;
#pragma unroll
        for (int k0 = 0; k0 < 64; k0 += 16) acc = mfma16_f32src<1, 128>(At + (32 * ti + l32) * 65 + k0 + 8 * hi, vv + (k0 + 8 * hi) * 128 + 32 * ei + l32, acc);
#pragma unroll
        for (int k0 = 0; k0 < 64; k0 += 16) acc = mfma16_f32src<1, 128>(qe + (32 * ti + l32) * 65 + k0 + 8 * hi, Sp + (k0 + 8 * hi) * 128 + 32 * ei + l32, acc);
        __syncthreads();
#pragma unroll
        for (int r = 0; r < 16; ++r) Sp[(32 * ti + crow32(r, hi)) * 128 + 32 * ei + l32] = acc[r];
        __syncthreads();
        { const int t = tid >> 3, e0 = (tid & 7) * 16; float ov[16]; float ss = 0.f;
#pragma unroll
          for (int j = 0; j < 4; ++j) { const f32x4 x = *(const LAS f32x4*)(Sp + t * 128 + e0 + 4 * j); ov[4 * j] = x[0]; ov[4 * j + 1] = x[1]; ov[4 * j + 2] = x[2]; ov[4 * j + 3] = x[3];
              ss += (x[0] * x[0] + x[1] * x[1]) + (x[2] * x[2] + x[3] * x[3]); }
          ss += dppx<0xB1>(ss); ss += dppx<0x4E>(ss); ss += dppx<0x141>(ss);
          const float rs = rsqrtf(ss * (1.f / 128.f) + EPS);
          const bf16x8 r0 = rr0, r1 = rr1;
          unsigned w[8];
#pragma unroll
          for (int j = 0; j < 4; ++j) { w[j] = pk2(ov[2 * j] * rs * go[e0 + 2 * j] * bf2f((bf16_t)r0[2 * j]), ov[2 * j + 1] * rs * go[e0 + 2 * j + 1] * bf2f((bf16_t)r0[2 * j + 1]));
              w[4 + j] = pk2(ov[8 + 2 * j] * rs * go[e0 + 8 + 2 * j] * bf2f((bf16_t)r1[2 * j]), ov[8 + 2 * j + 1] * rs * go[e0 + 8 + 2 * j + 1] * bf2f((bf16_t)r1[2 * j + 1])); }
          u32x4* yo = (u32x4*)(yb + (size_t)(row0 + t) * YW + h * 128 + e0);
          yo[0] = (u32x4){w[0], w[1], w[2], w[3]}; yo[1] = (u32x4){w[4], w[5], w[6], w[7]}; }
        __syncthreads();
    }
}
__device__ __forceinline__ void dswa_combine(const Ctx& a, int gw, int NGW, int lane) {
    const bf16_t* dout = (const bf16_t*)(a.ws + WS_R3 + R3_DO); const float* lse = (const float*)(a.ws + WS_R3 + R3_LSE); bf16_t* yc = (bf16_t*)(a.ws + WS_R3 + R3_Y) + 1280;
    const int hp = lane >> 5, e = 4 * (lane & 31);
    for (int row0 = gw; row0 < MTOK; row0 += 4 * NGW) {
        float l0[4], l1[4], l2[4]; u32x2 a0[4], a1[4], a2[4];
#pragma unroll
        for (int i = 0; i < 4; ++i) { const int row = row0 + i * NGW < MTOK ? row0 + i * NGW : row0;
            l0[i] = lse[(size_t)row * 6 + hp]; l1[i] = lse[(size_t)row * 6 + 2 + hp]; l2[i] = lse[(size_t)row * 6 + 4 + hp];
            a0[i] = *(const u32x2*)(dout + (size_t)row * 768 + hp * 128 + e); a1[i] = *(const u32x2*)(dout + (size_t)row * 768 + (2 + hp) * 128 + e); a2[i] = *(const u32x2*)(dout + (size_t)row * 768 + (4 + hp) * 128 + e); }
#pragma unroll
        for (int i = 0; i < 4; ++i) { const int row = row0 + i * NGW; if (row >= MTOK) break;
            const float mx = fmaxf(l0[i], fmaxf(l1[i], l2[i])); float w0 = expf(l0[i] - mx), w1 = expf(l1[i] - mx), w2 = expf(l2[i] - mx); const float inv = 1.f / (w0 + w1 + w2); w0 *= inv; w1 *= inv; w2 *= inv;
            float o[4];
            o[0] = w0 * __uint_as_float(a0[i].x << 16) + w1 * __uint_as_float(a1[i].x << 16) + w2 * __uint_as_float(a2[i].x << 16);
            o[1] = w0 * __uint_as_float(a0[i].x & 0xffff0000u) + w1 * __uint_as_float(a1[i].x & 0xffff0000u) + w2 * __uint_as_float(a2[i].x & 0xffff0000u);
            o[2] = w0 * __uint_as_float(a0[i].y << 16) + w1 * __uint_as_float(a1[i].y << 16) + w2 * __uint_as_float(a2[i].y << 16);
            o[3] = w0 * __uint_as_float(a0[i].y & 0xffff0000u) + w1 * __uint_as_float(a1[i].y & 0xffff0000u) + w2 * __uint_as_float(a2[i].y & 0xffff0000u);
            u32x2 w; w.x = pk2(o[0], o[1]); w.y = pk2(o[2], o[3]); *(u32x2*)(yc + (size_t)row * YW + hp * 128 + e) = w; }
    }
}

constexpr int N_Q_MLA = 96, N_Q_UNITS = 192;
__device__ __forceinline__ void phase_attention(const Ctx& a, int l, LAS unsigned char* lds, volatile LAS unsigned* qword, const int wv, const int qsel) {
    const bf16_t* u1 = (const bf16_t*)(a.ws + WS_R2);
    float mb_mla, mb_dswa;
    { const int ln = lane_id_v(); const float* gq = a.in(I_QN) + (size_t)l * 192; const float* gk = a.in(I_KN) + (size_t)l * 192; const float* dq = a.in(I_DQN) + (size_t)l * 128; const float* dk = a.in(I_DKN) + (size_t)l * 128;
      float a0 = fmaxf(fmaxf(fabsf(gq[ln]), fabsf(gq[64 + ln])), fabsf(gq[128 + ln])), a1 = fmaxf(fmaxf(fabsf(gk[ln]), fabsf(gk[64 + ln])), fabsf(gk[128 + ln]));
      float a2 = fmaxf(fabsf(dq[ln]), fabsf(dq[64 + ln])), a3 = fmaxf(fabsf(dk[ln]), fabsf(dk[64 + ln]));
      a0 = max_xor32(max_xor16(max_row16(a0))); a1 = max_xor32(max_xor16(max_row16(a1))); a2 = max_xor32(max_xor16(max_row16(a2))); a3 = max_xor32(max_xor16(max_row16(a3)));
      mb_mla = __builtin_bit_cast(float, __builtin_amdgcn_readfirstlane(__builtin_bit_cast(int, 1.02f * QS_MLA * 192.f * a0 * a1)));
      mb_dswa = __builtin_bit_cast(float, __builtin_amdgcn_readfirstlane(__builtin_bit_cast(int, 1.02f * QS_DSWA * 128.f * a2 * a3))); }
    const int xcc = (int)(xb_xcc_id() & 7u);
    for (int qi = 0; qi < 8; ++qi) {
        const int x = (xcc + qi) & 7, j = x >> 1, odd = x & 1;
        unsigned* head = (unsigned*)(a.ws + WS_CTL) + CW_QUEUE + 64 * (8 * l + x) + 4096 * qsel;
        for (;;) {
            if (wv == 0 && lane_id_v() == 0) *qword = __hip_atomic_fetch_add(head, 1u, __ATOMIC_RELAXED, __HIP_MEMORY_SCOPE_AGENT);
            __syncthreads();
            const int p = (int)__builtin_amdgcn_readfirstlane(*qword);
            __syncthreads();
            if (p >= N_Q_UNITS) break;
            att::AUnit u;
            if (p < N_Q_MLA) {
                const int k = p / 3, r = p % 3;
                const int bh = r == 1 ? 3 * j + 1 : 3 * j + 2 * odd, qb = r == 0 ? 63 - 2 * k : (r == 1 ? 62 - 2 * k + odd : 62 - 2 * k), b = bh / 6, h = bh % 6;
                u.Q = (const bf16_t*)(a.ws + WS_QKV + QKV_Q) + ((size_t)bh * SEQ + 256 * qb) * 192; u.qpitch = 192;
                u.K = (const bf16_t*)(a.ws + WS_QKV + QKV_K) + (size_t)bh * SEQ * 192; u.kpitch = 192;
                u.V = (const bf16_t*)(a.ws + WS_QKV + QKV_V) + (size_t)bh * SEQ * 128; u.vpitch = 128;
                u.O = (bf16_t*)(a.ws + WS_R3 + R3_Y) + ((size_t)(b * SEQ + 256 * qb)) * YW + h * 128; u.opitch = YW;
                u.lse = nullptr; u.lsepitch = 0; u.q0 = 256 * qb; u.j_lo = 0; u.j_hi = 4 * qb + 4; u.bias_c = 0.f; u.mbound = mb_mla;
#ifdef PROBE_ATT_VAR
                if (qsel) { u.O = (bf16_t*)(a.outp) + ((size_t)(b * SEQ + 256 * qb)) * YW + h * 128; att::attn_unit<192, 0, PROBE_ATT_VAR>(lds, u, wv); } else
#endif
                att::attn_unit<192, 0>(lds, u, wv);
            } else {
                const int v = x * 96 + (p - N_Q_MLA), b = v / 384, hh = (v / 64) % 6, idx = v % 64, g = hh >> 1, dil = g == 0 ? 1 : (g == 1 ? 4 : 16), nb = 64 / dil, r = idx / nb, qb = idx % nb;
                const size_t tok0 = (size_t)b * SEQ + r;
                u.Q = u1 + (tok0 + (size_t)256 * qb * dil) * U1W + C_QC + hh * 128; u.qpitch = (size_t)dil * U1W;
                u.K = u1 + tok0 * U1W + C_KC + hh * 128; u.kpitch = (size_t)dil * U1W;
                u.V = u1 + tok0 * U1W + C_VC + hh * 128; u.vpitch = (size_t)dil * U1W;
                u.O = (bf16_t*)(a.ws + WS_R3 + R3_DO) + (tok0 + (size_t)256 * qb * dil) * 768 + hh * 128; u.opitch = (size_t)dil * 768;
                u.lse = (float*)(a.ws + WS_R3 + R3_LSE) + (tok0 + (size_t)256 * qb * dil) * 6 + hh; u.lsepitch = (size_t)dil * 6;
                u.q0 = 256 * qb; u.j_lo = 4 * qb - 2 > 0 ? 4 * qb - 2 : 0; u.j_hi = 4 * qb + 4;
                u.bias_c = exp2f(-8.f * (float)(hh + 1) / 6.f) * (float)dil * LOG2E; u.mbound = mb_dswa;
                att::attn_unit<128, 1>(lds, u, wv);
            }
        }
    }
    __syncthreads();
}

constexpr int NPL = 12, NPH = 1 + NPL * DEPTH;
__global__ void __launch_bounds__(NTHR, 2) hybrid_fwd(Args args) {
    extern __shared__ __attribute__((aligned(16))) unsigned char lds_raw[];
    LAS unsigned char* lds = (LAS unsigned char*)lds_raw;
    const int tid = threadIdx.x;
    const int wv = __builtin_amdgcn_readfirstlane(tid >> 6);
    const int G = gridDim.x, bid = blockIdx.x, NGW = G * NWAVES;
#define LAUNDER() int tz_ = lane_id_v(); asm volatile("" : "+v"(tz_)); const int lane = tz_, wave = wv, gw = bid * NWAVES + wave
    volatile LAS unsigned* lctl = (volatile LAS unsigned*)(lds + LDSCTL_OFF);
    for (int u = tid; u < (LDS_BYTES - LDSCTL_OFF) / 4; u += NTHR) lctl[u] = 0u;
    __syncthreads();
#if defined(PROBE_DUP) || defined(PROBE_LIGHT)
    const int qsel_ = args.qsel;
#else
    constexpr int qsel_ = 0;
#endif
#if MK_SINGLE
    constexpr int lo = 0, hi = NPH;
#else
    const int lo = args.ph_lo, hi = args.ph_hi;
#endif
    unsigned* ctl = (unsigned*)(args.ws + WS_CTL);
    XcdBarrier bar; bar.bar = ctl + CW_BAR; bar.x = 0; bar.st = lctl + 8; bar.wv = wv;
    if (hi - lo > 1) bar = xcd_barrier_post(ctl + CW_BAR, lctl + 8, wv);
#ifndef PH_MASK
#define PH_MASK 0xFFFF
#endif
#define IN(k) (lo <= (k) && (k) < hi)
#define EN(j) ((PH_MASK >> (j)) & 1)
#define DUMMY_OUT(p) (qsel_ ? (float*)(wz + WS_R3) : (p))
#define DUMMY_XB(p) (qsel_ ? (bf16_t*)(wz + WS_QKV) : (p))
#define DUMMY_XB2(p) (qsel_ ? (bf16_t*)(wz + WS_R2) : (p))
#define DUMMY_SSQ(p) (qsel_ ? (float*)(wz + WS_GLA) : (p))
#ifndef STAGGER_US
#define STAGGER_US 0
#endif
#define STAGGER() do { const unsigned grp_ = ((unsigned)bid >> 3) & 3u; if (STAGGER_US > 0 && grp_) { const unsigned long long t0_ = __builtin_amdgcn_s_memrealtime(); \
        while (__builtin_amdgcn_s_memrealtime() - t0_ < (unsigned long long)(grp_ * STAGGER_US * 100)) __builtin_amdgcn_s_sleep(8); } } while (0)
#define SEAM(k) do { if (IN(k) && IN((k) + 1)) xcd_barrier<false>(bar); } while (0)
    unsigned char* ws = args.ws;
    volatile LAS unsigned long long* ptab = (volatile LAS unsigned long long*)(lds + LDSCTL_OFF + 256);
    if (tid < 27) ptab[tid] = (unsigned long long)args.in[tid];
    __syncthreads();
    Ctx cx; cx.ws = ws; cx.ptab = ptab;
#ifdef PROBE_ATT_VAR
    cx.outp = (unsigned char*)args.out;
#endif
    float* xres = args.out;
    bf16_t* xl_main = (bf16_t*)args.out;
#define WSP() unsigned char* wz = ws; asm volatile("" : "+s"(wz)); int bz = bid; asm volatile("" : "+s"(bz)); \
    bf16_t* W = (bf16_t*)(wz + WS_W + (size_t)(l & 1) * WS_WSTRIDE); bf16_t* xb = (bf16_t*)(wz + WS_XB); float* ssq = (float*)(wz + WS_SSQ); bf16_t* h1 = (bf16_t*)(wz + WS_R1); bf16_t* u2 = (bf16_t*)(wz + WS_R1); \
    bf16_t* u1 = (bf16_t*)(wz + WS_R2); float* m32 = (float*)(wz + WS_R2); bf16_t* mb = (bf16_t*)(wz + WS_QKV); bf16_t* qraw = (bf16_t*)(wz + WS_R3 + R3_QRAW); bf16_t* kvraw = (bf16_t*)(wz + WS_R3 + R3_KVRAW); \
    bf16_t* yy = (bf16_t*)(wz + WS_R3 + R3_Y); \
    (void)W; (void)xb; (void)ssq; (void)h1; (void)u2; (void)u1; (void)m32; (void)mb; (void)qraw; (void)kvraw; (void)yy

    if (EN(12) && IN(0)) { LAUNDER(); phase_prologue(cx, gw, NGW, lane, xl_main); phase_wconv(cx, 0, lds, gw, NGW, wave, lane, WG_0, WG_1); }
    if (IN(0) && IN(1)) xcd_barrier<true>(bar);
    for (int l = 0; l < DEPTH; ++l) {
        const int pb = 1 + NPL * l;
#define WCONV_TAIL(ll, g0, g1) do { if ((ll) < DEPTH) { const int nwg_ = (MTOK / 256) * (NGU / 256), rem_ = nwg_ % G; const int ns_ = rem_ ? G - rem_ : G, si_ = rem_ ? bid - rem_ : bid; \
        if (si_ >= 0) { __syncthreads(); LAUNDER(); phase_wconv(cx, (ll), lds, si_ * NWAVES + wave, ns_ * NWAVES, wave, lane, (g0), (g1)); } } } while (0)
        if (EN(1) && IN(pb + 1)) { WSP();
            pg8::Gemm g{xb, W + W_GU1, MTOK, NGU, DM, DM}; pg8::StaticOrder S; S.init(MTOK, NGU, G, bz, 4);
#ifdef PROBE_LIGHT
            if (qsel_ == 2) { pg8::EpiBf16 E2{(bf16_t*)(wz + WS_R3), DM}; pg8::gemm_phase<pg8::EpiBf16, pg8::StaticOrder, true, true>(lds, g, S, E2, wv); } else
#endif
            { pg8::EpiSwiGLU E{ssq, h1, FF};
            pg8::gemm_phase<pg8::EpiSwiGLU, pg8::StaticOrder, true, true, true>(lds, g, S, E, wv); }
            WCONV_TAIL(l, WG_1, WG_2);
        }
        SEAM(pb + 1);
        if (EN(2) && IN(pb + 2)) { WSP(); STAGGER();
            pg8::Gemm g{h1, W + W_D1, MTOK, DM, FF, FF}; pg8::StaticOrder S; S.init(MTOK, DM, G, bz, 4);
#ifdef PROBE_LIGHT
            if (qsel_ == 2) { pg8::EpiBf16 E2{(bf16_t*)(wz + WS_QKV), DM}; pg8::gemm_phase<pg8::EpiBf16, pg8::StaticOrder, true, true>(lds, g, S, E2, wv); } else
#endif
            { pg8::EpiResid<false> E{xres, xb, xl_main, xl_main, ssq, 0.5f};
            pg8::gemm_phase<pg8::EpiResid<false>, pg8::StaticOrder, true, true, true>(lds, g, S, E, wv); }
        }
        SEAM(pb + 2);
        if (EN(3) && IN(pb + 3)) { WSP();
            pg8::Gemm g{xb, W + W_IN, MTOK, NIN, DM, DM}; pg8::StaticOrder S; S.init(MTOK, NIN, G, bz, 4);
            pg8::EpiWin E{ssq, u1, u2, U1W, U2W};
            pg8::gemm_phase<pg8::EpiWin, pg8::StaticOrder, true, true, true>(lds, g, S, E, wv);
            WCONV_TAIL(l, WG_2, WG_3);
        }
        SEAM(pb + 3);
        if (EN(4) && IN(pb + 4)) { WSP();
            { pg8::Gemm g{u1 + C_CQ, W + W_UQ, MTOK, 1280, 512, U1W}; pg8::StaticOrder S; S.init(MTOK, 1280, G, bid);
              pg8::EpiBf16 E{qraw, QRAW_LD};
              pg8::gemm_phase<pg8::EpiBf16, pg8::StaticOrder, true, true>(lds, g, S, E, wv); }
            { pg8::Gemm g{u1 + C_CKV, W + W_UKV, MTOK, 1536, 256, U1W}; pg8::StaticOrder S; S.init(MTOK, 1536, G, bid);
              pg8::EpiBf16 E{kvraw, KVRAW_LD};
              pg8::gemm_phase<pg8::EpiBf16, pg8::StaticOrder, true, true>(lds, g, S, E, wv); }
        }
        SEAM(pb + 4);
        if (EN(5) && IN(pb + 5)) { LAUNDER(); phase_prep(cx, l, gw, NGW, lane, qsel_ == 0); gla_local(cx, l, lds, G, bid, wv); }
        SEAM(pb + 5);
        if (EN(6) && IN(pb + 6)) { if (qsel_ == 0) { for (int sb_ = bid; sb_ < 32; sb_ += G) gla_scan(cx, sb_, wv); } phase_attention(cx, l, lds, lctl + 16, wv, qsel_); }
        SEAM(pb + 6);
        if (EN(7) && IN(pb + 7)) { LAUNDER(); gla_out(cx, l, lds, G, bid, wv); dswa_combine(cx, gw, NGW, lane); }
        SEAM(pb + 7);
        if (EN(8) && IN(pb + 8)) { WSP();
            pg8::Gemm g{yy, W + W_M, MTOK, DM, YW, YW}; pg8::StaticOrder S; S.init(MTOK, DM, G, bz, 4);
            pg8::EpiMergeFused E{u2, U2W, mb};
            pg8::gemm_phase<pg8::EpiMergeFused, pg8::StaticOrder, true, true>(lds, g, S, E, wv);
        }
        SEAM(pb + 8);
        if (EN(9) && IN(pb + 9)) { WSP(); STAGGER();
            pg8::Gemm g{mb, W + W_OUT, MTOK, DM, DM, DM}; pg8::StaticOrder S; S.init(MTOK, DM, G, bz, 4);
#ifdef PROBE_LIGHT
            if (qsel_ == 2) { pg8::EpiBf16 E2{(bf16_t*)(wz + WS_R2), DM}; pg8::gemm_phase<pg8::EpiBf16, pg8::StaticOrder, true, true>(lds, g, S, E2, wv); } else
#endif
            { pg8::EpiResid<false> E{xres, xb, xl_main, l + 1 < DEPTH ? xl_main : (bf16_t*)(wz + WS_R2), ssq, 1.0f};
            pg8::gemm_phase<pg8::EpiResid<false>, pg8::StaticOrder, true, true>(lds, g, S, E, wv); }
        }
        SEAM(pb + 9);
        if (EN(10) && IN(pb + 10)) { WSP();
            pg8::Gemm g{xb, W + W_GU2, MTOK, NGU, DM, DM}; pg8::StaticOrder S; S.init(MTOK, NGU, G, bz, 4);
            pg8::EpiSwiGLU E{ssq, h1, FF};
            pg8::gemm_phase<pg8::EpiSwiGLU, pg8::StaticOrder, true, true, true>(lds, g, S, E, wv);
            WCONV_TAIL(l, WG_3, WG_4); WCONV_TAIL(l + 1, WG_0, WG_1);
        }
        SEAM(pb + 10);
        if (EN(11) && IN(pb + 11)) { WSP(); STAGGER();
            pg8::Gemm g{h1, W + W_D2, MTOK, DM, FF, FF}; pg8::StaticOrder S; S.init(MTOK, DM, G, bz, 4);
            if (l + 1 < DEPTH) { pg8::EpiResid<false> E{xres, xb, xl_main, xl_main, ssq, 0.5f}; pg8::gemm_phase<pg8::EpiResid<false>, pg8::StaticOrder, true, true, true>(lds, g, S, E, wv); }
            else { pg8::EpiResid<true> E{xres, xb, (const bf16_t*)(wz + WS_R2), nullptr, ssq, 0.5f}; pg8::gemm_phase<pg8::EpiResid<true>, pg8::StaticOrder, true, true, true>(lds, g, S, E, wv); }
        }
        SEAM(pb + 11);
    }
#undef IN
#undef SEAM
}

extern "C" void kernel_launch(void* const* d_in, const int* in_sizes, int n_in, void* d_out, int out_size, void* d_ws, size_t ws_size, hipStream_t stream) {
    static int grid = 0;
    if (grid == 0) {
        if (n_in != 27 || out_size != MTOK * DM || ws_size < WS_END) { fprintf(stderr, "kernel_launch: unexpected problem: n_in %d out %d ws %zu (need %zu)\n", n_in, out_size, ws_size, (size_t)WS_END); grid = -1; return; }
        int dev = 0, cus = 0, per_cu = 0;
        if (hipGetDevice(&dev) != hipSuccess || hipDeviceGetAttribute(&cus, hipDeviceAttributeMultiprocessorCount, dev) != hipSuccess) { grid = -1; return; }
        if (hipFuncSetAttribute((const void*)hybrid_fwd, hipFuncAttributeMaxDynamicSharedMemorySize, LDS_BYTES) != hipSuccess) { fprintf(stderr, "kernel_launch: hipFuncSetAttribute failed\n"); grid = -1; return; }
        if (hipOccupancyMaxActiveBlocksPerMultiprocessor(&per_cu, (const void*)hybrid_fwd, NTHR, LDS_BYTES) != hipSuccess || per_cu < 1)
            fprintf(stderr, "kernel_launch: occupancy query reports %d workgroups per CU\n", per_cu);
        (void)hipGetLastError();
        grid = cus;
    }
    if (grid < 0) return;
    if (hipMemsetAsync((char*)d_ws + WS_CTL, 0, CTL_BYTES, stream) != hipSuccess) return;
    Args a{};
    for (int i = 0; i < 27; ++i) a.in[i] = (const float*)d_in[i];
    a.out = (float*)d_out; a.ws = (unsigned char*)d_ws;
#if MK_SINGLE
    a.ph_lo = 0; a.ph_hi = NPH;
    hipLaunchKernelGGL(hybrid_fwd, dim3(grid), dim3(NTHR), LDS_BYTES, stream, a);
#else
    for (int p = 0; p < NPH; ++p) { a.ph_lo = p; a.ph_hi = p + 1; a.qsel = 0; hipLaunchKernelGGL(hybrid_fwd, dim3(grid), dim3(NTHR), LDS_BYTES, stream, a);
#ifdef PROBE_DUP
        if (p >= 1 && ((PROBE_DUP >> ((p - 1) % NPL)) & 1)) { a.qsel = 1; hipLaunchKernelGGL(hybrid_fwd, dim3(grid), dim3(NTHR), LDS_BYTES, stream, a); }
#ifdef PROBE_LIGHT
        if (p >= 1 && ((PROBE_LIGHT >> ((p - 1) % NPL)) & 1)) { a.qsel = 2; hipLaunchKernelGGL(hybrid_fwd, dim3(grid), dim3(NTHR), LDS_BYTES, stream, a); }
#endif
#endif
    }
#endif
    const hipError_t le = hipPeekAtLastError();
    if (le != hipSuccess) fprintf(stderr, "kernel_launch: launch failed: %s\n", hipGetErrorName(le));
}
```

```cpp
#include <hip/hip_runtime.h>
#include <cstdio>
#include <cstdint>

#ifndef PG8_ASM_STAGE
#define PG8_ASM_STAGE 0
#endif
#ifndef RESID_LO
#define RESID_LO 0
#endif
#ifndef MK_SINGLE
#define MK_SINGLE 1
#endif

__device__ __forceinline__ int lane_id_v() { int x; asm volatile("v_mbcnt_lo_u32_b32 %0, -1, 0\n\tv_mbcnt_hi_u32_b32 %0, -1, %0" : "=v"(x)); return x; }
template <int CTRL> __device__ __forceinline__ float dppx(float x) { return __builtin_bit_cast(float, __builtin_amdgcn_mov_dpp(__builtin_bit_cast(int, x), CTRL, 0xf, 0xf, true)); }
__device__ __forceinline__ float lane_xor1(float x) { return dppx<0xB1>(x); }
__device__ __forceinline__ float sum_xor16(float x) { auto s = __builtin_amdgcn_permlane16_swap(__float_as_uint(x), __float_as_uint(x), false, false); return __uint_as_float(s[0]) + __uint_as_float(s[1]); }
__device__ __forceinline__ float sum_xor32(float x) { auto s = __builtin_amdgcn_permlane32_swap(__float_as_uint(x), __float_as_uint(x), false, false); return __uint_as_float(s[0]) + __uint_as_float(s[1]); }
__device__ __forceinline__ float max_xor16(float x) { auto s = __builtin_amdgcn_permlane16_swap(__float_as_uint(x), __float_as_uint(x), false, false); return fmaxf(__uint_as_float(s[0]), __uint_as_float(s[1])); }
__device__ __forceinline__ float max_xor32(float x) { auto s = __builtin_amdgcn_permlane32_swap(__float_as_uint(x), __float_as_uint(x), false, false); return fmaxf(__uint_as_float(s[0]), __uint_as_float(s[1])); }
__device__ __forceinline__ float sum_row16(float x) { x += dppx<0xB1>(x); x += dppx<0x4E>(x); x += dppx<0x141>(x); x += dppx<0x128>(x); return x; }
__device__ __forceinline__ float max_row16(float x) { x = fmaxf(x, dppx<0xB1>(x)); x = fmaxf(x, dppx<0x4E>(x)); x = fmaxf(x, dppx<0x141>(x)); x = fmaxf(x, dppx<0x128>(x)); return x; }
namespace pg8 {
#define PG8_LAS __attribute__((address_space(3)))
typedef unsigned short bf16_t;
typedef short bf16x8 __attribute__((ext_vector_type(8)));
typedef float f32x4 __attribute__((ext_vector_type(4)));
typedef unsigned u32x4 __attribute__((ext_vector_type(4)));
typedef unsigned u32x2 __attribute__((ext_vector_type(2)));
constexpr int BM = 256, BK = 64, HALF = 128, HTB = HALF * BK * 2  , STAGE_BYTES = 8 * HTB, NXCD = 8, WGM = 8;

__host__ __device__ __forceinline__ int lds_byte(int r, int c) { const int st = (r >> 4) * 2 + (c >> 5), rr = r & 15, cc = c & 31, ob = rr * 64 + cc * 2; return st * 1024 + (ob ^ (((ob >> 9) & 1) << 5)); }
__host__ __device__ __forceinline__ void stage_rc(int b, int& R, int& C) { const int st = b / 1024, sb = b % 1024, swz = sb ^ (((sb >> 9) & 1) << 5); R = (st >> 1) * 16 + swz / 64; C = (st & 1) * 32 + (swz % 64) / 2; }
__host__ __device__ __forceinline__ int perm32(int rho) { const int n = rho >> 4, i = rho & 15; return 8 * (i >> 2) + 4 * n + (i & 3); }

struct Unit { int pm, pn; };
struct Gemm { const bf16_t* A; const bf16_t* Bt; int M, N, K, lda; };

struct StaticOrder {
    int nM, nN, nwg, G, c, wgm;
    __host__ __device__ void init(int M, int N, int G_, int c_, int wgm_ = WGM) { nM = M / BM; nN = N / BM; nwg = nM * nN; G = G_; c = c_; wgm = wgm_; }
    __host__ __device__ bool next(int i, Unit& u) const {
        const long L = (long)i * G + c; if (L >= nwg) return false;
        int wgid = (int)L; { const int q = nwg / NXCD, r = nwg % NXCD, xcd = wgid % NXCD, off = wgid / NXCD; wgid = (xcd < r ? xcd * (q + 1) : r * (q + 1) + (xcd - r) * q) + off; }
        const int nig = wgm * nN, gid = wgid / nig, fm = gid * wgm, gsz = (nM - fm) < wgm ? (nM - fm) : wgm;
        u.pm = fm + ((wgid % nig) % gsz); u.pn = (wgid % nig) / gsz; return true;
    }
    __device__ __forceinline__ void a_ready(const Unit&) const {}
    __device__ __forceinline__ void done(const Unit&) const {}
};
__device__ __forceinline__ unsigned cvt_pk_bf16(float lo, float hi) { unsigned r; asm volatile("v_cvt_pk_bf16_f32 %0, %1, %2" : "=v"(r) : "v"(lo), "v"(hi)); return r; }

template <class Epi, class Sched, bool ALIGN_EPI = false, bool SP2 = false, bool ABLK = false>
__device__ __forceinline__ void gemm_phase(PG8_LAS unsigned char* lds, const Gemm g, const Sched& S, const Epi& E, const int wv) {
    int tid_ = wv * 64 + lane_id_v(); asm volatile("" : "+v"(tid_));
    const int tid = tid_, wid = __builtin_amdgcn_readfirstlane(tid >> 6), lane = tid & 63, wr = wid >> 2, wc = wid & 3, fr = lane & 15, fq = lane >> 4;
    const int K = g.K, nt = K / BK;
    unsigned voffA[2], voffB[2];
#pragma unroll
    for (int i = 0; i < 2; ++i) { int R, C; stage_rc(tid * 16 + i * 8192, R, C); const int Rb = Epi::PERM ? ((R & ~31) + perm32(R & 31)) : R;
        voffA[i] = (unsigned)(R * (ABLK ? BK : g.lda) + C) * 2u; voffB[i] = (unsigned)(Rb * K + C) * 2u; }
    const size_t kstep = (size_t)(BK * 2);
    const size_t kstepA = ABLK ? (size_t)BM * BK * 2 : kstep;
    const size_t hstep = (size_t)HALF * K * 2, hstepA = (size_t)HALF * (ABLK ? BK : g.lda) * 2;
    const size_t tstep = 2 * hstep, tstepA = ABLK ? (size_t)nt * BM * BK * 2 : 2 * hstepA;
    const unsigned ldsw = (unsigned)wid * 1024u;
    const int aoff = lds_byte(wr * 64 + fr, fq * 8), boff = lds_byte(wc * 32 + fr, fq * 8);
#define PG8_SA(b, h) (((b) * 2 + (h)) * HTB)
#define PG8_SB(b, h) ((4 + (b) * 2 + (h)) * HTB)
#if PG8_ASM_STAGE
#define PG8_STAGE(bufoff, gbase, voff) do { const unsigned m0a_ = (unsigned)(size_t)(lds + (bufoff)) + ldsw; const char* gb_ = (const char*)(gbase); \
        asm volatile("s_mov_b32 m0, %2\n\ts_nop 0\n\tglobal_load_lds_dwordx4 %0, %1" :: "v"((voff)[0]), "s"(gb_), "s"(m0a_) : "memory", "m0"); \
        asm volatile("s_add_i32 m0, %2, 0x2000\n\ts_nop 0\n\tglobal_load_lds_dwordx4 %0, %1" :: "v"((voff)[1]), "s"(gb_), "s"(m0a_) : "memory", "m0", "scc"); } while (0)
#else
#define PG8_STAGE(bufoff, gbase, voff) do { _Pragma("unroll") for (int _i = 0; _i < 2; ++_i) \
        __builtin_amdgcn_global_load_lds((const unsigned*)((const char*)(gbase) + (voff)[_i]), (PG8_LAS unsigned*)(lds + (bufoff) + ldsw + _i * 8192), 16, 0, 0); } while (0)
#endif
#define PG8_LDA(dst, b, h) do { _Pragma("unroll") for (int m = 0; m < 4; ++m) _Pragma("unroll") for (int k = 0; k < 2; ++k) dst[m][k] = *(const PG8_LAS bf16x8*)(lds + PG8_SA(b, h) + aoff + m * 2048 + k * 1024); } while (0)
#define PG8_LDB(dst, b, h) do { _Pragma("unroll") for (int n = 0; n < 2; ++n) _Pragma("unroll") for (int k = 0; k < 2; ++k) dst[n][k] = *(const PG8_LAS bf16x8*)(lds + PG8_SB(b, h) + boff + n * 2048 + k * 1024); } while (0)
#define PG8_MMA(ai, bj, At, Bt) do { __builtin_amdgcn_s_setprio(1); _Pragma("unroll") for (int m = 0; m < 4; ++m) _Pragma("unroll") for (int n = 0; n < 2; ++n) _Pragma("unroll") for (int k = 0; k < 2; ++k) \
        acc[ai][bj][m][n] = __builtin_amdgcn_mfma_f32_16x16x32_bf16(Bt[n][k], At[m][k], acc[ai][bj][m][n], 0, 0, 0); __builtin_amdgcn_s_setprio(0); } while (0)
#define PG8_WAIT_V(n) asm volatile("s_waitcnt vmcnt(" #n ")" ::: "memory")
#define PG8_WAIT_L(n) asm volatile("s_waitcnt lgkmcnt(" #n ")" ::: "memory")
#define PG8_BAR __builtin_amdgcn_s_barrier()
#define PG8_SCHED __builtin_amdgcn_sched_barrier(0)
    Unit cur, nxt; int ui = 0;
    if (!S.next(0, cur)) return;
    f32x4 acc[2][2][4][2];
#pragma unroll
    for (int a = 0; a < 2; ++a)
#pragma unroll
        for (int b = 0; b < 2; ++b)
#pragma unroll
            for (int m = 0; m < 4; ++m)
#pragma unroll
                for (int n = 0; n < 2; ++n) acc[a][b][m][n] = (f32x4){0.f, 0.f, 0.f, 0.f};
    bf16x8 At[4][2], B0[2][2], B1[2][2];
    const char* cA = (const char*)g.A + (size_t)cur.pm * tstepA; const char* cB = (const char*)g.Bt + (size_t)cur.pn * tstep;
    S.a_ready(cur);
    if constexpr (SP2) {
        PG8_STAGE(PG8_SB(0, 0), cB, voffB); PG8_STAGE(PG8_SB(0, 1), cB + hstep, voffB); PG8_STAGE(PG8_SA(0, 0), cA, voffA); PG8_STAGE(PG8_SA(0, 1), cA + hstepA, voffA);
        if (wr == 1) PG8_BAR;
        PG8_WAIT_V(2); PG8_BAR;
        PG8_STAGE(PG8_SB(1, 0), cB + kstep, voffB); PG8_STAGE(PG8_SA(1, 0), cA + kstepA, voffA); PG8_STAGE(PG8_SB(1, 1), cB + hstep + kstep, voffB);
        PG8_WAIT_V(6); PG8_BAR;
    } else {
        PG8_STAGE(PG8_SB(0, 0), cB, voffB); PG8_STAGE(PG8_SA(0, 0), cA, voffA); PG8_STAGE(PG8_SB(0, 1), cB + hstep, voffB); PG8_STAGE(PG8_SA(0, 1), cA + hstepA, voffA);
        if (wr == 1) PG8_BAR;
        PG8_WAIT_V(4); PG8_BAR;
        PG8_STAGE(PG8_SB(1, 0), cB + kstep, voffB); PG8_STAGE(PG8_SA(1, 0), cA + kstepA, voffA); PG8_STAGE(PG8_SB(1, 1), cB + hstep + kstep, voffB);
        PG8_WAIT_V(6); PG8_BAR;
    }
    for (;;) {
        const bool has_next = S.next(ui + 1, nxt);
        const char* nA = has_next ? (const char*)g.A + (size_t)nxt.pm * tstepA : cA; const char* nB = has_next ? (const char*)g.Bt + (size_t)nxt.pn * tstep : cB;
        for (int t = 0; t < nt; t += 2) {
            const bool last = (t == nt - 2);
            const char* a1 = cA + (size_t)(t + 1) * kstepA;
            const char* a2 = last ? nA : cA + (size_t)(t + 2) * kstepA; const char* b2 = last ? nB : cB + (size_t)(t + 2) * kstep;
            const char* a3 = a2 + kstepA; const char* b3 = b2 + kstep;
            if (last && has_next) S.a_ready(nxt);
            if constexpr (Epi::HAS_MID) { if (t == Epi::T1 || t == Epi::T2) { const int ln_ = lane_id_v(); E.mid(acc, cur, wr, wc, ln_ & 15, ln_ >> 4, t); } }
            if constexpr (SP2) {
            PG8_LDB(B0, 0, 0); PG8_LDB(B1, 0, 1); PG8_SCHED; PG8_LDA(At, 0, 0); PG8_STAGE(PG8_SA(1, 1), a1 + hstepA, voffA);
            PG8_WAIT_V(8); PG8_WAIT_L(0); PG8_BAR; PG8_MMA(0, 0, At, B0); PG8_MMA(0, 1, At, B1); PG8_BAR; PG8_SCHED;
            PG8_LDA(At, 0, 1); PG8_STAGE(PG8_SB(0, 0), b2, voffB); PG8_STAGE(PG8_SB(0, 1), b2 + hstep, voffB); PG8_STAGE(PG8_SA(0, 0), a2, voffA);
            PG8_WAIT_V(8); PG8_WAIT_L(0); PG8_BAR; PG8_MMA(1, 0, At, B0); PG8_MMA(1, 1, At, B1); PG8_BAR; PG8_SCHED;
            PG8_LDB(B0, 1, 0); PG8_LDB(B1, 1, 1); PG8_SCHED; PG8_LDA(At, 1, 0); PG8_STAGE(PG8_SA(0, 1), a2 + hstepA, voffA);
            PG8_WAIT_V(8); PG8_WAIT_L(0); PG8_BAR; PG8_MMA(0, 0, At, B0); PG8_MMA(0, 1, At, B1); PG8_BAR; PG8_SCHED;
            PG8_LDA(At, 1, 1); PG8_STAGE(PG8_SB(1, 0), b3, voffB); PG8_STAGE(PG8_SB(1, 1), b3 + hstep, voffB); PG8_STAGE(PG8_SA(1, 0), a3, voffA);
            PG8_WAIT_V(8); PG8_WAIT_L(0); PG8_BAR; PG8_MMA(1, 0, At, B0); PG8_MMA(1, 1, At, B1); PG8_BAR; PG8_SCHED;
            } else {
            PG8_LDB(B0, 0, 0); PG8_SCHED; PG8_LDA(At, 0, 0); PG8_STAGE(PG8_SA(1, 1), a1 + hstepA, voffA);
            PG8_WAIT_L(8); PG8_BAR; PG8_WAIT_L(0); PG8_MMA(0, 0, At, B0); PG8_BAR; PG8_SCHED;
            PG8_LDB(B1, 0, 1); PG8_STAGE(PG8_SB(0, 0), b2, voffB);
            PG8_BAR; PG8_WAIT_L(0); PG8_MMA(0, 1, At, B1); PG8_BAR;
            PG8_LDA(At, 0, 1); PG8_STAGE(PG8_SA(0, 0), a2, voffA);
            PG8_BAR; PG8_WAIT_L(0); PG8_MMA(1, 0, At, B0); PG8_BAR; PG8_SCHED;
            PG8_STAGE(PG8_SB(0, 1), b2 + hstep, voffB);
            PG8_WAIT_V(6); PG8_BAR; PG8_MMA(1, 1, At, B1); PG8_BAR;
            PG8_LDB(B0, 1, 0); PG8_SCHED; PG8_LDA(At, 1, 0); PG8_STAGE(PG8_SA(0, 1), a2 + hstepA, voffA);
            PG8_WAIT_L(8); PG8_BAR; PG8_WAIT_L(0); PG8_MMA(0, 0, At, B0); PG8_BAR; PG8_SCHED;
            PG8_LDB(B1, 1, 1); PG8_STAGE(PG8_SB(1, 0), b3, voffB);
            PG8_BAR; PG8_WAIT_L(0); PG8_MMA(0, 1, At, B1); PG8_BAR;
            PG8_LDA(At, 1, 1); PG8_STAGE(PG8_SA(1, 0), a3, voffA);
            PG8_BAR; PG8_WAIT_L(0); PG8_MMA(1, 0, At, B0); PG8_BAR; PG8_SCHED;
            PG8_STAGE(PG8_SB(1, 1), b3 + hstep, voffB);
            PG8_WAIT_V(6); PG8_BAR; PG8_MMA(1, 1, At, B1); PG8_BAR;
            }
        }
        if constexpr (ALIGN_EPI) { if (wr == 0) PG8_BAR; }
        if constexpr (!Epi::AFTER_DRAIN) { const int ln_ = lane_id_v(); E(acc, cur, wr, wc, ln_ & 15, ln_ >> 4); S.done(cur); }
        if (!has_next) break;
#pragma unroll
        for (int a = 0; a < 2; ++a)
#pragma unroll
            for (int b = 0; b < 2; ++b)
#pragma unroll
                for (int m = 0; m < 4; ++m)
#pragma unroll
                    for (int n = 0; n < 2; ++n) acc[a][b][m][n] = (f32x4){0.f, 0.f, 0.f, 0.f};
        cur = nxt; cA = nA; cB = nB; ++ui;
        if constexpr (ALIGN_EPI) { if (wr == 1) PG8_BAR; }
    }
    PG8_WAIT_V(0);
    if constexpr (!ALIGN_EPI) { if (wr == 0) PG8_BAR; }
    PG8_BAR;
    if constexpr (Epi::AFTER_DRAIN) { E.fused(acc, cur, wr, wc, fr, fq, lds, wid, lane); S.done(cur); }
#undef PG8_SA
#undef PG8_SB
#undef PG8_STAGE
#undef PG8_LDA
#undef PG8_LDB
#undef PG8_MMA
#undef PG8_WAIT_V
#undef PG8_WAIT_L
#undef PG8_BAR
#undef PG8_SCHED
}

constexpr float NORM_EPS = 1e-6f;
__device__ __forceinline__ float row_rstd(const float* ssq, int row, int fq) {
    const f32x4 a = *(const f32x4*)(ssq + (size_t)row * 32 + fq * 8), b = *(const f32x4*)(ssq + (size_t)row * 32 + fq * 8 + 4);
    float s = ((a[0] + a[1]) + (a[2] + a[3])) + ((b[0] + b[1]) + (b[2] + b[3]));
    s = sum_xor32(sum_xor16(s));
    return rsqrtf(s * (1.0f / 2048.0f) + NORM_EPS);
}
__device__ __forceinline__ float fsigmoid(float x) { return __builtin_amdgcn_rcpf(1.0f + __expf(-x)); }
__device__ __forceinline__ u32x4 pack8(const f32x4 v0, const f32x4 v1) { u32x4 w; w.x = cvt_pk_bf16(v0[0], v0[1]); w.y = cvt_pk_bf16(v0[2], v0[3]); w.z = cvt_pk_bf16(v1[0], v1[1]); w.w = cvt_pk_bf16(v1[2], v1[3]); return w; }
__device__ __forceinline__ void unpack8(const u32x4 w, f32x4& v0, f32x4& v1) {
    v0[0] = __uint_as_float(w.x << 16); v0[1] = __uint_as_float(w.x & 0xffff0000u); v0[2] = __uint_as_float(w.y << 16); v0[3] = __uint_as_float(w.y & 0xffff0000u);
    v1[0] = __uint_as_float(w.z << 16); v1[1] = __uint_as_float(w.z & 0xffff0000u); v1[2] = __uint_as_float(w.w << 16); v1[3] = __uint_as_float(w.w & 0xffff0000u); }

struct EpiSwiGLU {
    static constexpr bool PERM = true, AFTER_DRAIN = false, HAS_MID = false;
    const float* ssq; bf16_t* H; int ldh;
    __device__ __forceinline__ void operator()(const f32x4 (&acc)[2][2][4][2], const Unit& u, int wr, int wc, int fr, int fq) const {
        const int row0 = u.pm * BM + wr * 64 + fr;
        bf16_t* Hb = H + ((size_t)(u.pm * (ldh / BK) + 2 * u.pn + (wc >> 1)) * BM + wr * 64 + fr) * BK + (wc & 1) * 32 + 8 * fq;
        float rs[2][4];
#pragma unroll
        for (int ai = 0; ai < 2; ++ai)
#pragma unroll
            for (int m = 0; m < 4; ++m) rs[ai][m] = row_rstd(ssq, row0 + ai * HALF + m * 16, fq);
#pragma unroll
        for (int ai = 0; ai < 2; ++ai)
#pragma unroll
            for (int m = 0; m < 4; ++m) { const float r = rs[ai][m];
                f32x4 h0, h1;
#pragma unroll
                for (int j = 0; j < 4; ++j) { const float g0 = acc[ai][0][m][0][j] * r, g1 = acc[ai][0][m][1][j] * r;
                    h0[j] = g0 * fsigmoid(g0) * (acc[ai][1][m][0][j] * r); h1[j] = g1 * fsigmoid(g1) * (acc[ai][1][m][1][j] * r); }
                *(u32x4*)(Hb + (size_t)(ai * HALF + m * 16) * BK) = pack8(h0, h1); }
    }
};
template <bool FINAL> struct EpiResid {
    static constexpr bool PERM = true, AFTER_DRAIN = false, HAS_MID = false;
    float* out; bf16_t* xb; const bf16_t* xl_in; bf16_t* xl_out; float* ssq; float alpha;
    __device__ __forceinline__ void operator()(const f32x4 (&acc)[2][2][4][2], const Unit& u, int wr, int wc, int fr, int fq) const {
        const int row0 = u.pm * BM + wr * 64 + fr, col0 = u.pn * BM + wc * 32 + 8 * fq;
        const size_t xb0 = ((size_t)(u.pm * (2048 / BK) + 4 * u.pn + (wc >> 1)) * BM + wr * 64 + fr) * BK + (wc & 1) * 32 + 8 * fq;
#pragma unroll
        for (int ai = 0; ai < 2; ++ai) {
            u32x4 bw[4][2], lw[4][2];
#pragma unroll
            for (int m = 0; m < 4; ++m)
#pragma unroll
                for (int bj = 0; bj < 2; ++bj) { const size_t offb = xb0 + (size_t)(2 * bj) * BM * BK + (size_t)(ai * HALF + m * 16) * BK; bw[m][bj] = *(const u32x4*)(xb + offb); if (RESID_LO) lw[m][bj] = *(const u32x4*)(xl_in + offb); }
#pragma unroll
            for (int m = 0; m < 4; ++m) { const int row = row0 + ai * HALF + m * 16; float ss = 0.f;
#pragma unroll
                for (int bj = 0; bj < 2; ++bj) { const size_t off = (size_t)row * 2048 + col0 + bj * HALF, offb = xb0 + (size_t)(2 * bj) * BM * BK + (size_t)(ai * HALF + m * 16) * BK;
                    f32x4 b0, b1; unpack8(bw[m][bj], b0, b1); if (RESID_LO) { f32x4 l0, l1; unpack8(lw[m][bj], l0, l1); b0 += l0; b1 += l1; }
                    const f32x4 v0 = b0 + acc[ai][bj][m][0] * alpha, v1 = b1 + acc[ai][bj][m][1] * alpha;
                    if (FINAL) { *(f32x4*)(out + off) = v0; *(f32x4*)(out + off + 4) = v1; }
                    else { ss += ((v0[0] * v0[0] + v0[1] * v0[1]) + (v0[2] * v0[2] + v0[3] * v0[3])) + ((v1[0] * v1[0] + v1[1] * v1[1]) + (v1[2] * v1[2] + v1[3] * v1[3]));
                        const u32x4 hw = pack8(v0, v1); f32x4 h0, h1; unpack8(hw, h0, h1);
                        *(u32x4*)(xb + offb) = hw; if (RESID_LO) *(u32x4*)(xl_out + offb) = pack8(v0 - h0, v1 - h1); } }
                if (!FINAL) { ss = sum_xor32(sum_xor16(ss)); if (fq == 0) ssq[(size_t)row * 32 + u.pn * 4 + wc] = ss; } }
            asm volatile("" ::: "memory"); }
    }
};
struct EpiWin {
    static constexpr bool PERM = true, AFTER_DRAIN = false, HAS_MID = false;
    const float* ssq; bf16_t* u1; bf16_t* u2; int ld1, ld2;
    __device__ __forceinline__ void operator()(const f32x4 (&acc)[2][2][4][2], const Unit& u, int wr, int wc, int fr, int fq) const {
        const int row0 = u.pm * BM + wr * 64 + fr; const int mode = u.pn < 17 ? 0 : (u.pn < 19 ? 1 : 2);
        bf16_t* dst = mode == 2 ? u2 : u1; const int ld = mode == 2 ? ld2 : ld1; const int col0 = (mode == 2 ? (u.pn - 19) : u.pn) * BM + wc * 32 + 8 * fq;
        float rsv[2][4];
#pragma unroll
        for (int ai = 0; ai < 2; ++ai)
#pragma unroll
            for (int m = 0; m < 4; ++m) rsv[ai][m] = row_rstd(ssq, row0 + ai * HALF + m * 16, fq);
#pragma unroll
        for (int ai = 0; ai < 2; ++ai)
#pragma unroll
            for (int m = 0; m < 4; ++m) { const int row = row0 + ai * HALF + m * 16; const float rs = rsv[ai][m];
#pragma unroll
                for (int bj = 0; bj < 2; ++bj) { f32x4 v0 = acc[ai][bj][m][0] * rs, v1 = acc[ai][bj][m][1] * rs;
                    if (mode == 1) {
#pragma unroll
                        for (int j = 0; j < 4; ++j) { v0[j] = v0[j] * fsigmoid(v0[j]); v1[j] = v1[j] * fsigmoid(v1[j]); } }
                    else if (mode == 2) {
#pragma unroll
                        for (int j = 0; j < 4; ++j) { v0[j] = fmaxf(fsigmoid(v0[j]), 9.094947e-13f); v1[j] = fmaxf(fsigmoid(v1[j]), 9.094947e-13f); } }
                    *(u32x4*)(dst + (size_t)row * ld + col0 + bj * HALF) = pack8(v0, v1); } }
    }
};
struct EpiBf16 {
    static constexpr bool PERM = true, AFTER_DRAIN = false, HAS_MID = false;
    bf16_t* O; int ldc;
    __device__ __forceinline__ void operator()(const f32x4 (&acc)[2][2][4][2], const Unit& u, int wr, int wc, int fr, int fq) const {
        const int row0 = u.pm * BM + wr * 64 + fr, col0 = u.pn * BM + wc * 32 + 8 * fq;
#pragma unroll
        for (int ai = 0; ai < 2; ++ai)
#pragma unroll
            for (int m = 0; m < 4; ++m) { bf16_t* rowp = O + (size_t)(row0 + ai * HALF + m * 16) * ldc + col0;
#pragma unroll
                for (int bj = 0; bj < 2; ++bj) *(u32x4*)(rowp + bj * HALF) = pack8(acc[ai][bj][m][0], acc[ai][bj][m][1]); }
    }
};
struct EpiF32 {
    static constexpr bool PERM = false, AFTER_DRAIN = false, HAS_MID = false;
    float* C; int ldc;
    __device__ __forceinline__ void operator()(const f32x4 (&acc)[2][2][4][2], const Unit& u, int wr, int wc, int fr, int fq) const {
        const int row0 = u.pm * BM + wr * 64 + fr, col0 = u.pn * BM + wc * 32 + 4 * fq;
#pragma unroll
        for (int ai = 0; ai < 2; ++ai)
#pragma unroll
            for (int m = 0; m < 4; ++m) { float* rowp = C + (size_t)(row0 + ai * HALF + m * 16) * ldc + col0;
#pragma unroll
                for (int bj = 0; bj < 2; ++bj)
#pragma unroll
                    for (int n = 0; n < 2; ++n) *(f32x4*)(rowp + bj * HALF + n * 16) = acc[ai][bj][m][n]; }
    }
};
struct EpiMergeFused {
    static constexpr bool PERM = true, AFTER_DRAIN = false, HAS_MID = true;
    static constexpr int T1 = 12, T2 = 20;
    const bf16_t* gate; int ldg; bf16_t* mb;
    __device__ __forceinline__ void mid(f32x4 (&acc)[2][2][4][2], const Unit& u, int wr, int wc, int fr, int fq, int t) const {
        const int row0 = u.pm * BM + wr * 64 + fr, col0 = u.pn * BM + wc * 32 + 8 * fq; const bf16_t* gx = gate + (t == T1 ? 0 : 2048); const bf16_t* gy = gx + 2048;
#pragma unroll
        for (int ai = 0; ai < 2; ++ai) { u32x4 wx[4][2], wy[4][2];
#pragma unroll
            for (int m = 0; m < 4; ++m)
#pragma unroll
                for (int bj = 0; bj < 2; ++bj) { const size_t o = (size_t)(row0 + ai * HALF + m * 16) * ldg + col0 + bj * HALF; wx[m][bj] = *(const u32x4*)(gx + o); wy[m][bj] = *(const u32x4*)(gy + o); }
#pragma unroll
            for (int m = 0; m < 4; ++m)
#pragma unroll
                for (int bj = 0; bj < 2; ++bj) { f32x4 x0, x1, y0, y1; unpack8(wx[m][bj], x0, x1); unpack8(wy[m][bj], y0, y1);
#pragma unroll
                    for (int j = 0; j < 4; ++j) { acc[ai][bj][m][0][j] *= x0[j] * __builtin_amdgcn_rcpf(y0[j]); acc[ai][bj][m][1][j] *= x1[j] * __builtin_amdgcn_rcpf(y1[j]); } }
            asm volatile("" ::: "memory"); }
    }
    __device__ __forceinline__ void operator()(const f32x4 (&acc)[2][2][4][2], const Unit& u, int wr, int wc, int fr, int fq) const {
        const int row0 = u.pm * BM + wr * 64 + fr, col0 = u.pn * BM + wc * 32 + 8 * fq; const bf16_t* gc = gate + 4096;
#pragma unroll
        for (int ai = 0; ai < 2; ++ai) { u32x4 gw[4][2];
#pragma unroll
            for (int m = 0; m < 4; ++m)
#pragma unroll
                for (int bj = 0; bj < 2; ++bj) gw[m][bj] = *(const u32x4*)(gc + (size_t)(row0 + ai * HALF + m * 16) * ldg + col0 + bj * HALF);
#pragma unroll
            for (int m = 0; m < 4; ++m)
#pragma unroll
                for (int bj = 0; bj < 2; ++bj) { f32x4 g0, g1; unpack8(gw[m][bj], g0, g1);
                    *(u32x4*)(mb + (size_t)(row0 + ai * HALF + m * 16) * 2048 + col0 + bj * HALF) = pack8(g0 * acc[ai][bj][m][0], g1 * acc[ai][bj][m][1]); }
            asm volatile("" ::: "memory"); }
    }
};
}

#define GAS __attribute__((address_space(1)))
#define LAS __attribute__((address_space(3)))
typedef unsigned short bf16_t;
typedef short bf16x8 __attribute__((ext_vector_type(8)));
typedef short s16x4 __attribute__((ext_vector_type(4)));
typedef float f32x4 __attribute__((ext_vector_type(4)));
typedef float f32x16 __attribute__((ext_vector_type(16)));
typedef unsigned u32x4 __attribute__((ext_vector_type(4)));
typedef unsigned u32x2 __attribute__((ext_vector_type(2)));
#define LDS_WAIT() asm volatile("s_waitcnt lgkmcnt(0)" ::: "memory")
#define VM_WAIT() asm volatile("s_waitcnt vmcnt(0)" ::: "memory")
#define SBAR() __builtin_amdgcn_sched_barrier(0)
__device__ __forceinline__ unsigned f2bf(float f) { unsigned u = __builtin_bit_cast(unsigned, f); return (u + 0x7fffu + ((u >> 16) & 1u)) >> 16; }
__device__ __forceinline__ float bf2f(bf16_t b) { return __uint_as_float(((unsigned)b) << 16); }
__device__ __forceinline__ unsigned pk2(float lo, float hi) { return f2bf(lo) | (f2bf(hi) << 16); }
__device__ __forceinline__ float wave_sum(float v) { return sum_xor32(sum_xor16(sum_row16(v))); }

constexpr int NB = 2, SEQ = 16384, MTOK = NB * SEQ, DM = 2048, FF = 5504, DEPTH = 4;
constexpr int NGU = 2 * FF, NIN = 11008, U1W = 4864, U2W = 6144;
constexpr int C_CQ = 0, C_CKV = 512, C_QB = 768, C_KB = 1024, C_VB = 1280, C_QC = 1792, C_KC = 2560, C_VC = 3328, C_KROPE = 4096, C_GLR = 4160, C_RB = 4352;
constexpr int QRAW_LD = 1280, KVRAW_LD = 1536, YW = 1536;
constexpr float EPS = 1e-6f, LOG2E = 1.4426950408889634f, LN2 = 0.6931471805599453f;
constexpr float QS_MLA = 0.07216878364870322f * LOG2E;
constexpr float QS_DSWA = 0.08838834764831845f * LOG2E;

namespace att {
constexpr int SHM_V = 64 * 128 * 2;
__device__ __forceinline__ int v_rd_base(int lane) { const int g = lane >> 4, c = lane & 15; return (g & 1) * 2048 + (g >> 1) * 256 + (c >> 2) * 64 + (c & 3) * 8; }
__device__ __forceinline__ unsigned cvtpk(float lo, float hi) { unsigned r; asm volatile("v_cvt_pk_bf16_f32 %0, %1, %2" : "=v"(r) : "v"(lo), "v"(hi)); return r; }
#define MFMA16(A_, B_, C_) __builtin_amdgcn_mfma_f32_16x16x32_bf16(A_, B_, C_, 0, 0, 0)

#define TRRD(dst, base, off) asm volatile("ds_read_b64_tr_b16 %0, %1 offset:%2" : "=&v"(dst) : "v"(base), "i"(off) : "memory")
#define PV_SLOT_RD(i) do { constexpr int i_ = (i); if ((i_ & 1) == 0) { TRRD(va[i_ & 7], vbe, (i_ >> 2) * 512 + ((i_ >> 1) & 1) * 8192); TRRD(vb[i_ & 7], vbe, (i_ >> 2) * 512 + ((i_ >> 1) & 1) * 8192 + 4096); } \
        else { TRRD(va[i_ & 7], vbo, (i_ >> 2) * 512 + ((i_ >> 1) & 1) * 8192); TRRD(vb[i_ & 7], vbo, (i_ >> 2) * 512 + ((i_ >> 1) & 1) * 8192 + 4096); } } while (0)
__device__ __forceinline__ void pv_issue(s16x4 (&va)[8], s16x4 (&vb)[8], int vbe, int vbo) { PV_SLOT_RD(0); PV_SLOT_RD(1); PV_SLOT_RD(2); PV_SLOT_RD(3); PV_SLOT_RD(4); PV_SLOT_RD(5); PV_SLOT_RD(6); }
template <class F> __device__ __forceinline__ void pv_tile(f32x4 (&o)[8][2], s16x4 (&va)[8], s16x4 (&vb)[8], int vbe, int vbo, bf16x8 p00, bf16x8 p01, bf16x8 p10, bf16x8 p11, F&& between) {
#define VF_(x, y) (bf16x8){x[0], x[1], x[2], x[3], y[0], y[1], y[2], y[3]}
#define PV_SLOT_MM(i) do { constexpr int i_ = (i), db_ = 2 * (i_ >> 2) + (i_ & 1); const bf16x8 f_ = VF_(va[i_ & 7], vb[i_ & 7]); \
        if (((i_ >> 1) & 1) == 0) { o[db_][0] = MFMA16(f_, p00, o[db_][0]); o[db_][1] = MFMA16(f_, p10, o[db_][1]); } else { o[db_][0] = MFMA16(f_, p01, o[db_][0]); o[db_][1] = MFMA16(f_, p11, o[db_][1]); } } while (0)
#define PV_STEP(i, W) do { if ((i) + 7 < 16) PV_SLOT_RD(((i) + 7) & 15); asm volatile("s_waitcnt lgkmcnt(" #W ")" ::: "memory"); SBAR(); PV_SLOT_MM(i); SBAR(); } while (0)
    PV_STEP(0, 14); PV_STEP(1, 14); PV_STEP(2, 14); PV_STEP(3, 14); between(0); SBAR();
    PV_STEP(4, 14); PV_STEP(5, 14); PV_STEP(6, 14); PV_STEP(7, 14); between(1); SBAR();
    PV_STEP(8, 14); PV_STEP(9, 12); PV_STEP(10, 10); PV_STEP(11, 8); between(2); SBAR();
    PV_STEP(12, 6); PV_STEP(13, 4); PV_STEP(14, 2); PV_STEP(15, 0); between(3);
#undef PV_STEP
#undef PV_SLOT_MM
#undef VF_
}

struct AUnit { const bf16_t* Q; const bf16_t* K; const bf16_t* V; bf16_t* O; float* lse; size_t qpitch, kpitch, vpitch, opitch, lsepitch; int q0, j_lo, j_hi; float bias_c, mbound; };

template <int DQK> __device__ __forceinline__ int k_chunk_swz(int row, int c) {
    if (DQK == 192) return (c & ~7) | ((c & 7) ^ ((row >> 1) & 7));
    return c ^ (((row >> 1) & 7) | ((row & 1) << 3));
}
template <int DQK, int MODE, int VAR = 0>
__device__ __forceinline__ void attn_unit(LAS unsigned char* lds, const AUnit& u, const int wv) {
    constexpr int PK = DQK * 2, SHK = 64 * PK, NCH = DQK / 8, NKD = (64 * NCH) / 512, NKS = DQK / 32;
    constexpr int KOFF = 4 * SHM_V;
    int tid_ = wv * 64 + lane_id_v(); asm volatile("" : "+v"(tid_));
    const int tid = tid_, wid = __builtin_amdgcn_readfirstlane(tid >> 6), lane = tid & 63, c16 = lane & 15, g4 = lane >> 4;
    LAS unsigned char* V_lds = lds; LAS unsigned char* K_lds = lds + KOFF;
    bf16x8 qr[2][NKS];
#pragma unroll
    for (int qb = 0; qb < 2; ++qb) { const bf16_t* qrow = u.Q + (size_t)(wid * 32 + 16 * qb + c16) * u.qpitch + g4 * 8;
#pragma unroll
      for (int ks = 0; ks < NKS; ++ks) qr[qb][ks] = *(const bf16x8*)(qrow + ks * 32); }
    float l0 = 0.f, l1 = 0.f; f32x4 o[8][2]; const float mb_ = u.mbound;
#pragma unroll
    for (int db = 0; db < 8; ++db) { o[db][0] = (f32x4){0.f, 0.f, 0.f, 0.f}; o[db][1] = (f32x4){0.f, 0.f, 0.f, 0.f}; }
    const int vb0 = (int)(size_t)V_lds + v_rd_base(lane), vsw = (g4 & 1) * 32;
    const int qlo = u.q0 + wid * 32, qj = qlo + c16;
    const bool lead = wid < 4;
    const float NEG = -__builtin_inff();
#define KSRC(P_, LN_) ([&]() -> unsigned { const int sl = ((P_) * 8 + wid) * 64 + (LN_), row = sl / NCH, cs = sl % NCH; return (unsigned)row * kp32 + (unsigned)k_chunk_swz<DQK>(row, cs) * 8u; }())
#define VSRC(P_, LN_) ([&]() -> unsigned { const int off = (((P_) * 8 + wid) * 64 + (LN_)) * 16, sub = off >> 9, kk = ((sub >> 2) << 3) | ((off & 511) >> 6), c = ((sub & 3) << 5) | (((off ^ (((sub >> 2) & 1) << 5)) & 63) >> 1); \
        const int k = (kk & ~0xC) | ((kk & 4) << 1) | ((kk & 8) >> 1); return (unsigned)k * vp32 + (unsigned)c; }())
    const unsigned kp32 = (unsigned)u.kpitch, vp32 = (unsigned)u.vpitch;
    unsigned dsrc[NKD + 2];
#pragma unroll
    for (int p_ = 0; p_ < NKD + 2; ++p_) dsrc[p_] = p_ < NKD ? KSRC(p_ < NKD ? p_ : 0, lane) : VSRC(p_ >= NKD ? p_ - NKD : 0, lane);
#define ST_PIECE(T_, KBF_, VBF_, P_, LN_) do { if ((P_) < NKD) __builtin_amdgcn_global_load_lds((const unsigned*)(u.K + (size_t)(T_) * 64 * u.kpitch + dsrc[P_]), (LAS unsigned*)(K_lds + (KBF_) * SHK + ((P_) * 8 + wid) * 1024), 16, 0, 0); \
        else __builtin_amdgcn_global_load_lds((const unsigned*)(u.V + (size_t)(T_) * 64 * u.vpitch + dsrc[P_]), (LAS unsigned*)(V_lds + (VBF_) * SHM_V + (((P_) - NKD) * 8 + wid) * 1024), 16, 0, 0); } while (0)
#define ST_DMA(t, kbf, vbf) do { int ln_ = lane; asm volatile("" : "+v"(ln_)); _Pragma("unroll") for (int p_ = 0; p_ < NKD + 2; ++p_) ST_PIECE(t, kbf, vbf, p_, ln_); } while (0)
    int kra[DQK == 192 ? 2 : 4];
#pragma unroll
    for (int i = 0; i < (DQK == 192 ? 2 : 4); ++i) kra[i] = (int)(size_t)K_lds + c16 * PK + 16 * k_chunk_swz<DQK>(c16, 4 * i + g4);
#define KFRD(dst_, ka_, ks_, kb_) asm volatile("ds_read_b128 %0, %1 offset:%2" : "=v"(dst_) : "v"(ka_), "i"((kb_) * 16 * PK + (DQK == 192 ? 128 * ((ks_) >> 1) : 0)) : "memory")
#define KADDR(kbs_, ks_) ((DQK == 192 ? kra[(ks_) & 1] : kra[(ks_) & 3]) + (kbs_))
#define QK_TILE(T_, KB_) do { \
        _Pragma("unroll") for (int kb = 0; kb < 4; ++kb) { sc[kb][0] = (f32x4){0.f, 0.f, 0.f, 0.f}; sc[kb][1] = (f32x4){0.f, 0.f, 0.f, 0.f}; } \
        { __builtin_amdgcn_s_setprio(1); bf16x8 kf[2][4]; const int kbs_ = (KB_) * SHK; \
          { const int ka_ = KADDR(kbs_, 0); KFRD(kf[0][0], ka_, 0, 0); KFRD(kf[0][1], ka_, 0, 1); KFRD(kf[0][2], ka_, 0, 2); KFRD(kf[0][3], ka_, 0, 3); } \
          _Pragma("unroll") for (int ks = 0; ks < NKS; ++ks) { \
              if (ks + 1 < NKS) { const int ka_ = KADDR(kbs_, ks + 1); KFRD(kf[(ks + 1) & 1][0], ka_, ks + 1, 0); KFRD(kf[(ks + 1) & 1][1], ka_, ks + 1, 1); KFRD(kf[(ks + 1) & 1][2], ka_, ks + 1, 2); KFRD(kf[(ks + 1) & 1][3], ka_, ks + 1, 3); \
                  asm volatile("s_waitcnt lgkmcnt(4)" ::: "memory"); } else asm volatile("s_waitcnt lgkmcnt(0)" ::: "memory"); \
              SBAR(); \
              _Pragma("unroll") for (int kb = 0; kb < 4; ++kb) { sc[kb][0] = MFMA16(kf[ks & 1][kb], qr[0][ks], sc[kb][0]); sc[kb][1] = MFMA16(kf[ks & 1][kb], qr[1][ks], sc[kb][1]); } \
              SBAR(); } __builtin_amdgcn_s_setprio(0); } \
        const int kb0 = (T_) * 64; \
        if (MODE == 0) { if (kb0 + 63 > qlo) { _Pragma("unroll") for (int kb = 0; kb < 4; ++kb) { _Pragma("unroll") for (int r = 0; r < 4; ++r) { const int key = kb0 + 16 * kb + 4 * g4 + r; \
                if (key > qj) sc[kb][0][r] = NEG; if (key > qj + 16) sc[kb][1][r] = NEG; } } } } \
        else { _Pragma("unroll") for (int kb = 0; kb < 4; ++kb) { _Pragma("unroll") for (int r = 0; r < 4; ++r) { const int dist = qj - (kb0 + 16 * kb + 4 * g4 + r), dist2 = dist + 16; \
                sc[kb][0][r] = ((unsigned)dist <= 128u) ? sc[kb][0][r] - u.bias_c * (float)dist : NEG; sc[kb][1][r] = ((unsigned)dist2 <= 128u) ? sc[kb][1][r] - u.bias_c * (float)dist2 : NEG; } } } } while (0)
#define PKB(qb_, s_) ([&]() -> bf16x8 { u32x4 w_ = {cvtpk(sc[2 * (s_)][qb_][0], sc[2 * (s_)][qb_][1]), cvtpk(sc[2 * (s_)][qb_][2], sc[2 * (s_)][qb_][3]), cvtpk(sc[2 * (s_) + 1][qb_][0], sc[2 * (s_) + 1][qb_][1]), cvtpk(sc[2 * (s_) + 1][qb_][2], sc[2 * (s_) + 1][qb_][3])}; \
        return *reinterpret_cast<bf16x8*>(&w_); }())
#define SOFTMAX_TILE() do { \
        _Pragma("unroll") for (int kb = 0; kb < 4; ++kb) { _Pragma("unroll") for (int r = 0; r < 4; ++r) { sc[kb][0][r] = __builtin_amdgcn_exp2f(sc[kb][0][r] - mb_); sc[kb][1][r] = __builtin_amdgcn_exp2f(sc[kb][1][r] - mb_); } } \
        float ps0 = 0.f, ps1 = 0.f; \
        _Pragma("unroll") for (int kb = 0; kb < 4; ++kb) { _Pragma("unroll") for (int r = 0; r < 4; ++r) { ps0 += sc[kb][0][r]; ps1 += sc[kb][1][r]; } } \
        l0 += ps0; l1 += ps1; \
        p00 = PKB(0, 0); p01 = PKB(0, 1); p10 = PKB(1, 0); p11 = PKB(1, 1); } while (0)
#define PV_PRE(VB_) pv_issue(va, vb, vb0 + (VB_) * SHM_V + vsw, vb0 + (VB_) * SHM_V + (vsw ^ 32))
#define PV_TILE(VB_, DT_, DKB_, DVB_) do { __builtin_amdgcn_s_setprio(1); const int dt_ = (DT_), dkb_ = (DKB_), dvb_ = (DVB_); \
        pv_tile(o, va, vb, vb0 + (VB_) * SHM_V + vsw, vb0 + (VB_) * SHM_V + (vsw ^ 32), p00, p01, p10, p11, [&](int st_) { if (dt_ >= 0) { int lp_ = lane; asm volatile("" : "+v"(lp_)); \
            if (st_ == 0) { ST_PIECE(dt_, dkb_, dvb_, 0, lp_); ST_PIECE(dt_, dkb_, dvb_, 1, lp_); } else if (st_ == 1) { ST_PIECE(dt_, dkb_, dvb_, 2, lp_); } else if (st_ == 2) { ST_PIECE(dt_, dkb_, dvb_, 3, lp_); } \
            else if (NKD + 2 > 4) { ST_PIECE(dt_, dkb_, dvb_, NKD + 1, lp_); } } }); __builtin_amdgcn_s_setprio(0); } while (0)
    f32x4 sc[4][2]; bf16x8 p00, p01, p10, p11; s16x4 va[8], vb[8];
    int kb_ = 0, vb_ = 0, vprev = 0;
    ST_DMA(u.j_lo, 0, 0);
    if (u.j_lo + 1 < u.j_hi) ST_DMA(u.j_lo + 1, 1, 1);
#define TILE_TOP() do { if (t + 1 < u.j_hi) asm volatile("s_waitcnt vmcnt(%0)" :: "i"(NKD + 2) : "memory"); else VM_WAIT(); \
        asm volatile("s_waitcnt lgkmcnt(0)" ::: "memory"); __builtin_amdgcn_s_barrier(); asm volatile("" ::: "memory"); } while (0)
#define DT() ((t + 2 < u.j_hi) ? t + 2 : -1)
#define KB2() (kb_ == 0 ? 2 : kb_ - 1)
#define VB2() ((vb_ + 2) & 3)
#define TILE_NEXT() do { vprev = vb_; kb_ = kb_ == 2 ? 0 : kb_ + 1; vb_ = (vb_ + 1) & 3; } while (0)
    if (lead) {
        { const int t = u.j_lo; TILE_TOP(); QK_TILE(t, kb_); if (DT() >= 0) ST_DMA(DT(), KB2(), VB2()); SOFTMAX_TILE(); TILE_NEXT(); }
        for (int t = u.j_lo + 1; t < u.j_hi; ++t) { PV_PRE(vprev); TILE_TOP(); PV_TILE(vprev, DT(), KB2(), VB2()); QK_TILE(t, kb_); SOFTMAX_TILE(); TILE_NEXT(); }
        PV_PRE(vprev); PV_TILE(vprev, -1, 0, 0);
    } else {
        { const int t = u.j_lo; TILE_TOP(); QK_TILE(t, kb_); if (DT() >= 0) ST_DMA(DT(), KB2(), VB2()); TILE_NEXT(); }
        for (int t = u.j_lo + 1; t < u.j_hi; ++t) { TILE_TOP(); { const int vp_ = vprev; PV_PRE(vp_); SOFTMAX_TILE(); PV_TILE(vp_, DT(), KB2(), VB2()); } QK_TILE(t, kb_); TILE_NEXT(); }
        PV_PRE(vprev); SOFTMAX_TILE(); PV_TILE(vprev, -1, 0, 0);
    }
#undef TILE_TOP
#undef DT
#undef KB2
#undef VB2
#undef TILE_NEXT
    { const int le = lane_id_v(), ce = le & 15, ge = le >> 4;
    const float lt0 = sum_xor32(sum_xor16(l0)), lt1 = sum_xor32(sum_xor16(l1));
    const float i0 = __builtin_amdgcn_rcpf(lt0), i1 = __builtin_amdgcn_rcpf(lt1);
    bf16_t* Ow = u.O + (size_t)(wid * 32 + ce) * u.opitch + 4 * ge;
#pragma unroll
    for (int db = 0; db < 8; ++db) {
        u32x2 w0 = {cvtpk(o[db][0][0] * i0, o[db][0][1] * i0), cvtpk(o[db][0][2] * i0, o[db][0][3] * i0)}; *(u32x2*)(Ow + 16 * db) = w0;
        u32x2 w1 = {cvtpk(o[db][1][0] * i1, o[db][1][1] * i1), cvtpk(o[db][1][2] * i1, o[db][1][3] * i1)}; *(u32x2*)(Ow + 16 * u.opitch + 16 * db) = w1; }
    if (MODE == 1) { if (ge == 0) { u.lse[(size_t)(wid * 32 + ce) * u.lsepitch] = (mb_ + __log2f(lt0)) * LN2; u.lse[(size_t)(wid * 32 + 16 + ce) * u.lsepitch] = (mb_ + __log2f(lt1)) * LN2; } } }
    __syncthreads();
#undef ST_DMA
#undef ST_PIECE
#undef KSRC
#undef VSRC
#undef KFRD
#undef KADDR
#undef QK_TILE
#undef PKB
#undef SOFTMAX_TILE
#undef PV_TILE
#undef PV_PRE
}
}

constexpr size_t al256(size_t x) { return (x + 255) & ~(size_t)255; }
constexpr size_t WS_CTL = 0, CTL_BYTES = 1u << 20;
constexpr size_t WS_ROPE = WS_CTL + CTL_BYTES;
constexpr size_t WS_SSQ = WS_ROPE + al256((size_t)MTOK * 64 * 4);
constexpr size_t WS_XB = WS_SSQ + al256((size_t)MTOK * 32 * 4);
constexpr size_t WS_W = WS_XB + al256((size_t)MTOK * DM * 2);
constexpr size_t W_GU1 = 0, W_D1 = W_GU1 + (size_t)NGU * DM, W_IN = W_D1 + (size_t)DM * FF, W_UQ = W_IN + (size_t)NIN * DM, W_UKV = W_UQ + (size_t)1280 * 512,
                 W_M = W_UKV + (size_t)1536 * 256, W_OUT = W_M + (size_t)DM * YW, W_GU2 = W_OUT + (size_t)DM * DM,
                 W_D2 = W_GU2 + (size_t)NGU * DM, W_END = W_D2 + (size_t)DM * FF;
constexpr size_t WS_WSTRIDE = al256(W_END * 2);
constexpr size_t WS_R1 = WS_W + 2 * WS_WSTRIDE;
constexpr size_t WS_R2 = WS_R1 + al256((size_t)MTOK * U2W * 2);
constexpr size_t WS_QKV = WS_R2 + al256((size_t)MTOK * U1W * 2);
constexpr size_t QKV_Q = 0, QKV_K = (size_t)NB * 6 * SEQ * 192 * 2, QKV_V = 2 * QKV_K, QKV_END = QKV_V + (size_t)NB * 6 * SEQ * 128 * 2;
constexpr size_t WS_R3 = WS_QKV + al256(QKV_END);
constexpr size_t R3_QRAW = 0, R3_KVRAW = (size_t)MTOK * QRAW_LD * 2, R3_RAW_END = R3_KVRAW + (size_t)MTOK * KVRAW_LD * 2;
constexpr size_t R3_Y = 0, R3_DO = R3_Y + (size_t)MTOK * YW * 2, R3_LSE = R3_DO + (size_t)MTOK * 768 * 2;
constexpr size_t R3_END = (R3_LSE + (size_t)MTOK * 6 * 4) > R3_RAW_END ? (R3_LSE + (size_t)MTOK * 6 * 4) : R3_RAW_END;
constexpr size_t WS_GLA = WS_R3 + al256(R3_END);
constexpr size_t GLA_DS = 0, GLA_BC = (size_t)2048 * 8192 * 4, GLA_DEC = GLA_BC + (size_t)MTOK * 256 * 4, GLA_END = GLA_DEC + (size_t)2048 * 64 * 4;
constexpr size_t WS_END = WS_GLA + al256(GLA_END);
constexpr int CW_BAR = 1024;
constexpr int CW_QUEUE = 16384;

constexpr int RING_BYTES = 155648, LDSCTL_OFF = RING_BYTES, LDS_BYTES = 163840;
constexpr int NWAVES = 8, NTHR = 512;

#define XB_TMO      128
#define XB_XCNT(j)  (256  + 64 * (j))
#define XB_XSUB(j)  (1280 + 64 * (j))
#define XB_XGEN(j)  (2304 + 64 * (j))
#define XB_TOP      3328
#define XB_TOPGEN   3392
#define XCD_BAR_WORDS 3456
#define XB_SPIN_CAP (1u << 20)
__device__ __forceinline__ unsigned xb_ld(unsigned* p)              { return __hip_atomic_load(p, __ATOMIC_RELAXED, __HIP_MEMORY_SCOPE_AGENT); }
__device__ __forceinline__ unsigned xb_add(unsigned* p, unsigned v) { return __hip_atomic_fetch_add(p, v, __ATOMIC_RELAXED, __HIP_MEMORY_SCOPE_AGENT); }
__device__ __forceinline__ unsigned xb_xcc_id() { return (unsigned)__builtin_amdgcn_s_getreg((3 << 11) | 20) & 0xFu; }
#define XB_SPIN(cond, bar) do { unsigned _sp = 0; while (cond) { __builtin_amdgcn_s_sleep(1); \
    if ((++_sp & 255u) == 0u) { if (xb_ld(&(bar)[XB_TMO])) break; if (_sp > XB_SPIN_CAP) { atomicAdd(&(bar)[XB_TMO], 1u); break; } } } } while (0)
struct XcdBarrier { unsigned* bar; unsigned x; volatile LAS unsigned* st; int wv; };
__device__ __forceinline__ bool xb_thread0(int wv) { return wv == 0 && lane_id_v() == 0; }
__device__ __forceinline__ XcdBarrier xcd_barrier_post(unsigned* bar, volatile LAS unsigned* st, int wv) {
    XcdBarrier b; b.bar = bar; b.x = xb_xcc_id(); b.st = st; b.wv = wv;
    if (xb_thread0(wv)) (void)xb_add(&bar[XB_XCNT(b.x)], 1u);
    return b;
}
__device__ __forceinline__ void xcd_barrier_complete(unsigned* bar, unsigned x, unsigned& nloc, unsigned& nx) {
    const unsigned G = gridDim.x * gridDim.y * gridDim.z;
    unsigned sum, cnt, mine, sp = 0u;
    for (;;) {
        sum = 0u; cnt = 0u; mine = 0u;
#pragma unroll
        for (unsigned j = 0; j < 16; ++j) { const unsigned c = xb_ld(&bar[XB_XCNT(j)]); sum += c; cnt += (c > 0u) ? 1u : 0u; mine = (j == x) ? c : mine; }
        if (sum == G) break;
        __builtin_amdgcn_s_sleep(1);
        if ((++sp & 255u) == 0u) { if (xb_ld(&bar[XB_TMO])) break; if (sp > XB_SPIN_CAP) { atomicAdd(&bar[XB_TMO], 1u); break; } }
    }
    nloc = mine > 0u ? mine : 1u; nx = cnt > 0u ? cnt : 1u;
}
template <bool FIRST> __device__ __forceinline__ void xcd_barrier(const XcdBarrier& b) {
    asm volatile("s_waitcnt vmcnt(0)" ::: "memory");
    __syncthreads();
    if (xb_thread0(b.wv)) {
        unsigned* bar = b.bar;
        __builtin_amdgcn_s_waitcnt(0);
        unsigned nloc = b.st[0], nx = b.st[1];
        if (FIRST) { xcd_barrier_complete(bar, b.x, nloc, nx); b.st[0] = nloc; b.st[1] = nx; }
        const unsigned old = xb_add(&bar[XB_XSUB(b.x)], 1u);
        const unsigned gen = old / nloc;
        if (old + 1u == (gen + 1u) * nloc) {
            __builtin_amdgcn_fence(__ATOMIC_RELEASE, "agent");
            asm volatile("s_waitcnt vmcnt(0)" ::: "memory");
            const unsigned og = xb_add(&bar[XB_TOP], 1u);
            const unsigned tg = og / nx;
            if (og + 1u == (tg + 1u) * nx) xb_add(&bar[XB_TOPGEN], 1u);
            else XB_SPIN(xb_ld(&bar[XB_TOPGEN]) == tg, bar);
            __builtin_amdgcn_fence(__ATOMIC_ACQUIRE, "agent");
            xb_add(&bar[XB_XGEN(b.x)], 1u);
            asm volatile("s_waitcnt vmcnt(0)" ::: "memory");
        } else {
            XB_SPIN(xb_ld(&bar[XB_XGEN(b.x)]) == gen, bar);
            __builtin_amdgcn_fence(__ATOMIC_ACQUIRE, "agent");
            asm volatile("s_waitcnt vmcnt(0)" ::: "memory");
        }
    }
    __syncthreads();
}

struct Args { const float* in[27]; float* out; unsigned char* ws; int ph_lo, ph_hi, qsel, pad; };
struct Ctx { unsigned char* ws; volatile LAS unsigned long long* ptab;
#ifdef PROBE_ATT_VAR
    unsigned char* outp;
#endif
    __device__ __forceinline__ const float* in(int i) const { const unsigned long long v = ptab[i];
        const unsigned lo = __builtin_amdgcn_readfirstlane((unsigned)v), hi = __builtin_amdgcn_readfirstlane((unsigned)(v >> 32)); return (const float*)(((unsigned long long)hi << 32) | lo); } };
enum { I_X = 0, I_POS, I_F1N, I_F1G, I_F1U, I_F1D, I_MIXN, I_WIN, I_CQN, I_CKVN, I_WUQ, I_WUKV, I_QN, I_KN, I_WG2, I_BG2, I_ON, I_DQN, I_DKN, I_WA, I_WB, I_WC, I_WOUT, I_F2N, I_F2G, I_F2U, I_F2D };

__device__ __forceinline__ int win_map(int n) {
    if (n < 768) return n;
    if (n < 1024) return 832 + (n - 768);
    if (n < 1280) return 1088 + (n - 1024);
    if (n < 1792) return 1344 + (n - 1280);
    if (n < 2560) return 2384 + (n - 1792);
    if (n < 3328) return 3152 + (n - 2560);
    if (n < 4096) return 3920 + (n - 3328);
    if (n < 4160) return 768 + (n - 4096);
    if (n < 4176) return 1856 + (n - 4160);
    if (n < 4352) return -1;
    if (n < 4864) return 1872 + (n - 4352);
    return 4688 + (n - 4864);
}
struct WMat { const float* src; const float* src2; const float* gain; bf16_t* dst; int K, Nsrc, Ndst, kind, ldd; };
__device__ __forceinline__ void wconv_item(const WMat& w, int item, LAS float* scr, int lane) {
    const int nblk = w.Ndst / 32, kb = item / nblk, nb = item % nblk, k0 = 64 * kb, n0 = 32 * nb;
    const int cq = lane & 7, kr = lane >> 3, nn = n0 + 4 * cq;
    const float* sp = w.src; int scol = nn; bool valid = true;
    if (w.kind == 1) { const int tile = nn >> 8; int wi = nn & 255; if (wi >= 128) { sp = w.src2; wi -= 128; } scol = tile * 128 + wi; }
    else if (w.kind == 2) { scol = win_map(nn); valid = scol >= 0; }
    else valid = nn < w.Nsrc;
    if (!valid) scol = 0;
    f32x4 v[8]; float g[8];
#pragma unroll
    for (int i = 0; i < 8; ++i) { const int kk = 8 * i + kr; v[i] = *(const f32x4*)(sp + (size_t)(k0 + kk) * w.Nsrc + scol); g[i] = w.gain ? w.gain[k0 + kk] : 1.f; }
#pragma unroll
    for (int i = 0; i < 8; ++i) { const int kk = 8 * i + kr; LAS float* d = scr + kk * 33 + 4 * cq; const float gg = valid ? g[i] : 0.f;
        d[0] = v[i][0] * gg; d[1] = v[i][1] * gg; d[2] = v[i][2] * gg; d[3] = v[i][3] * gg; }
    LDS_WAIT(); asm volatile("" ::: "memory");
    const int c = lane & 7;
#pragma unroll
    for (int j = 0; j < 4; ++j) { const int n = (lane >> 3) + 8 * j; const LAS float* s = scr + (8 * c) * 33 + n;
        u32x4 o; o.x = pk2(s[0 * 33], s[1 * 33]); o.y = pk2(s[2 * 33], s[3 * 33]); o.z = pk2(s[4 * 33], s[5 * 33]); o.w = pk2(s[6 * 33], s[7 * 33]);
        *(u32x4*)(w.dst + (size_t)(n0 + n) * (w.ldd ? w.ldd : w.K) + k0 + 8 * c) = o; }
    LDS_WAIT(); asm volatile("" ::: "memory");
}
constexpr int wc_items(int K, int Ndst) { return (K / 64) * (Ndst / 32); }
constexpr int WI_GU = wc_items(DM, NGU), WI_D = wc_items(FF, DM), WI_IN = wc_items(DM, NIN), WI_UQ = wc_items(512, 1280), WI_UKV = wc_items(256, 1536),
              WI_A = wc_items(768, DM), WI_B = wc_items(512, DM), WI_C = wc_items(256, DM), WI_OUT = wc_items(DM, DM);
constexpr int WI_TOTAL = 2 * WI_GU + 2 * WI_D + WI_IN + WI_UQ + WI_UKV + WI_A + WI_B + WI_C + WI_OUT;
constexpr int WG_0 = 0, WG_1 = WI_GU, WG_2 = WI_GU + WI_D + WI_IN, WG_3 = WI_TOTAL - WI_D, WG_4 = WI_TOTAL;

__device__ __forceinline__ void phase_wconv(const Ctx& a, int l, LAS unsigned char* lds, int gw, int NGW, int wave, int lane, int it0 = 0, int it1 = WI_TOTAL) {
    LAS float* scr = (LAS float*)(lds + wave * 16384);
    bf16_t* W = (bf16_t*)(a.ws + WS_W + (size_t)(l & 1) * WS_WSTRIDE);
    const size_t oFF = (size_t)l * DM * FF;
    for (int it = it0 + gw; it < it1; it += NGW) {
        int r = it; WMat w;
        if (r < WI_GU) { w = WMat{a.in(I_F1G) + oFF, a.in(I_F1U) + oFF, a.in(I_F1N) + (size_t)l * DM, W + W_GU1, DM, FF, NGU, 1, 0}; }
        else if ((r -= WI_GU) < WI_D) { w = WMat{a.in(I_F1D) + oFF, nullptr, nullptr, W + W_D1, FF, DM, DM, 0, 0}; }
        else if ((r -= WI_D) < WI_IN) { w = WMat{a.in(I_WIN) + (size_t)l * DM * 10832, nullptr, a.in(I_MIXN) + (size_t)l * DM, W + W_IN, DM, 10832, NIN, 2, 0}; }
        else if ((r -= WI_IN) < WI_GU) { w = WMat{a.in(I_F2G) + oFF, a.in(I_F2U) + oFF, a.in(I_F2N) + (size_t)l * DM, W + W_GU2, DM, FF, NGU, 1, 0}; }
        else if ((r -= WI_GU) < WI_OUT) { w = WMat{a.in(I_WOUT) + (size_t)l * DM * DM, nullptr, nullptr, W + W_OUT, DM, DM, DM, 0, 0}; }
        else if ((r -= WI_OUT) < WI_A) { w = WMat{a.in(I_WA) + (size_t)l * 768 * DM, nullptr, nullptr, W + W_M, 768, DM, DM, 0, YW}; }
        else if ((r -= WI_A) < WI_B) { w = WMat{a.in(I_WB) + (size_t)l * 512 * DM, nullptr, nullptr, W + W_M + 768, 512, DM, DM, 0, YW}; }
        else if ((r -= WI_B) < WI_C) { w = WMat{a.in(I_WC) + (size_t)l * 256 * DM, nullptr, nullptr, W + W_M + 1280, 256, DM, DM, 0, YW}; }
        else if ((r -= WI_C) < WI_UQ) { w = WMat{a.in(I_WUQ) + (size_t)l * 512 * 1152, nullptr, a.in(I_CQN) + (size_t)l * 512, W + W_UQ, 512, 1152, 1280, 0, 0}; }
        else if ((r -= WI_UQ) < WI_UKV) { w = WMat{a.in(I_WUKV) + (size_t)l * 256 * 1536, nullptr, a.in(I_CKVN) + (size_t)l * 256, W + W_UKV, 256, 1536, 1536, 0, 0}; }
        else { r -= WI_UKV; w = WMat{a.in(I_F2D) + oFF, nullptr, nullptr, W + W_D2, FF, DM, DM, 0, 0}; }
        wconv_item(w, r, scr, lane);
    }
}

__device__ __forceinline__ void phase_prologue(const Ctx& a, int gw, int NGW, int lane, bf16_t* xl) {
    const int* pos = (const int*)a.in(I_POS);
    float* ropec = (float*)(a.ws + WS_ROPE); float* ropes = ropec + (size_t)MTOK * 32;
    const int i = lane & 31; const float invf = exp2f(-(float)i * 0.41524101186092029f);
    for (int p = gw; p < MTOK / 2; p += NGW) { const int tok = 2 * p + (lane >> 5); const float ang = (float)pos[tok] * invf; float sn, cs; sincosf(ang, &sn, &cs);
        ropec[(size_t)tok * 32 + i] = cs; ropes[(size_t)tok * 32 + i] = sn; }
    const float* x = a.in(I_X); bf16_t* xb = (bf16_t*)(a.ws + WS_XB); float* ssq = (float*)(a.ws + WS_SSQ);
    for (int m = gw; m < MTOK; m += NGW) { const f32x4* xr = (const f32x4*)(x + (size_t)m * DM) + lane; u32x2* o8 = (u32x2*)(xb + ((size_t)((m >> 8) * 32 + (lane >> 4)) * 256 + (m & 255)) * 64) + (lane & 15);        u32x2* l8 = (u32x2*)(xl + (size_t)m * DM) + lane; float s = 0.f;
#pragma unroll
        for (int j = 0; j < 8; ++j) { const f32x4 v = xr[64 * j]; s += (v[0] * v[0] + v[1] * v[1]) + (v[2] * v[2] + v[3] * v[3]); u32x2 w; w.x = pk2(v[0], v[1]); w.y = pk2(v[2], v[3]); o8[(size_t)j * 4 * 256 * 16] = w;
            if (RESID_LO) { u32x2 wl; wl.x = pk2(v[0] - __uint_as_float(w.x << 16), v[1] - __uint_as_float(w.x & 0xffff0000u)); wl.y = pk2(v[2] - __uint_as_float(w.y << 16), v[3] - __uint_as_float(w.y & 0xffff0000u)); l8[64 * j] = wl; } }
        s += lane_xor1(s); if ((lane & 1) == 0) ssq[(size_t)m * 32 + (lane >> 1)] = s; }
}

__device__ __forceinline__ float row16_sum(float x) { return sum_row16(x); }
__device__ __forceinline__ void unpk4(const u32x2 w, float (&f)[4]) { f[0] = __uint_as_float(w.x << 16); f[1] = __uint_as_float(w.x & 0xffff0000u); f[2] = __uint_as_float(w.y << 16); f[3] = __uint_as_float(w.y & 0xffff0000u); }
__device__ __forceinline__ void unpk8(const u32x4 w, float (&f)[8]) { f[0] = __uint_as_float(w.x << 16); f[1] = __uint_as_float(w.x & 0xffff0000u); f[2] = __uint_as_float(w.y << 16); f[3] = __uint_as_float(w.y & 0xffff0000u);
    f[4] = __uint_as_float(w.z << 16); f[5] = __uint_as_float(w.z & 0xffff0000u); f[6] = __uint_as_float(w.w << 16); f[7] = __uint_as_float(w.w & 0xffff0000u); }
__device__ __forceinline__ float ssq8(const u32x4 w) { float f[8]; unpk8(w, f); return ((f[0] * f[0] + f[1] * f[1]) + (f[2] * f[2] + f[3] * f[3])) + ((f[4] * f[4] + f[5] * f[5]) + (f[6] * f[6] + f[7] * f[7])); }
__device__ __forceinline__ void rope4(float (&x)[4], const f32x4 cs, const f32x4 sn, bool first) {
#pragma unroll
    for (int e = 0; e < 4; ++e) { const float xp = dppx<0x128>(x[e]); x[e] = first ? x[e] * cs[e] - xp * sn[e] : xp * sn[e] + x[e] * cs[e]; }
}
__device__ __forceinline__ void phase_prep(const Ctx& a, int l, int gw, int NGW, int lane, bool do_dswa) {
    bf16_t* u1 = (bf16_t*)(a.ws + WS_R2);
    const bf16_t* qraw = (const bf16_t*)(a.ws + WS_R3 + R3_QRAW); const bf16_t* kvraw = (const bf16_t*)(a.ws + WS_R3 + R3_KVRAW);
    const float* ropec = (const float*)(a.ws + WS_ROPE); const float* ropes = ropec + (size_t)MTOK * 32;
    bf16_t* Qo = (bf16_t*)(a.ws + WS_QKV + QKV_Q); bf16_t* Ko = (bf16_t*)(a.ws + WS_QKV + QKV_K); bf16_t* Vo = (bf16_t*)(a.ws + WS_QKV + QKV_V);
    const int t = lane & 15, g4 = lane >> 4; const bool first = t < 8;
    const float* gq = a.in(I_QN) + (size_t)l * 192; const float* gk = a.in(I_KN) + (size_t)l * 192;
    const f32x4 gq0 = *(const f32x4*)(gq + 4 * t), gq1 = *(const f32x4*)(gq + 64 + 4 * t), gq2 = *(const f32x4*)(gq + 128 + 4 * t);
    const f32x4 gka = *(const f32x4*)(gk + 8 * t), gkb = *(const f32x4*)(gk + 8 * t + 4), gkr = *(const f32x4*)(gk + 128 + 4 * t);
    const float* dq = a.in(I_DQN) + (size_t)l * 128; const float* dk = a.in(I_DKN) + (size_t)l * 128;
    const f32x4 dqa = *(const f32x4*)(dq + 8 * t), dqb = *(const f32x4*)(dq + 8 * t + 4), dka = *(const f32x4*)(dk + 8 * t), dkb = *(const f32x4*)(dk + 8 * t + 4);
    for (int qd = gw; qd < MTOK / 4; qd += NGW) {
        const int row = 4 * qd + g4; bf16_t* ur = u1 + (size_t)row * U1W; const int b = row / SEQ, s = row % SEQ;
        float q = 0.f;
#pragma unroll
        for (int j = 0; j < 4; ++j) q += ssq8(*(const u32x4*)(ur + C_CQ + 8 * t + 128 * j));
        const float rstd_cq = rsqrtf(row16_sum(q) * (1.f / 512.f) + EPS);
        q = ssq8(*(const u32x4*)(ur + C_CKV + 8 * t)) + ssq8(*(const u32x4*)(ur + C_CKV + 128 + 8 * t));
        const float rstd_ckv = rsqrtf(row16_sum(q) * (1.f / 256.f) + EPS);
        float kr[4]; unpk4(*(const u32x2*)(ur + C_KROPE + 4 * t), kr);
        const float ssq_kr = row16_sum((kr[0] * kr[0] + kr[1] * kr[1]) + (kr[2] * kr[2] + kr[3] * kr[3]));
        const f32x4 cs = *(const f32x4*)(ropec + (size_t)row * 32 + 4 * (t & 7)), sn = *(const f32x4*)(ropes + (size_t)row * 32 + 4 * (t & 7));
#pragma unroll 2
        for (int h = 0; h < 6; ++h) {
            const bf16_t* qp = qraw + (size_t)row * QRAW_LD + h * 192 + 4 * t;
            float x0[4], x1[4], x2[4]; unpk4(*(const u32x2*)qp, x0); unpk4(*(const u32x2*)(qp + 64), x1); unpk4(*(const u32x2*)(qp + 128), x2);
            float ss = 0.f;
#pragma unroll
            for (int e = 0; e < 4; ++e) { x0[e] *= rstd_cq; x1[e] *= rstd_cq; x2[e] *= rstd_cq; ss += x0[e] * x0[e] + x1[e] * x1[e] + x2[e] * x2[e]; }
            const float rq = rsqrtf(row16_sum(ss) * (1.f / 192.f) + EPS);
#pragma unroll
            for (int e = 0; e < 4; ++e) { x0[e] *= rq * gq0[e]; x1[e] *= rq * gq1[e]; x2[e] *= rq * gq2[e]; }
            rope4(x2, cs, sn, first);
            bf16_t* qo = Qo + ((size_t)((b * 6 + h) * SEQ + s)) * 192 + 4 * t;
            { u32x2 w; w.x = pk2(x0[0] * QS_MLA, x0[1] * QS_MLA); w.y = pk2(x0[2] * QS_MLA, x0[3] * QS_MLA); *(u32x2*)qo = w;
              w.x = pk2(x1[0] * QS_MLA, x1[1] * QS_MLA); w.y = pk2(x1[2] * QS_MLA, x1[3] * QS_MLA); *(u32x2*)(qo + 64) = w;
              w.x = pk2(x2[0] * QS_MLA, x2[1] * QS_MLA); w.y = pk2(x2[2] * QS_MLA, x2[3] * QS_MLA); *(u32x2*)(qo + 128) = w; }
            const bf16_t* kp = kvraw + (size_t)row * KVRAW_LD + h * 256 + 8 * t;
            float kn[8], vv[8]; unpk8(*(const u32x4*)kp, kn); unpk8(*(const u32x4*)(kp + 128), vv);
            ss = 0.f;
#pragma unroll
            for (int e = 0; e < 8; ++e) { kn[e] *= rstd_ckv; vv[e] *= rstd_ckv; ss += kn[e] * kn[e]; }
            const float rk = rsqrtf((row16_sum(ss) + ssq_kr) * (1.f / 192.f) + EPS);
            float kx[4];
#pragma unroll
            for (int e = 0; e < 4; ++e) { kn[e] *= rk * gka[e]; kn[4 + e] *= rk * gkb[e]; kx[e] = kr[e] * rk * gkr[e]; }
            rope4(kx, cs, sn, first);
            bf16_t* ko = Ko + ((size_t)((b * 6 + h) * SEQ + s)) * 192;
            { u32x4 w; w.x = pk2(kn[0], kn[1]); w.y = pk2(kn[2], kn[3]); w.z = pk2(kn[4], kn[5]); w.w = pk2(kn[6], kn[7]); *(u32x4*)(ko + 8 * t) = w;
              u32x2 w2; w2.x = pk2(kx[0], kx[1]); w2.y = pk2(kx[2], kx[3]); *(u32x2*)(ko + 128 + 4 * t) = w2;
              w.x = pk2(vv[0], vv[1]); w.y = pk2(vv[2], vv[3]); w.z = pk2(vv[4], vv[5]); w.w = pk2(vv[6], vv[7]);
              *(u32x4*)(Vo + ((size_t)((b * 6 + h) * SEQ + s)) * 128 + 8 * t) = w; }
        }
        if (do_dswa)
#pragma unroll 2
        for (int h = 0; h < 6; ++h) {
            u32x4* qp = (u32x4*)(ur + C_QC + h * 128 + 8 * t); u32x4* kp = (u32x4*)(ur + C_KC + h * 128 + 8 * t);
            float qv[8], kv[8]; unpk8(*qp, qv); unpk8(*kp, kv);
            float sq = 0.f, sk = 0.f;
#pragma unroll
            for (int e = 0; e < 8; ++e) { sq += qv[e] * qv[e]; sk += kv[e] * kv[e]; }
            const float rq = rsqrtf(row16_sum(sq) * (1.f / 128.f) + EPS) * QS_DSWA, rk = rsqrtf(row16_sum(sk) * (1.f / 128.f) + EPS);
            u32x4 w; w.x = pk2(qv[0] * rq * dqa[0], qv[1] * rq * dqa[1]); w.y = pk2(qv[2] * rq * dqa[2], qv[3] * rq * dqa[3]); w.z = pk2(qv[4] * rq * dqb[0], qv[5] * rq * dqb[1]); w.w = pk2(qv[6] * rq * dqb[2], qv[7] * rq * dqb[3]); *qp = w;
            w.x = pk2(kv[0] * rk * dka[0], kv[1] * rk * dka[1]); w.y = pk2(kv[2] * rk * dka[2], kv[3] * rk * dka[3]); w.z = pk2(kv[4] * rk * dkb[0], kv[5] * rk * dkb[1]); w.w = pk2(kv[6] * rk * dkb[2], kv[7] * rk * dkb[3]); *kp = w;
        }
    }
}

__device__ __forceinline__ float logsigmoidf_(float z) { return fminf(z, 0.f) - log1pf(expf(-fabsf(z))); }
__device__ __forceinline__ int crow32(int r, int hi) { return (r & 3) + 8 * (r >> 2) + 4 * hi; }
template <int SA, int SB> __device__ __forceinline__ f32x16 mfma16_f32src(const LAS float* pa, const LAS float* pb, f32x16 acc) {
    float a[8], b[8];
#pragma unroll
    for (int j = 0; j < 8; ++j) { a[j] = pa[j * SA]; b[j] = pb[j * SB]; }
    u32x4 wa = {att::cvtpk(a[0], a[1]), att::cvtpk(a[2], a[3]), att::cvtpk(a[4], a[5]), att::cvtpk(a[6], a[7])}, wb = {att::cvtpk(b[0], b[1]), att::cvtpk(b[2], b[3]), att::cvtpk(b[4], b[5]), att::cvtpk(b[6], b[7])};
    return __builtin_amdgcn_mfma_f32_32x32x16_bf16(*reinterpret_cast<bf16x8*>(&wa), *reinterpret_cast<bf16x8*>(&wb), acc, 0, 0, 0);
}
__device__ __forceinline__ void gla_local(const Ctx& a, int l, LAS unsigned char* lds, int G, int bid, const int wv) {
    int tid_ = wv * 64 + lane_id_v(); asm volatile("" : "+v"(tid_));
    const int tid = tid_, wid = __builtin_amdgcn_readfirstlane(tid >> 6), lane = tid & 63, l32 = lane & 31, hi = lane >> 5;
    LAS float* kd = (LAS float*)lds; LAS float* vv = (LAS float*)(lds + 16640); LAS float* tot = (LAS float*)(lds + 16640 + 32768);
    const bf16_t* u1 = (const bf16_t*)(a.ws + WS_R2);
    float* dS = (float*)(a.ws + WS_GLA + GLA_DS); float* bcum = (float*)(a.ws + WS_GLA + GLA_BC); float* dec = (float*)(a.ws + WS_GLA + GLA_DEC);
    const float* w2 = a.in(I_WG2) + (size_t)l * 16 * 256; const float* b2 = a.in(I_BG2) + (size_t)l * 256;
    const int d = lane, tg = wid;
    struct GLLoad { float w2c[16]; float bias; bf16x8 g0[8], g1[8]; bf16_t kraw[8]; bf16x8 v0, v1; };
    auto gl_load = [&](int ci, GLLoad& L) {
        const int bh = ci >> 8, c = ci & 255, b = bh >> 2, h = bh & 3, row0 = b * SEQ + 64 * c;
#pragma unroll
        for (int j = 0; j < 16; ++j) L.w2c[j] = w2[j * 256 + h * 64 + d];
        L.bias = b2[h * 64 + d];
#pragma unroll
        for (int i = 0; i < 8; ++i) { const int t = tg * 8 + i; const bf16_t* gl = u1 + (size_t)(row0 + t) * U1W + C_GLR; L.g0[i] = *(const bf16x8*)gl; L.g1[i] = *(const bf16x8*)(gl + 8);
            L.kraw[i] = u1[(size_t)(row0 + t) * U1W + C_KB + h * 64 + d]; }
        const int t = tid >> 3, c0 = (tid & 7) * 16; const bf16_t* vp = u1 + (size_t)(row0 + t) * U1W + C_VB + h * 128 + c0;
        L.v0 = *(const bf16x8*)vp; L.v1 = *(const bf16x8*)(vp + 8); };
    GLLoad L;
    if (bid < 2048) gl_load(bid, L);
    for (int ci = bid; ci < 2048; ci += G) {
        const int bh = ci >> 8, c = ci & 255, b = bh >> 2, h = bh & 3, row0 = b * SEQ + 64 * c;
        float bcv[8]; float run = 0.f;
#pragma unroll
        for (int i = 0; i < 8; ++i) { float z = L.bias;
#pragma unroll
            for (int j = 0; j < 8; ++j) { z += bf2f((bf16_t)L.g0[i][j]) * L.w2c[j]; z += bf2f((bf16_t)L.g1[i][j]) * L.w2c[8 + j]; }
            run += logsigmoidf_(z) * (1.f / 16.f); bcv[i] = run; }
        tot[tg * 64 + d] = run;
        bf16_t kraw[8];
#pragma unroll
        for (int i = 0; i < 8; ++i) kraw[i] = L.kraw[i];
        { const int t = tid >> 3, c0 = (tid & 7) * 16;
#pragma unroll
          for (int j = 0; j < 8; ++j) { vv[t * 128 + c0 + j] = bf2f((bf16_t)L.v0[j]); vv[t * 128 + c0 + 8 + j] = bf2f((bf16_t)L.v1[j]); } }
        if (ci + G < 2048) gl_load(ci + G, L);
        __syncthreads();
        float off = 0.f, bend = 0.f;
#pragma unroll
        for (int g = 0; g < 8; ++g) { const float x = tot[g * 64 + d]; bend += x; if (g < tg) off += x; }
#pragma unroll
        for (int i = 0; i < 8; ++i) { const int t = tg * 8 + i; const float bc = bcv[i] + off;
            bcum[(size_t)(row0 + t) * 256 + h * 64 + d] = bc;
            const float kk = bf2f(kraw[i]);
            kd[t * 65 + d] = kk * expf(bend - bc); }
        if (tg == 0) dec[(size_t)ci * 64 + d] = expf(bend);
        __syncthreads();
        { const int di = wid >> 2, ei = wid & 3; f32x16 acc = {};
#pragma unroll
          for (int k0 = 0; k0 < 64; k0 += 16) acc = mfma16_f32src<65, 128>(kd + (k0 + 8 * hi) * 65 + 32 * di + l32, vv + (k0 + 8 * hi) * 128 + 32 * ei + l32, acc);
          float* dst = dS + (size_t)ci * 8192;
#pragma unroll
          for (int r = 0; r < 16; ++r) dst[(32 * di + crow32(r, hi)) * 128 + 32 * ei + l32] = acc[r]; }
        __syncthreads();
    }
}
__device__ __forceinline__ void gla_scan(const Ctx& a, int bid, const int wv) {
    float* dS = (float*)(a.ws + WS_GLA + GLA_DS); const float* dec = (const float*)(a.ws + WS_GLA + GLA_DEC);
    int tid_ = wv * 64 + lane_id_v(); asm volatile("" : "+v"(tid_));
    const int gid = bid * NTHR + tid_, bh = gid >> 11, de = (gid & 2047) * 4, d = de >> 7;
    f32x4 st = {0.f, 0.f, 0.f, 0.f}; float* p = dS + (size_t)bh * 256 * 8192 + de; const float* dc = dec + (size_t)bh * 256 * 64 + d;
    for (int c = 0; c < 256; c += 8) { f32x4 x[8]; float g[8];
#pragma unroll
        for (int i = 0; i < 8; ++i) { x[i] = *(const f32x4*)(p + (size_t)(c + i) * 8192); g[i] = dc[(c + i) * 64]; }
#pragma unroll
        for (int i = 0; i < 8; ++i) { *(f32x4*)(p + (size_t)(c + i) * 8192) = st; st = st * g[i] + x[i]; } }
}
__device__ __forceinline__ void gla_out(const Ctx& a, int l, LAS unsigned char* lds, int G, int bid, const int wv) {
    int tid_ = wv * 64 + lane_id_v(); asm volatile("" : "+v"(tid_));
    const int tid = tid_, wid = __builtin_amdgcn_readfirstlane(tid >> 6), lane = tid & 63, l32 = lane & 31, hi = lane >> 5;
    LAS float* qe = (LAS float*)lds; LAS float* ke = (LAS float*)(lds + 16640); LAS float* At = (LAS float*)(lds + 33280);
    LAS float* vv = (LAS float*)(lds + 49920); LAS float* Sp = (LAS float*)(lds + 82688);
    const bf16_t* u1 = (const bf16_t*)(a.ws + WS_R2);
    const float* dS = (const float*)(a.ws + WS_GLA + GLA_DS); const float* bcum = (const float*)(a.ws + WS_GLA + GLA_BC);
    bf16_t* yb = (bf16_t*)(a.ws + WS_R3 + R3_Y) + 768; const float* go = a.in(I_ON) + (size_t)l * 128;
    struct GOLoad { float bc[8]; bf16_t q[8], k[8]; bf16x8 v0, v1, r0, r1; f32x4 sp[4]; };
    auto go_load = [&](int ci, GOLoad& L) {
        const int bh = ci >> 8, c = ci & 255, b = bh >> 2, h = bh & 3, row0 = b * SEQ + 64 * c;
#pragma unroll
        for (int i = 0; i < 8; ++i) { const int t = wid * 8 + i; L.bc[i] = bcum[(size_t)(row0 + t) * 256 + h * 64 + lane];
            L.q[i] = u1[(size_t)(row0 + t) * U1W + C_QB + h * 64 + lane]; L.k[i] = u1[(size_t)(row0 + t) * U1W + C_KB + h * 64 + lane]; }
        const int t = tid >> 3, c0 = (tid & 7) * 16; const bf16_t* vp = u1 + (size_t)(row0 + t) * U1W + C_VB + h * 128 + c0; const bf16_t* rp = u1 + (size_t)(row0 + t) * U1W + C_RB + h * 128 + c0;
        L.v0 = *(const bf16x8*)vp; L.v1 = *(const bf16x8*)(vp + 8); L.r0 = *(const bf16x8*)rp; L.r1 = *(const bf16x8*)(rp + 8);
        const f32x4* sp = (const f32x4*)(dS + (size_t)ci * 8192) + tid * 4;
#pragma unroll
        for (int j = 0; j < 4; ++j) L.sp[j] = sp[j]; };
    GOLoad L;
    if (bid < 2048) go_load(bid, L);
    for (int ci = bid; ci < 2048; ci += G) {
        const int bh = ci >> 8, c = ci & 255, b = bh >> 2, h = bh & 3, row0 = b * SEQ + 64 * c;
        { const int d = lane, tg = wid;
#pragma unroll
          for (int i = 0; i < 8; ++i) { const int t = tg * 8 + i; const float bc = L.bc[i];
              const float q = bf2f(L.q[i]), k = bf2f(L.k[i]);
              qe[t * 65 + d] = q * 0.125f * expf(bc); ke[t * 65 + d] = k * expf(-bc); } }
        bf16x8 rr0, rr1;
        { const int t = tid >> 3, c0 = (tid & 7) * 16;
#pragma unroll
          for (int j = 0; j < 8; ++j) { vv[t * 128 + c0 + j] = bf2f((bf16_t)L.v0[j]); vv[t * 128 + c0 + 8 + j] = bf2f((bf16_t)L.v1[j]); }
          rr0 = L.r0; rr1 = L.r1;
#pragma unroll
          for (int j = 0; j < 4; ++j) *(LAS f32x4*)(Sp + tid * 16 + j * 4) = L.sp[j]; }
        if (ci + G < 2048) go_load(ci + G, L);
        __syncthreads();
        if (wid < 4) {
            if (wid < 3) { const int ti = wid == 0 ? 0 : 1, si = wid == 2 ? 1 : 0; f32x16 acc = {};
#pragma unroll
                for (int k0 = 0; k0 < 64; k0 += 16) acc = mfma16_f32src<1, 1>(qe + (32 * ti + l32) * 65 + k0 + 8 * hi, ke + (32 * si + l32) * 65 + k0 + 8 * hi, acc);
#pragma unroll
                for (int r = 0; r < 16; ++r) { const int t = 32 * ti + crow32(r, hi), s = 32 * si + l32; At[t * 65 + s] = (s <= t) ? acc[r] : 0.f; } }
            else {
#pragma unroll
                for (int r = 0; r < 16; ++r) At[crow32(r, hi) * 65 + 32 + l32] = 0.f; }
        }
        __syncthreads();
        f32x16 acc = {}; const int ti = wid >> 2, ei = wid & 3;
#pragma unroll
        for (int k0 = 0; k0 < 64; k0 += 16) acc = mfma16_f32src<1, 128>(At + (32 * ti + l32) * 65 + k0 + 8 * hi, vv + (k0 + 8 * hi) * 128 + 32 * ei + l32, acc);
#pragma unroll
        for (int k0 = 0; k0 < 64; k0 += 16) acc = mfma16_f32src<1, 128>(qe + (32 * ti + l32) * 65 + k0 + 8 * hi, Sp + (k0 + 8 * hi) * 128 + 32 * ei + l32, acc);
        __syncthreads();
#pragma unroll
        for (int r = 0; r < 16; ++r) Sp[(32 * ti + crow32(r, hi)) * 128 + 32 * ei + l32] = acc[r];
        __syncthreads();
        { const int t = tid >> 3, e0 = (tid & 7) * 16; float ov[16]; float ss = 0.f;
#pragma unroll
          for (int j = 0; j < 4; ++j) { const f32x4 x = *(const LAS f32x4*)(Sp + t * 128 + e0 + 4 * j); ov[4 * j] = x[0]; ov[4 * j + 1] = x[1]; ov[4 * j + 2] = x[2]; ov[4 * j + 3] = x[3];
              ss += (x[0] * x[0] + x[1] * x[1]) + (x[2] * x[2] + x[3] * x[3]); }
          ss += dppx<0xB1>(ss); ss += dppx<0x4E>(ss); ss += dppx<0x141>(ss);
          const float rs = rsqrtf(ss * (1.f / 128.f) + EPS);
          const bf16x8 r0 = rr0, r1 = rr1;
          unsigned w[8];
#pragma unroll
          for (int j = 0; j < 4; ++j) { w[j] = pk2(ov[2 * j] * rs * go[e0 + 2 * j] * bf2f((bf16_t)r0[2 * j]), ov[2 * j + 1] * rs * go[e0 + 2 * j + 1] * bf2f((bf16_t)r0[2 * j + 1]));
              w[4 + j] = pk2(ov[8 + 2 * j] * rs * go[e0 + 8 + 2 * j] * bf2f((bf16_t)r1[2 * j]), ov[8 + 2 * j + 1] * rs * go[e0 + 8 + 2 * j + 1] * bf2f((bf16_t)r1[2 * j + 1])); }
          u32x4* yo = (u32x4*)(yb + (size_t)(row0 + t) * YW + h * 128 + e0);
          yo[0] = (u32x4){w[0], w[1], w[2], w[3]}; yo[1] = (u32x4){w[4], w[5], w[6], w[7]}; }
        __syncthreads();
    }
}
__device__ __forceinline__ void dswa_combine(const Ctx& a, int gw, int NGW, int lane) {
    const bf16_t* dout = (const bf16_t*)(a.ws + WS_R3 + R3_DO); const float* lse = (const float*)(a.ws + WS_R3 + R3_LSE); bf16_t* yc = (bf16_t*)(a.ws + WS_R3 + R3_Y) + 1280;
    const int hp = lane >> 5, e = 4 * (lane & 31);
    for (int row0 = gw; row0 < MTOK; row0 += 4 * NGW) {
        float l0[4], l1[4], l2[4]; u32x2 a0[4], a1[4], a2[4];
#pragma unroll
        for (int i = 0; i < 4; ++i) { const int row = row0 + i * NGW < MTOK ? row0 + i * NGW : row0;
            l0[i] = lse[(size_t)row * 6 + hp]; l1[i] = lse[(size_t)row * 6 + 2 + hp]; l2[i] = lse[(size_t)row * 6 + 4 + hp];
            a0[i] = *(const u32x2*)(dout + (size_t)row * 768 + hp * 128 + e); a1[i] = *(const u32x2*)(dout + (size_t)row * 768 + (2 + hp) * 128 + e); a2[i] = *(const u32x2*)(dout + (size_t)row * 768 + (4 + hp) * 128 + e); }
#pragma unroll
        for (int i = 0; i < 4; ++i) { const int row = row0 + i * NGW; if (row >= MTOK) break;
            const float mx = fmaxf(l0[i], fmaxf(l1[i], l2[i])); float w0 = expf(l0[i] - mx), w1 = expf(l1[i] - mx), w2 = expf(l2[i] - mx); const float inv = 1.f / (w0 + w1 + w2); w0 *= inv; w1 *= inv; w2 *= inv;
            float o[4];
            o[0] = w0 * __uint_as_float(a0[i].x << 16) + w1 * __uint_as_float(a1[i].x << 16) + w2 * __uint_as_float(a2[i].x << 16);
            o[1] = w0 * __uint_as_float(a0[i].x & 0xffff0000u) + w1 * __uint_as_float(a1[i].x & 0xffff0000u) + w2 * __uint_as_float(a2[i].x & 0xffff0000u);
            o[2] = w0 * __uint_as_float(a0[i].y << 16) + w1 * __uint_as_float(a1[i].y << 16) + w2 * __uint_as_float(a2[i].y << 16);
            o[3] = w0 * __uint_as_float(a0[i].y & 0xffff0000u) + w1 * __uint_as_float(a1[i].y & 0xffff0000u) + w2 * __uint_as_float(a2[i].y & 0xffff0000u);
            u32x2 w; w.x = pk2(o[0], o[1]); w.y = pk2(o[2], o[3]); *(u32x2*)(yc + (size_t)row * YW + hp * 128 + e) = w; }
    }
}

constexpr int N_Q_MLA = 96, N_Q_UNITS = 192;
__device__ __forceinline__ void phase_attention(const Ctx& a, int l, LAS unsigned char* lds, volatile LAS unsigned* qword, const int wv, const int qsel) {
    const bf16_t* u1 = (const bf16_t*)(a.ws + WS_R2);
    float mb_mla, mb_dswa;
    { const int ln = lane_id_v(); const float* gq = a.in(I_QN) + (size_t)l * 192; const float* gk = a.in(I_KN) + (size_t)l * 192; const float* dq = a.in(I_DQN) + (size_t)l * 128; const float* dk = a.in(I_DKN) + (size_t)l * 128;
      float a0 = fmaxf(fmaxf(fabsf(gq[ln]), fabsf(gq[64 + ln])), fabsf(gq[128 + ln])), a1 = fmaxf(fmaxf(fabsf(gk[ln]), fabsf(gk[64 + ln])), fabsf(gk[128 + ln]));
      float a2 = fmaxf(fabsf(dq[ln]), fabsf(dq[64 + ln])), a3 = fmaxf(fabsf(dk[ln]), fabsf(dk[64 + ln]));
      a0 = max_xor32(max_xor16(max_row16(a0))); a1 = max_xor32(max_xor16(max_row16(a1))); a2 = max_xor32(max_xor16(max_row16(a2))); a3 = max_xor32(max_xor16(max_row16(a3)));
      mb_mla = __builtin_bit_cast(float, __builtin_amdgcn_readfirstlane(__builtin_bit_cast(int, 1.02f * QS_MLA * 192.f * a0 * a1)));
      mb_dswa = __builtin_bit_cast(float, __builtin_amdgcn_readfirstlane(__builtin_bit_cast(int, 1.02f * QS_DSWA * 128.f * a2 * a3))); }
    const int xcc = (int)(xb_xcc_id() & 7u);
    for (int qi = 0; qi < 8; ++qi) {
        const int x = (xcc + qi) & 7, j = x >> 1, odd = x & 1;
        unsigned* head = (unsigned*)(a.ws + WS_CTL) + CW_QUEUE + 64 * (8 * l + x) + 4096 * qsel;
        for (;;) {
            if (wv == 0 && lane_id_v() == 0) *qword = __hip_atomic_fetch_add(head, 1u, __ATOMIC_RELAXED, __HIP_MEMORY_SCOPE_AGENT);
            __syncthreads();
            const int p = (int)__builtin_amdgcn_readfirstlane(*qword);
            __syncthreads();
            if (p >= N_Q_UNITS) break;
            att::AUnit u;
            if (p < N_Q_MLA) {
                const int k = p / 3, r = p % 3;
                const int bh = r == 1 ? 3 * j + 1 : 3 * j + 2 * odd, qb = r == 0 ? 63 - 2 * k : (r == 1 ? 62 - 2 * k + odd : 62 - 2 * k), b = bh / 6, h = bh % 6;
                u.Q = (const bf16_t*)(a.ws + WS_QKV + QKV_Q) + ((size_t)bh * SEQ + 256 * qb) * 192; u.qpitch = 192;
                u.K = (const bf16_t*)(a.ws + WS_QKV + QKV_K) + (size_t)bh * SEQ * 192; u.kpitch = 192;
                u.V = (const bf16_t*)(a.ws + WS_QKV + QKV_V) + (size_t)bh * SEQ * 128; u.vpitch = 128;
                u.O = (bf16_t*)(a.ws + WS_R3 + R3_Y) + ((size_t)(b * SEQ + 256 * qb)) * YW + h * 128; u.opitch = YW;
                u.lse = nullptr; u.lsepitch = 0; u.q0 = 256 * qb; u.j_lo = 0; u.j_hi = 4 * qb + 4; u.bias_c = 0.f; u.mbound = mb_mla;
#ifdef PROBE_ATT_VAR
                if (qsel) { u.O = (bf16_t*)(a.outp) + ((size_t)(b * SEQ + 256 * qb)) * YW + h * 128; att::attn_unit<192, 0, PROBE_ATT_VAR>(lds, u, wv); } else
#endif
                att::attn_unit<192, 0>(lds, u, wv);
            } else {
                const int v = x * 96 + (p - N_Q_MLA), b = v / 384, hh = (v / 64) % 6, idx = v % 64, g = hh >> 1, dil = g == 0 ? 1 : (g == 1 ? 4 : 16), nb = 64 / dil, r = idx / nb, qb = idx % nb;
                const size_t tok0 = (size_t)b * SEQ + r;
                u.Q = u1 + (tok0 + (size_t)256 * qb * dil) * U1W + C_QC + hh * 128; u.qpitch = (size_t)dil * U1W;
                u.K = u1 + tok0 * U1W + C_KC + hh * 128; u.kpitch = (size_t)dil * U1W;
                u.V = u1 + tok0 * U1W + C_VC + hh * 128; u.vpitch = (size_t)dil * U1W;
                u.O = (bf16_t*)(a.ws + WS_R3 + R3_DO) + (tok0 + (size_t)256 * qb * dil) * 768 + hh * 128; u.opitch = (size_t)dil * 768;
                u.lse = (float*)(a.ws + WS_R3 + R3_LSE) + (tok0 + (size_t)256 * qb * dil) * 6 + hh; u.lsepitch = (size_t)dil * 6;
                u.q0 = 256 * qb; u.j_lo = 4 * qb - 2 > 0 ? 4 * qb - 2 : 0; u.j_hi = 4 * qb + 4;
                u.bias_c = exp2f(-8.f * (float)(hh + 1) / 6.f) * (float)dil * LOG2E; u.mbound = mb_dswa;
                att::attn_unit<128, 1>(lds, u, wv);
            }
        }
    }
    __syncthreads();
}

constexpr int NPL = 12, NPH = 1 + NPL * DEPTH;
__global__ void __launch_bounds__(NTHR, 2) hybrid_fwd(Args args) {
    extern __shared__ __attribute__((aligned(16))) unsigned char lds_raw[];
    LAS unsigned char* lds = (LAS unsigned char*)lds_raw;
    const int tid = threadIdx.x;
    const int wv = __builtin_amdgcn_readfirstlane(tid >> 6);
    const int G = gridDim.x, bid = blockIdx.x, NGW = G * NWAVES;
#define LAUNDER() int tz_ = lane_id_v(); asm volatile("" : "+v"(tz_)); const int lane = tz_, wave = wv, gw = bid * NWAVES + wave
    volatile LAS unsigned* lctl = (volatile LAS unsigned*)(lds + LDSCTL_OFF);
    for (int u = tid; u < (LDS_BYTES - LDSCTL_OFF) / 4; u += NTHR) lctl[u] = 0u;
    __syncthreads();
#if defined(PROBE_DUP) || defined(PROBE_LIGHT)
    const int qsel_ = args.qsel;
#else
    constexpr int qsel_ = 0;
#endif
#if MK_SINGLE
    constexpr int lo = 0, hi = NPH;
#else
    const int lo = args.ph_lo, hi = args.ph_hi;
#endif
    unsigned* ctl = (unsigned*)(args.ws + WS_CTL);
    XcdBarrier bar; bar.bar = ctl + CW_BAR; bar.x = 0; bar.st = lctl + 8; bar.wv = wv;
    if (hi - lo > 1) bar = xcd_barrier_post(ctl + CW_BAR, lctl + 8, wv);
#ifndef PH_MASK
#define PH_MASK 0xFFFF
#endif
#define IN(k) (lo <= (k) && (k) < hi)
#define EN(j) ((PH_MASK >> (j)) & 1)
#define DUMMY_OUT(p) (qsel_ ? (float*)(wz + WS_R3) : (p))
#define DUMMY_XB(p) (qsel_ ? (bf16_t*)(wz + WS_QKV) : (p))
#define DUMMY_XB2(p) (qsel_ ? (bf16_t*)(wz + WS_R2) : (p))
#define DUMMY_SSQ(p) (qsel_ ? (float*)(wz + WS_GLA) : (p))
#ifndef STAGGER_US
#define STAGGER_US 0
#endif
#define STAGGER() do { const unsigned grp_ = ((unsigned)bid >> 3) & 3u; if (STAGGER_US > 0 && grp_) { const unsigned long long t0_ = __builtin_amdgcn_s_memrealtime(); \
        while (__builtin_amdgcn_s_memrealtime() - t0_ < (unsigned long long)(grp_ * STAGGER_US * 100)) __builtin_amdgcn_s_sleep(8); } } while (0)
#define SEAM(k) do { if (IN(k) && IN((k) + 1)) xcd_barrier<false>(bar); } while (0)
    unsigned char* ws = args.ws;
    volatile LAS unsigned long long* ptab = (volatile LAS unsigned long long*)(lds + LDSCTL_OFF + 256);
    if (tid < 27) ptab[tid] = (unsigned long long)args.in[tid];
    __syncthreads();
    Ctx cx; cx.ws = ws; cx.ptab = ptab;
#ifdef PROBE_ATT_VAR
    cx.outp = (unsigned char*)args.out;
#endif
    float* xres = args.out;
    bf16_t* xl_main = (bf16_t*)args.out;
#define WSP() unsigned char* wz = ws; asm volatile("" : "+s"(wz)); int bz = bid; asm volatile("" : "+s"(bz)); \
    bf16_t* W = (bf16_t*)(wz + WS_W + (size_t)(l & 1) * WS_WSTRIDE); bf16_t* xb = (bf16_t*)(wz + WS_XB); float* ssq = (float*)(wz + WS_SSQ); bf16_t* h1 = (bf16_t*)(wz + WS_R1); bf16_t* u2 = (bf16_t*)(wz + WS_R1); \
    bf16_t* u1 = (bf16_t*)(wz + WS_R2); float* m32 = (float*)(wz + WS_R2); bf16_t* mb = (bf16_t*)(wz + WS_QKV); bf16_t* qraw = (bf16_t*)(wz + WS_R3 + R3_QRAW); bf16_t* kvraw = (bf16_t*)(wz + WS_R3 + R3_KVRAW); \
    bf16_t* yy = (bf16_t*)(wz + WS_R3 + R3_Y); \
    (void)W; (void)xb; (void)ssq; (void)h1; (void)u2; (void)u1; (void)m32; (void)mb; (void)qraw; (void)kvraw; (void)yy

    if (EN(12) && IN(0)) { LAUNDER(); phase_prologue(cx, gw, NGW, lane, xl_main); phase_wconv(cx, 0, lds, gw, NGW, wave, lane, WG_0, WG_1); }
    if (IN(0) && IN(1)) xcd_barrier<true>(bar);
    for (int l = 0; l < DEPTH; ++l) {
        const int pb = 1 + NPL * l;
#define WCONV_TAIL(ll, g0, g1) do { if ((ll) < DEPTH) { const int nwg_ = (MTOK / 256) * (NGU / 256), rem_ = nwg_ % G; const int ns_ = rem_ ? G - rem_ : G, si_ = rem_ ? bid - rem_ : bid; \
        if (si_ >= 0) { __syncthreads(); LAUNDER(); phase_wconv(cx, (ll), lds, si_ * NWAVES + wave, ns_ * NWAVES, wave, lane, (g0), (g1)); } } } while (0)
        if (EN(1) && IN(pb + 1)) { WSP();
            pg8::Gemm g{xb, W + W_GU1, MTOK, NGU, DM, DM}; pg8::StaticOrder S; S.init(MTOK, NGU, G, bz, 4);
#ifdef PROBE_LIGHT
            if (qsel_ == 2) { pg8::EpiBf16 E2{(bf16_t*)(wz + WS_R3), DM}; pg8::gemm_phase<pg8::EpiBf16, pg8::StaticOrder, true, true>(lds, g, S, E2, wv); } else
#endif
            { pg8::EpiSwiGLU E{ssq, h1, FF};
            pg8::gemm_phase<pg8::EpiSwiGLU, pg8::StaticOrder, true, true, true>(lds, g, S, E, wv); }
            WCONV_TAIL(l, WG_1, WG_2);
        }
        SEAM(pb + 1);
        if (EN(2) && IN(pb + 2)) { WSP(); STAGGER();
            pg8::Gemm g{h1, W + W_D1, MTOK, DM, FF, FF}; pg8::StaticOrder S; S.init(MTOK, DM, G, bz, 4);
#ifdef PROBE_LIGHT
            if (qsel_ == 2) { pg8::EpiBf16 E2{(bf16_t*)(wz + WS_QKV), DM}; pg8::gemm_phase<pg8::EpiBf16, pg8::StaticOrder, true, true>(lds, g, S, E2, wv); } else
#endif
            { pg8::EpiResid<false> E{xres, xb, xl_main, xl_main, ssq, 0.5f};
            pg8::gemm_phase<pg8::EpiResid<false>, pg8::StaticOrder, true, true, true>(lds, g, S, E, wv); }
        }
        SEAM(pb + 2);
        if (EN(3) && IN(pb + 3)) { WSP();
            pg8::Gemm g{xb, W + W_IN, MTOK, NIN, DM, DM}; pg8::StaticOrder S; S.init(MTOK, NIN, G, bz, 4);
            pg8::EpiWin E{ssq, u1, u2, U1W, U2W};
            pg8::gemm_phase<pg8::EpiWin, pg8::StaticOrder, true, true, true>(lds, g, S, E, wv);
            WCONV_TAIL(l, WG_2, WG_3);
        }
        SEAM(pb + 3);
        if (EN(4) && IN(pb + 4)) { WSP();
            { pg8::Gemm g{u1 + C_CQ, W + W_UQ, MTOK, 1280, 512, U1W}; pg8::StaticOrder S; S.init(MTOK, 1280, G, bid);
              pg8::EpiBf16 E{qraw, QRAW_LD};
              pg8::gemm_phase<pg8::EpiBf16, pg8::StaticOrder, true, true>(lds, g, S, E, wv); }
            { pg8::Gemm g{u1 + C_CKV, W + W_UKV, MTOK, 1536, 256, U1W}; pg8::StaticOrder S; S.init(MTOK, 1536, G, bid);
              pg8::EpiBf16 E{kvraw, KVRAW_LD};
              pg8::gemm_phase<pg8::EpiBf16, pg8::StaticOrder, true, true>(lds, g, S, E, wv); }
        }
        SEAM(pb + 4);
        if (EN(5) && IN(pb + 5)) { LAUNDER(); phase_prep(cx, l, gw, NGW, lane, qsel_ == 0); gla_local(cx, l, lds, G, bid, wv); }
        SEAM(pb + 5);
        if (EN(6) && IN(pb + 6)) { if (qsel_ == 0) { for (int sb_ = bid; sb_ < 32; sb_ += G) gla_scan(cx, sb_, wv); } phase_attention(cx, l, lds, lctl + 16, wv, qsel_); }
        SEAM(pb + 6);
        if (EN(7) && IN(pb + 7)) { LAUNDER(); gla_out(cx, l, lds, G, bid, wv); dswa_combine(cx, gw, NGW, lane); }
        SEAM(pb + 7);
        if (EN(8) && IN(pb + 8)) { WSP();
            pg8::Gemm g{yy, W + W_M, MTOK, DM, YW, YW}; pg8::StaticOrder S; S.init(MTOK, DM, G, bz, 4);
            pg8::EpiMergeFused E{u2, U2W, mb};
            pg8::gemm_phase<pg8::EpiMergeFused, pg8::StaticOrder, true, true>(lds, g, S, E, wv);
        }
        SEAM(pb + 8);
        if (EN(9) && IN(pb + 9)) { WSP(); STAGGER();
            pg8::Gemm g{mb, W + W_OUT, MTOK, DM, DM, DM}; pg8::StaticOrder S; S.init(MTOK, DM, G, bz, 4);
#ifdef PROBE_LIGHT
            if (qsel_ == 2) { pg8::EpiBf16 E2{(bf16_t*)(wz + WS_R2), DM}; pg8::gemm_phase<pg8::EpiBf16, pg8::StaticOrder, true, true>(lds, g, S, E2, wv); } else
#endif
            { pg8::EpiResid<false> E{xres, xb, xl_main, l + 1 < DEPTH ? xl_main : (bf16_t*)(wz + WS_R2), ssq, 1.0f};
            pg8::gemm_phase<pg8::EpiResid<false>, pg8::StaticOrder, true, true>(lds, g, S, E, wv); }
        }
        SEAM(pb + 9);
        if (EN(10) && IN(pb + 10)) { WSP();
            pg8::Gemm g{xb, W + W_GU2, MTOK, NGU, DM, DM}; pg8::StaticOrder S; S.init(MTOK, NGU, G, bz, 4);
            pg8::EpiSwiGLU E{ssq, h1, FF};
            pg8::gemm_phase<pg8::EpiSwiGLU, pg8::StaticOrder, true, true, true>(lds, g, S, E, wv);
            WCONV_TAIL(l, WG_3, WG_4); WCONV_TAIL(l + 1, WG_0, WG_1);
        }
        SEAM(pb + 10);
        if (EN(11) && IN(pb + 11)) { WSP(); STAGGER();
            pg8::Gemm g{h1, W + W_D2, MTOK, DM, FF, FF}; pg8::StaticOrder S; S.init(MTOK, DM, G, bz, 4);
            if (l + 1 < DEPTH) { pg8::EpiResid<false> E{xres, xb, xl_main, xl_main, ssq, 0.5f}; pg8::gemm_phase<pg8::EpiResid<false>, pg8::StaticOrder, true, true, true>(lds, g, S, E, wv); }
            else { pg8::EpiResid<true> E{xres, xb, (const bf16_t*)(wz + WS_R2), nullptr, ssq, 0.5f}; pg8::gemm_phase<pg8::EpiResid<true>, pg8::StaticOrder, true, true, true>(lds, g, S, E, wv); }
        }
        SEAM(pb + 11);
    }
#undef IN
#undef SEAM
}

extern "C" void kernel_launch(void* const* d_in, const int* in_sizes, int n_in, void* d_out, int out_size, void* d_ws, size_t ws_size, hipStream_t stream) {
    static int grid = 0;
    if (grid == 0) {
        if (n_in != 27 || out_size != MTOK * DM || ws_size < WS_END) { fprintf(stderr, "kernel_launch: unexpected problem: n_in %d out %d ws %zu (need %zu)\n", n_in, out_size, ws_size, (size_t)WS_END); grid = -1; return; }
        int dev = 0, cus = 0, per_cu = 0;
        if (hipGetDevice(&dev) != hipSuccess || hipDeviceGetAttribute(&cus, hipDeviceAttributeMultiprocessorCount, dev) != hipSuccess) { grid = -1; return; }
        if (hipFuncSetAttribute((const void*)hybrid_fwd, hipFuncAttributeMaxDynamicSharedMemorySize, LDS_BYTES) != hipSuccess) { fprintf(stderr, "kernel_launch: hipFuncSetAttribute failed\n"); grid = -1; return; }
        if (hipOccupancyMaxActiveBlocksPerMultiprocessor(&per_cu, (const void*)hybrid_fwd, NTHR, LDS_BYTES) != hipSuccess || per_cu < 1)
            fprintf(stderr, "kernel_launch: occupancy query reports %d workgroups per CU\n", per_cu);
        (void)hipGetLastError();
        grid = cus;
    }
    if (grid < 0) return;
    if (hipMemsetAsync((char*)d_ws + WS_CTL, 0, CTL_BYTES, stream) != hipSuccess) return;
    Args a{};
    for (int i = 0; i < 27; ++i) a.in[i] = (const float*)d_in[i];
    a.out = (float*)d_out; a.ws = (unsigned char*)d_ws;
#if MK_SINGLE
    a.ph_lo = 0; a.ph_hi = NPH;
    hipLaunchKernelGGL(hybrid_fwd, dim3(grid), dim3(NTHR), LDS_BYTES, stream, a);
#else
    for (int p = 0; p < NPH; ++p) { a.ph_lo = p; a.ph_hi = p + 1; a.qsel = 0; hipLaunchKernelGGL(hybrid_fwd, dim3(grid), dim3(NTHR), LDS_BYTES, stream, a);
#ifdef PROBE_DUP
        if (p >= 1 && ((PROBE_DUP >> ((p - 1) % NPL)) & 1)) { a.qsel = 1; hipLaunchKernelGGL(hybrid_fwd, dim3(grid), dim3(NTHR), LDS_BYTES, stream, a); }
#ifdef PROBE_LIGHT
        if (p >= 1 && ((PROBE_LIGHT >> ((p - 1) % NPL)) & 1)) { a.qsel = 2; hipLaunchKernelGGL(hybrid_fwd, dim3(grid), dim3(NTHR), LDS_BYTES, stream, a); }
#endif
#endif
    }
#endif
    const hipError_t le = hipPeekAtLastError();
    if (le != hipSuccess) fprintf(stderr, "kernel_launch: launch failed: %s\n", hipGetErrorName(le));
}
```
